# Optimizing an MI355X kernel written in HIP

```python
import math
import jax, jax.numpy as jnp
from jax import lax
import numpy as np

D_MODEL = 1024
BATCH = 4
SEQ = 8192
DEPTH = 2

D_RNN = D_MODEL
RNN_HEADS = 8
RNN_BLOCK = D_RNN // RNN_HEADS
RNN_CONV = 4
RG_C = 8.0
ATT_HEADS = 8
HEAD_DIM = 128
ATT_WIDTH = ATT_HEADS * HEAD_DIM
Q_BLOCK = 128
D_FF = 3 * D_MODEL
FFN_CONV = 3
EPS = 1e-6
IN_SPLITS = (D_RNN, D_RNN, ATT_WIDTH, ATT_WIDTH, ATT_WIDTH, D_MODEL, D_MODEL)
D_IN = sum(IN_SPLITS)

kernel_name = "hybrid_rglru_stickbreak_adaln_convffn"


def rmsnorm(x, g):
    x32 = x.astype(jnp.float32)
    y = x32 * lax.rsqrt(jnp.mean(x32 * x32, axis=-1, keepdims=True) + EPS)
    return (y * g.astype(jnp.float32)).astype(x.dtype)


def causal_dwconv(x, w, b):
    k_w = w.shape[0]
    s = x.shape[1]
    xp = jnp.pad(x, ((0, 0), (k_w - 1, 0), (0, 0)))
    out = b + w[0] * xp[:, 0:s]
    for k in range(1, k_w):
        out = out + w[k] * xp[:, k:k + s]
    return out


def rg_lru(x, wa, ba, wx, bx, lam):
    b_, s_, c_ = x.shape
    xh = x.reshape(b_, s_, RNN_HEADS, RNN_BLOCK)
    r = jax.nn.sigmoid(jnp.einsum('bshi,hij->bshj', xh, wa).reshape(b_, s_, c_) + ba)
    i = jax.nn.sigmoid(jnp.einsum('bshi,hij->bshj', xh, wx).reshape(b_, s_, c_) + bx)
    log_a = -RG_C * r.astype(jnp.float32) * jax.nn.softplus(-lam.astype(jnp.float32))
    a = jnp.exp(log_a)
    mult = jnp.sqrt(-jnp.expm1(2.0 * log_a))
    u = mult * (i * x).astype(jnp.float32)

    def step(h, inp):
        a_t, u_t = inp
        h = a_t * h + u_t
        return h, h

    h0 = jnp.zeros((b_, c_), jnp.float32)
    _, hs = lax.scan(step, h0, (jnp.swapaxes(a, 0, 1), jnp.swapaxes(u, 0, 1)))
    return jnp.swapaxes(hs, 0, 1).astype(x.dtype)


def head_rmsnorm(x, g):
    return rmsnorm(x, g)


def stick_breaking_attention(q, k, v):
    b_, s_, h_, d_ = q.shape
    nb = s_ // Q_BLOCK
    scale = 1.0 / math.sqrt(d_)
    kh = jnp.transpose(k, (0, 2, 1, 3))
    vh = jnp.transpose(v, (0, 2, 1, 3))
    qb = jnp.transpose(q.reshape(b_, nb, Q_BLOCK, h_, d_), (1, 0, 3, 2, 4))
    key_pos = jnp.arange(s_)

    def one_block(args):
        q_blk, blk = args
        q_pos = blk * Q_BLOCK + jnp.arange(Q_BLOCK)
        mask = key_pos[None, :] < q_pos[:, None]
        z = jnp.einsum('bhqd,bhkd->bhqk', q_blk, kh).astype(jnp.float32) * scale
        log_beta = jax.nn.log_sigmoid(z)
        log_1mb = jnp.where(mask, log_beta - z, 0.0)
        suffix = lax.cumsum(log_1mb, axis=3, reverse=True) - log_1mb
        attn = jnp.where(mask, jnp.exp(log_beta + suffix), 0.0)
        return jnp.einsum('bhqk,bhkd->bhqd', attn.astype(v.dtype), vh)

    out = lax.map(one_block, (qb, jnp.arange(nb)))
    return jnp.transpose(out, (1, 0, 3, 2, 4)).reshape(b_, s_, h_ * d_)


def setup_inputs(seed: int = 0) -> dict:
    key = jax.random.key(seed)
    ks = jax.random.split(key, 24)
    n = jax.random.normal
    L, D = DEPTH, D_MODEL
    u = jax.random.uniform(ks[10], (L, D_RNN), minval=0.9, maxval=0.999)
    a0 = u ** (1.0 / RG_C)
    lam = jnp.log(a0) - jnp.log1p(-a0)
    return {
        "x": n(ks[0], (BATCH, SEQ, D), jnp.float32),
        "c": n(ks[1], (BATCH, D), jnp.float32),
        "ada_w": n(ks[2], (L, D, 6 * D), jnp.float32) * (0.5 * D ** -0.5),
        "ada_b": n(ks[3], (L, 6 * D), jnp.float32) * 0.01,
        "norm1_g": 1.0 + 0.05 * n(ks[4], (L, D), jnp.float32),
        "w_in": n(ks[5], (L, D, D_IN), jnp.float32) * D ** -0.5,
        "conv_w": n(ks[6], (L, RNN_CONV, D_RNN), jnp.float32) * RNN_CONV ** -0.5,
        "conv_b": n(ks[7], (L, D_RNN), jnp.float32) * 0.01,
        "rg_wa": n(ks[8], (L, RNN_HEADS, RNN_BLOCK, RNN_BLOCK), jnp.float32) * RNN_BLOCK ** -0.5,
        "rg_ba": n(ks[9], (L, D_RNN), jnp.float32) * 0.01,
        "rg_wx": n(ks[11], (L, RNN_HEADS, RNN_BLOCK, RNN_BLOCK), jnp.float32) * RNN_BLOCK ** -0.5,
        "rg_bx": n(ks[12], (L, D_RNN), jnp.float32) * 0.01,
        "rg_lambda": lam.astype(jnp.float32),
        "q_norm_g": 1.0 + 0.05 * n(ks[13], (L, HEAD_DIM), jnp.float32),
        "k_norm_g": 1.0 + 0.05 * n(ks[14], (L, HEAD_DIM), jnp.float32),
        "w_out": n(ks[15], (L, D, D), jnp.float32) * D ** -0.5,
        "norm2_g": 1.0 + 0.05 * n(ks[16], (L, D), jnp.float32),
        "ffn_up": n(ks[17], (L, D, 2 * D_FF), jnp.float32) * D ** -0.5,
        "ffn_conv_w": n(ks[18], (L, FFN_CONV, 2 * D_FF), jnp.float32) * FFN_CONV ** -0.5,
        "ffn_conv_b": n(ks[19], (L, 2 * D_FF), jnp.float32) * 0.01,
        "ffn_down": n(ks[20], (L, D_FF, D), jnp.float32) * D_FF ** -0.5,
    }


def reference(x, c, ada_w, ada_b, norm1_g, w_in, conv_w, conv_b, rg_wa, rg_ba, rg_wx, rg_bx,
              rg_lambda, q_norm_g, k_norm_g, w_out, norm2_g, ffn_up, ffn_conv_w, ffn_conv_b,
              ffn_down):
    b_, s_, d_ = x.shape
    cuts = np.cumsum(IN_SPLITS)[:-1].tolist()
    for l in range(DEPTH):
        mod = c @ ada_w[l] + ada_b[l]
        sh1, sc1, gt1, sh2, sc2, gt2 = [m[:, None, :] for m in jnp.split(mod, 6, axis=-1)]

        h = rmsnorm(x, norm1_g[l]) * (1.0 + sc1) + sh1
        p = h @ w_in[l]
        xr, yr, q, k, v, ga, gb = jnp.split(p, cuts, axis=-1)

        xr = causal_dwconv(xr, conv_w[l], conv_b[l])
        y_a = rg_lru(xr, rg_wa[l], rg_ba[l], rg_wx[l], rg_bx[l], rg_lambda[l]) * jax.nn.gelu(yr)

        q = head_rmsnorm(q.reshape(b_, s_, ATT_HEADS, HEAD_DIM), q_norm_g[l])
        k = head_rmsnorm(k.reshape(b_, s_, ATT_HEADS, HEAD_DIM), k_norm_g[l])
        v = v.reshape(b_, s_, ATT_HEADS, HEAD_DIM)
        y_b = stick_breaking_attention(q, k, v)

        mix = jax.nn.sigmoid(ga) * y_a + jax.nn.sigmoid(gb) * y_b
        x = x + gt1 * (mix @ w_out[l])

        h2 = rmsnorm(x, norm2_g[l]) * (1.0 + sc2) + sh2
        up = causal_dwconv(h2 @ ffn_up[l], ffn_conv_w[l], ffn_conv_b[l])
        g_ff, v_ff = jnp.split(up, 2, axis=-1)
        x = x + gt2 * ((jax.nn.gelu(g_ff) * v_ff) @ ffn_down[l])
    return x
```

```cpp
#include <hip/hip_runtime.h>
#include <hip/hip_cooperative_groups.h>
#include <cstdio>
#include <cstdint>
namespace cg = cooperative_groups;
__device__ __forceinline__ int opaque_tid() { int t = threadIdx.x; asm volatile("" : "+v"(t)); return t; }
__device__ __forceinline__ int opaque_bid() { int t = blockIdx.x; asm volatile("" : "+s"(t)); return t; }
namespace pg8 {
#define PG8_LAS __attribute__((address_space(3)))
typedef unsigned short bf16_t;
typedef short bf16x8 __attribute__((ext_vector_type(8)));
typedef float f32x4 __attribute__((ext_vector_type(4)));
typedef unsigned u32x4 __attribute__((ext_vector_type(4)));
constexpr int BM = 256, BK = 64, HALF = 128, HTB = HALF * BK * 2  , STAGE_BYTES = 8 * HTB, NXCD = 8, WGM = 8;

__host__ __device__ __forceinline__ int lds_byte(int r, int c) { const int st = (r >> 4) * 2 + (c >> 5), rr = r & 15, cc = c & 31, ob = rr * 64 + cc * 2; return st * 1024 + (ob ^ (((ob >> 9) & 1) << 5)); }
__host__ __device__ __forceinline__ void stage_rc(int b, int& R, int& C) { const int st = b / 1024, sb = b % 1024, swz = sb ^ (((sb >> 9) & 1) << 5); R = (st >> 1) * 16 + swz / 64; C = (st & 1) * 32 + (swz % 64) / 2; }
__host__ __device__ __forceinline__ int perm32(int rho) { const int n = rho >> 4, i = rho & 15; return 8 * (i >> 2) + 4 * n + (i & 3); }

struct Unit { int pm, pn; };
struct Gemm { const bf16_t* A; const bf16_t* Bt; int M, N, K; };

struct StaticOrder {
    int nM, nN, nwg, G, c;
    __host__ __device__ void init(int M, int N, int G_, int c_) { nM = M / BM; nN = N / BM; nwg = nM * nN; G = G_; c = c_; }
    __host__ __device__ bool next(int i, Unit& u) const {
        const long L = (long)i * G + c; if (L >= nwg) return false;
        int wgid = (int)L; { const int q = nwg / NXCD, r = nwg % NXCD, xcd = wgid % NXCD, off = wgid / NXCD; wgid = (xcd < r ? xcd * (q + 1) : r * (q + 1) + (xcd - r) * q) + off; }
        const int nig = WGM * nN, gid = wgid / nig, fm = gid * WGM, gsz = (nM - fm) < WGM ? (nM - fm) : WGM;
        u.pm = fm + ((wgid % nig) % gsz); u.pn = (wgid % nig) / gsz; return true;
    }
    __device__ __forceinline__ void a_ready(const Unit&) const {}
    __device__ __forceinline__ void done(const Unit&) const {}
};

template <class Epi, class Sched, bool ALIGN_EPI = false, bool SP2 = false>
__device__ __forceinline__ void gemm_phase(PG8_LAS unsigned char* lds, const Gemm g, const Sched& S, const Epi& E) {
    const int tid = opaque_tid(), wid = __builtin_amdgcn_readfirstlane(tid >> 6), lane = tid & 63, wr = wid >> 2, wc = wid & 3, fr = lane & 15, fq = lane >> 4;
    const int K = g.K, nt = K / BK;
    unsigned voffA[2], voffB[2];
#pragma unroll
    for (int i = 0; i < 2; ++i) { int R, C; stage_rc(tid * 16 + i * 8192, R, C); const int Rb = Epi::PERM ? ((R & ~31) + perm32(R & 31)) : R;
        voffA[i] = (unsigned)(R * K + C) * 2u; voffB[i] = (unsigned)(Rb * K + C) * 2u; }
    const size_t kstep = (size_t)(BK * 2);
    const size_t hstep = (size_t)HALF * K * 2;
    const size_t tstep = 2 * hstep;
    const unsigned ldsw = (unsigned)wid * 1024u;
    const int aoff = lds_byte(wr * 64 + fr, fq * 8), boff = lds_byte(wc * 32 + fr, fq * 8);
#define PG8_SA(b, h) (((b) * 2 + (h)) * HTB)
#define PG8_SB(b, h) ((4 + (b) * 2 + (h)) * HTB)
#define PG8_STAGE(bufoff, gbase, voff) do { _Pragma("unroll") for (int _i = 0; _i < 2; ++_i) \
        __builtin_amdgcn_global_load_lds((const unsigned*)((const char*)(gbase) + (voff)[_i]), (PG8_LAS unsigned*)(lds + (bufoff) + ldsw + _i * 8192), 16, 0, 0); } while (0)
#define PG8_LDA(dst, b, h) do { _Pragma("unroll") for (int m = 0; m < 4; ++m) _Pragma("unroll") for (int k = 0; k < 2; ++k) dst[m][k] = *(const PG8_LAS bf16x8*)(lds + PG8_SA(b, h) + aoff + m * 2048 + k * 1024); } while (0)
#define PG8_LDB(dst, b, h) do { _Pragma("unroll") for (int n = 0; n < 2; ++n) _Pragma("unroll") for (int k = 0; k < 2; ++k) dst[n][k] = *(const PG8_LAS bf16x8*)(lds + PG8_SB(b, h) + boff + n * 2048 + k * 1024); } while (0)
#define PG8_MMA(ai, bj, At, Bt) do { __builtin_amdgcn_s_setprio(1); _Pragma("unroll") for (int m = 0; m < 4; ++m) _Pragma("unroll") for (int n = 0; n < 2; ++n) _Pragma("unroll") for (int k = 0; k < 2; ++k) \
        acc[ai][bj][m][n] = __builtin_amdgcn_mfma_f32_16x16x32_bf16(Bt[n][k], At[m][k], acc[ai][bj][m][n], 0, 0, 0); __builtin_amdgcn_s_setprio(0); } while (0)
#define PG8_WAIT_V(n) asm volatile("s_waitcnt vmcnt(" #n ")" ::: "memory")
#define PG8_WAIT_L(n) asm volatile("s_waitcnt lgkmcnt(" #n ")" ::: "memory")
#define PG8_BAR __builtin_amdgcn_s_barrier()
#define PG8_SCHED __builtin_amdgcn_sched_barrier(0)
    Unit cur, nxt; int ui = 0;
    if (!S.next(0, cur)) return;
    f32x4 acc[2][2][4][2];
#pragma unroll
    for (int a = 0; a < 2; ++a)
#pragma unroll
        for (int b = 0; b < 2; ++b)
#pragma unroll
            for (int m = 0; m < 4; ++m)
#pragma unroll
                for (int n = 0; n < 2; ++n) acc[a][b][m][n] = (f32x4){0.f, 0.f, 0.f, 0.f};
    bf16x8 At[4][2], B0[2][2], B1[2][2];
    const char* cA = (const char*)g.A + (size_t)cur.pm * tstep; const char* cB = (const char*)g.Bt + (size_t)cur.pn * tstep;
    S.a_ready(cur);
    if constexpr (SP2) {
        PG8_STAGE(PG8_SB(0, 0), cB, voffB); PG8_STAGE(PG8_SB(0, 1), cB + hstep, voffB); PG8_STAGE(PG8_SA(0, 0), cA, voffA); PG8_STAGE(PG8_SA(0, 1), cA + hstep, voffA);
        if (wr == 1) PG8_BAR;
        PG8_WAIT_V(2); PG8_BAR;
        PG8_STAGE(PG8_SB(1, 0), cB + kstep, voffB); PG8_STAGE(PG8_SA(1, 0), cA + kstep, voffA); PG8_STAGE(PG8_SB(1, 1), cB + hstep + kstep, voffB);
        PG8_WAIT_V(6); PG8_BAR;
    } else {
        PG8_STAGE(PG8_SB(0, 0), cB, voffB); PG8_STAGE(PG8_SA(0, 0), cA, voffA); PG8_STAGE(PG8_SB(0, 1), cB + hstep, voffB); PG8_STAGE(PG8_SA(0, 1), cA + hstep, voffA);
        if (wr == 1) PG8_BAR;
        PG8_WAIT_V(4); PG8_BAR;
        PG8_STAGE(PG8_SB(1, 0), cB + kstep, voffB); PG8_STAGE(PG8_SA(1, 0), cA + kstep, voffA); PG8_STAGE(PG8_SB(1, 1), cB + hstep + kstep, voffB);
        PG8_WAIT_V(6); PG8_BAR;
    }
    for (;;) {
        const bool has_next = S.next(ui + 1, nxt);
        const char* nA = has_next ? (const char*)g.A + (size_t)nxt.pm * tstep : cA; const char* nB = has_next ? (const char*)g.Bt + (size_t)nxt.pn * tstep : cB;
        for (int t = 0; t < nt; t += 2) {
            const bool last = (t == nt - 2);
            const char* a1 = cA + (size_t)(t + 1) * kstep;
            const char* a2 = last ? nA : cA + (size_t)(t + 2) * kstep; const char* b2 = last ? nB : cB + (size_t)(t + 2) * kstep;
            const char* a3 = a2 + kstep; const char* b3 = b2 + kstep;
            if (last && has_next) S.a_ready(nxt);
            if constexpr (SP2) {
            PG8_LDB(B0, 0, 0); PG8_LDB(B1, 0, 1); PG8_SCHED; PG8_LDA(At, 0, 0); PG8_STAGE(PG8_SA(1, 1), a1 + hstep, voffA);
            PG8_WAIT_V(8); PG8_WAIT_L(0); PG8_BAR; PG8_MMA(0, 0, At, B0); PG8_MMA(0, 1, At, B1); PG8_BAR; PG8_SCHED;
            PG8_LDA(At, 0, 1); PG8_STAGE(PG8_SB(0, 0), b2, voffB); PG8_STAGE(PG8_SB(0, 1), b2 + hstep, voffB); PG8_STAGE(PG8_SA(0, 0), a2, voffA);
            PG8_WAIT_V(8); PG8_WAIT_L(0); PG8_BAR; PG8_MMA(1, 0, At, B0); PG8_MMA(1, 1, At, B1); PG8_BAR; PG8_SCHED;
            PG8_LDB(B0, 1, 0); PG8_LDB(B1, 1, 1); PG8_SCHED; PG8_LDA(At, 1, 0); PG8_STAGE(PG8_SA(0, 1), a2 + hstep, voffA);
            PG8_WAIT_V(8); PG8_WAIT_L(0); PG8_BAR; PG8_MMA(0, 0, At, B0); PG8_MMA(0, 1, At, B1); PG8_BAR; PG8_SCHED;
            PG8_LDA(At, 1, 1); PG8_STAGE(PG8_SB(1, 0), b3, voffB); PG8_STAGE(PG8_SB(1, 1), b3 + hstep, voffB); PG8_STAGE(PG8_SA(1, 0), a3, voffA);
            PG8_WAIT_V(8); PG8_WAIT_L(0); PG8_BAR; PG8_MMA(1, 0, At, B0); PG8_MMA(1, 1, At, B1); PG8_BAR; PG8_SCHED;
            } else {
            PG8_LDB(B0, 0, 0); PG8_SCHED; PG8_LDA(At, 0, 0); PG8_STAGE(PG8_SA(1, 1), a1 + hstep, voffA);
            PG8_WAIT_L(8); PG8_BAR; PG8_WAIT_L(0); PG8_MMA(0, 0, At, B0); PG8_BAR; PG8_SCHED;
            PG8_LDB(B1, 0, 1); PG8_STAGE(PG8_SB(0, 0), b2, voffB);
            PG8_BAR; PG8_WAIT_L(0); PG8_MMA(0, 1, At, B1); PG8_BAR;
            PG8_LDA(At, 0, 1); PG8_STAGE(PG8_SA(0, 0), a2, voffA);
            PG8_BAR; PG8_WAIT_L(0); PG8_MMA(1, 0, At, B0); PG8_BAR; PG8_SCHED;
            PG8_STAGE(PG8_SB(0, 1), b2 + hstep, voffB);
            PG8_WAIT_V(6); PG8_BAR; PG8_MMA(1, 1, At, B1); PG8_BAR;
            PG8_LDB(B0, 1, 0); PG8_SCHED; PG8_LDA(At, 1, 0); PG8_STAGE(PG8_SA(0, 1), a2 + hstep, voffA);
            PG8_WAIT_L(8); PG8_BAR; PG8_WAIT_L(0); PG8_MMA(0, 0, At, B0); PG8_BAR; PG8_SCHED;
            PG8_LDB(B1, 1, 1); PG8_STAGE(PG8_SB(1, 0), b3, voffB);
            PG8_BAR; PG8_WAIT_L(0); PG8_MMA(0, 1, At, B1); PG8_BAR;
            PG8_LDA(At, 1, 1); PG8_STAGE(PG8_SA(1, 0), a3, voffA);
            PG8_BAR; PG8_WAIT_L(0); PG8_MMA(1, 0, At, B0); PG8_BAR; PG8_SCHED;
            PG8_STAGE(PG8_SB(1, 1), b3 + hstep, voffB);
            PG8_WAIT_V(6); PG8_BAR; PG8_MMA(1, 1, At, B1); PG8_BAR;
            }
        }
        if constexpr (ALIGN_EPI) { if (wr == 0) PG8_BAR; }
        if constexpr (!Epi::AFTER_DRAIN) { E(acc, cur, wr, wc, fr, fq); S.done(cur); }
        if (!has_next) break;
#pragma unroll
        for (int a = 0; a < 2; ++a)
#pragma unroll
            for (int b = 0; b < 2; ++b)
#pragma unroll
                for (int m = 0; m < 4; ++m)
#pragma unroll
                    for (int n = 0; n < 2; ++n) acc[a][b][m][n] = (f32x4){0.f, 0.f, 0.f, 0.f};
        cur = nxt; cA = nA; cB = nB; ++ui;
        if constexpr (ALIGN_EPI) { if (wr == 1) PG8_BAR; }
    }
    PG8_WAIT_V(0);
    if constexpr (!ALIGN_EPI) { if (wr == 0) PG8_BAR; }
    PG8_BAR;
    if constexpr (Epi::AFTER_DRAIN) { E.fused(acc, cur, wr, wc, fr, fq, lds, wid, lane); S.done(cur); }
#undef PG8_SA
#undef PG8_SB
#undef PG8_STAGE
#undef PG8_LDA
#undef PG8_LDB
#undef PG8_MMA
#undef PG8_WAIT_V
#undef PG8_WAIT_L
#undef PG8_BAR
#undef PG8_SCHED
}
}
typedef pg8::bf16_t bf16_t;
typedef pg8::bf16x8 bf16x8;
typedef pg8::f32x4 f32x4;
typedef pg8::u32x4 u32x4;
typedef unsigned u32x2 __attribute__((ext_vector_type(2)));
#define LAS __attribute__((address_space(3)))

constexpr int DM = 1024, NB = 4, SEQ = 8192, MTOK = NB * SEQ, DIN = 7168, DFF = 3072, DFF2 = 6144, NL = 2;
constexpr int NTH = 512;
constexpr float EPS = 1e-6f;
constexpr int RT = 128, NT = SEQ / RT;
constexpr size_t WS_MOD = 4096;
constexpr size_t WS_GW = WS_MOD + (size_t)NL * NB * 6144 * 4;
constexpr size_t WS_SUM = WS_GW + (size_t)NL * 2 * 8 * 128 * 128 * 2;
constexpr size_t WS_HIN = WS_SUM + (size_t)NB * NT * 1024 * 2 * 4;
constexpr size_t WS_W = (WS_HIN + (size_t)NB * NT * 1024 * 4 + 4095) / 4096 * 4096;
constexpr size_t W_IN_E = (size_t)DIN * DM, W_OUT_E = (size_t)DM * DM, W_UP_E = (size_t)DFF2 * DM, W_DN_E = (size_t)DM * DFF, W_LAYER_E = W_IN_E + W_OUT_E + W_UP_E + W_DN_E;
constexpr size_t WS_XN = WS_W + NL * W_LAYER_E * 2;
constexpr size_t PBUF = (size_t)MTOK * DM * 2;
constexpr size_t WS_P = WS_XN + PBUF;
constexpr size_t WS_END = WS_P + 5 * PBUF;
constexpr int MH = MTOK / 2;
constexpr size_t UPH_BYTES = (size_t)MH * DFF2 * 2;

__device__ __forceinline__ float bf2f(bf16_t b) { return __uint_as_float(((unsigned)b) << 16); }
__device__ __forceinline__ unsigned pk2(float lo, float hi) { unsigned r; asm volatile("v_cvt_pk_bf16_f32 %0, %1, %2" : "=v"(r) : "v"(lo), "v"(hi)); return r; }
__device__ __forceinline__ float bflo(unsigned w) { return __uint_as_float(w << 16); }
__device__ __forceinline__ float bfhi(unsigned w) { return __uint_as_float(w & 0xffff0000u); }
__device__ __forceinline__ float sigmoidf_(float x) { return __builtin_amdgcn_rcpf(1.0f + __expf(-x)); }
__device__ __forceinline__ float gelu_tanh(float x) { const float u = 1.5957691216057308f * (x + 0.044715f * x * x * x); return x * sigmoidf_(u); }

struct EpiSplit {
    static constexpr bool PERM = true, AFTER_DRAIN = false;
    bf16_t* base; size_t tstride; int modes;
    __device__ __forceinline__ void operator()(const f32x4 (&acc)[2][2][4][2], const pg8::Unit& u, int wr, int wc, int fr, int fq) const {
        const int colt = u.pn * 256, t = colt >> 10; const int mode = (modes >> (4 * t)) & 15;
        bf16_t* o = base + (size_t)t * tstride; const int col0 = (colt & 1023) + wc * 32 + 8 * fq; const int row0 = u.pm * 256 + wr * 64 + fr;
#pragma unroll
        for (int ai = 0; ai < 2; ++ai)
#pragma unroll
            for (int m = 0; m < 4; ++m) { bf16_t* rowp = o + (size_t)(row0 + ai * 128 + m * 16) * DM + col0;
#pragma unroll
                for (int bj = 0; bj < 2; ++bj) { f32x4 v0 = acc[ai][bj][m][0], v1 = acc[ai][bj][m][1];
                    if (mode == 1) {
#pragma unroll
                        for (int j = 0; j < 4; ++j) { v0[j] = gelu_tanh(v0[j]); v1[j] = gelu_tanh(v1[j]); } }
                    else if (mode == 2) {
#pragma unroll
                        for (int j = 0; j < 4; ++j) { v0[j] = sigmoidf_(v0[j]); v1[j] = sigmoidf_(v1[j]); } }
                    u32x4 w; w.x = pk2(v0[0], v0[1]); w.y = pk2(v0[2], v0[3]); w.z = pk2(v1[0], v1[1]); w.w = pk2(v1[2], v1[3]);
                    *(u32x4*)(rowp + bj * 128) = w; } }
    }
};
struct EpiPlain {
    static constexpr bool PERM = true, AFTER_DRAIN = false;
    bf16_t* o; int ldc;
    __device__ __forceinline__ void operator()(const f32x4 (&acc)[2][2][4][2], const pg8::Unit& u, int wr, int wc, int fr, int fq) const {
        const int col0 = u.pn * 256 + wc * 32 + 8 * fq; const int row0 = u.pm * 256 + wr * 64 + fr;
#pragma unroll
        for (int ai = 0; ai < 2; ++ai)
#pragma unroll
            for (int m = 0; m < 4; ++m) { bf16_t* rowp = o + (size_t)(row0 + ai * 128 + m * 16) * ldc + col0;
#pragma unroll
                for (int bj = 0; bj < 2; ++bj) { const f32x4 v0 = acc[ai][bj][m][0], v1 = acc[ai][bj][m][1];
                    u32x4 w; w.x = pk2(v0[0], v0[1]); w.y = pk2(v0[2], v0[3]); w.z = pk2(v1[0], v1[1]); w.w = pk2(v1[2], v1[3]);
                    *(u32x4*)(rowp + bj * 128) = w; } }
    }
};
struct EpiRes {
    static constexpr bool PERM = false, AFTER_DRAIN = false;
    const float* res; float* out; const float* gate  ; int row_off;
    __device__ __forceinline__ void operator()(const f32x4 (&acc)[2][2][4][2], const pg8::Unit& u, int wr, int wc, int fr, int fq) const {
        const int grow0 = row_off + u.pm * 256; const int b = grow0 / SEQ; const int row0 = grow0 + wr * 64 + fr, col0 = u.pn * 256 + wc * 32 + 4 * fq;
        f32x4 gv[2][2];
#pragma unroll
        for (int bj = 0; bj < 2; ++bj)
#pragma unroll
            for (int n = 0; n < 2; ++n) gv[bj][n] = *(const f32x4*)(gate + (size_t)b * 6144 + col0 + bj * 128 + n * 16);
#pragma unroll
        for (int ai = 0; ai < 2; ++ai)
#pragma unroll
            for (int m = 0; m < 4; ++m) { const size_t off = (size_t)(row0 + ai * 128 + m * 16) * DM + col0;
#pragma unroll
                for (int bj = 0; bj < 2; ++bj)
#pragma unroll
                    for (int n = 0; n < 2; ++n) { const f32x4 r = *(const f32x4*)(res + off + bj * 128 + n * 16); *(f32x4*)(out + off + bj * 128 + n * 16) = r + gv[bj][n] * acc[ai][bj][m][n]; }
                asm volatile("" ::: "memory"); }
    }
};

struct Args { const float* in[21]; float* out; unsigned char* ws; };

__device__ void p0_mod(const Args& a, LAS unsigned char* lds) {
    const int tid = opaque_tid(), w = tid >> 6, lane = tid & 63;
    const float* c = a.in[1]; const float* aw = a.in[2]; const float* ab = a.in[3]; float* mod = (float*)(a.ws + WS_MOD);
    LAS float* red = (LAS float*)lds;
    for (int grp = blockIdx.x; grp < NL * 6144 / 64; grp += gridDim.x) {
        const int gl = grp * 64 + lane, l = gl / 6144, j = gl % 6144;
        const float* wp = aw + (size_t)l * DM * 6144 + j;
        float s0 = 0.f, s1 = 0.f, s2 = 0.f, s3 = 0.f;
#pragma unroll 8
        for (int k = w * 128; k < w * 128 + 128; ++k) { const float wv = wp[(size_t)k * 6144]; s0 += c[k] * wv; s1 += c[DM + k] * wv; s2 += c[2 * DM + k] * wv; s3 += c[3 * DM + k] * wv; }
        red[(w * 4 + 0) * 64 + lane] = s0; red[(w * 4 + 1) * 64 + lane] = s1; red[(w * 4 + 2) * 64 + lane] = s2; red[(w * 4 + 3) * 64 + lane] = s3;
        __syncthreads();
        if (tid < 256) { const int b = tid >> 6; float s = ab[(size_t)l * 6144 + j];
#pragma unroll
            for (int ww = 0; ww < 8; ++ww) s += red[(ww * 4 + b) * 64 + lane];
            mod[((size_t)l * NB + b) * 6144 + j] = s; }
        __syncthreads();
    }
    bf16_t* gw = (bf16_t*)(a.ws + WS_GW);
    for (size_t idx = (size_t)blockIdx.x * NTH + tid; idx < (size_t)NL * 2 * 8 * 128 * 128; idx += (size_t)gridDim.x * NTH) {
        const int i = idx & 127, j = (idx >> 7) & 127, h = (idx >> 14) & 7, mat = (idx >> 17) & 1, l = (int)(idx >> 18);
        const float* src = a.in[mat ? 10 : 8];
        const float v = src[(((size_t)l * 8 + h) * 128 + i) * 128 + j];
        gw[idx] = (bf16_t)(pk2(v, v) & 0xffff);
    }
}
__device__ void transpose_w(const float* __restrict__ W, bf16_t* __restrict__ Wt, int K, int N, int rmode, LAS unsigned char* lds, int& tcount) {
    LAS float* t = (LAS float*)lds;
    const int tid = opaque_tid(); const int ntn = N / 64, ntiles = (K / 64) * ntn;
    for (int tile = 0; tile < ntiles; ++tile, ++tcount) {
        if ((tcount % (int)gridDim.x) != (int)blockIdx.x) continue;
        const int k0 = (tile / ntn) * 64, n0 = (tile % ntn) * 64;
#pragma unroll
        for (int i = 0; i < 2; ++i) { const int k = (tid >> 4) + 32 * i, n = (tid & 15) * 4; const f32x4 v = *(const f32x4*)(W + (size_t)(k0 + k) * N + n0 + n);
            t[k * 65 + n] = v[0]; t[k * 65 + n + 1] = v[1]; t[k * 65 + n + 2] = v[2]; t[k * 65 + n + 3] = v[3]; }
        __syncthreads();
        { const int n = tid >> 3, p = tid & 7; float v[8];
#pragma unroll
          for (int e = 0; e < 8; ++e) v[e] = t[(p * 8 + e) * 65 + n];
          u32x4 w; w.x = pk2(v[0], v[1]); w.y = pk2(v[2], v[3]); w.z = pk2(v[4], v[5]); w.w = pk2(v[6], v[7]);
          int nr = n0 + n; if (rmode == 1) nr = nr < 2048 ? nr : (nr < 5120 ? nr + 2048 : nr - 3072);
          *(u32x4*)(Wt + (size_t)nr * K + k0 + p * 8) = w; }
        __syncthreads();
    }
}
__device__ void p0_weights(const Args& a, LAS unsigned char* lds) {
    int tc = 0;
    for (int l = 0; l < NL; ++l) {
        bf16_t* wl = (bf16_t*)(a.ws + WS_W) + (size_t)l * W_LAYER_E;
        transpose_w(a.in[5] + (size_t)l * DM * DIN, wl, DM, DIN, 1, lds, tc);
        transpose_w(a.in[15] + (size_t)l * DM * DM, wl + W_IN_E, DM, DM, 0, lds, tc);
        transpose_w(a.in[17] + (size_t)l * DM * DFF2, wl + W_IN_E + W_OUT_E, DM, DFF2, 0, lds, tc);
        transpose_w(a.in[20] + (size_t)l * DFF * DM, wl + W_IN_E + W_OUT_E + W_UP_E, DFF, DM, 0, lds, tc);
    }
}
__device__ void norm_phase(const float* __restrict__ x, const float* __restrict__ g, const float* __restrict__ modl  , int shk, int sck, bf16_t* __restrict__ xn) {
    const int tid = opaque_tid(); const int w = tid >> 6, lane = tid & 63;
    for (int row = blockIdx.x * 8 + w; row < MTOK; row += gridDim.x * 8) {
        const int b = row / SEQ; const float* xr = x + (size_t)row * DM; f32x4 v[4]; float ss = 0.f;
#pragma unroll
        for (int i = 0; i < 4; ++i) { v[i] = *(const f32x4*)(xr + lane * 4 + 256 * i); ss += v[i][0] * v[i][0] + v[i][1] * v[i][1] + v[i][2] * v[i][2] + v[i][3] * v[i][3]; }
#pragma unroll
        for (int o = 32; o >= 1; o >>= 1) ss += __shfl_xor(ss, o);
        const float rstd = rsqrtf(ss * (1.0f / DM) + EPS);
        const float* sh = modl + (size_t)b * 6144 + shk * 1024; const float* sc = modl + (size_t)b * 6144 + sck * 1024;
#pragma unroll
        for (int i = 0; i < 4; ++i) { const int c = lane * 4 + 256 * i; const f32x4 gg = *(const f32x4*)(g + c), s1 = *(const f32x4*)(sc + c), s0 = *(const f32x4*)(sh + c);
            f32x4 y;
#pragma unroll
            for (int j = 0; j < 4; ++j) y[j] = v[i][j] * rstd * gg[j] * (1.0f + s1[j]) + s0[j];
            u32x2 o; o.x = pk2(y[0], y[1]); o.y = pk2(y[2], y[3]); *(u32x2*)(xn + (size_t)row * DM + c) = o; }
    }
}
constexpr int KP = 272, VP = 136;
constexpr float DEAD = -110.0f;
__device__ void attn_phase(const Args& a, int l, LAS unsigned char* lds) {
    const int tid = opaque_tid(), w = __builtin_amdgcn_readfirstlane(tid >> 6), lane = tid & 63, fr = lane & 15, fq = lane >> 4;
    LAS unsigned char* Ks = lds; LAS unsigned char* Vt = lds + 64 * KP; LAS int* flags = (LAS int*)(lds + 64 * KP + 128 * VP);
    bf16_t* Qb = (bf16_t*)(a.ws + WS_P); const bf16_t* Kb = (const bf16_t*)(a.ws + WS_P + PBUF); const bf16_t* Vb = (const bf16_t*)(a.ws + WS_P + 2 * PBUF);
    const float* gq = a.in[13] + l * 128; const float* gk = a.in[14] + l * 128;
    const int sp = tid & 15, skey = tid >> 4;
    float gks[8];
#pragma unroll
    for (int e = 0; e < 8; ++e) gks[e] = gk[sp * 8 + e];
    const int nunits = NB * 8 * (SEQ / 256);
    for (int unit = blockIdx.x; unit < nunits; unit += gridDim.x) {
        const int qt = (SEQ / 256 - 1) - unit / (NB * 8), bh = unit % (NB * 8), b = bh >> 3, hh = bh & 7;
        const size_t rowbase = (size_t)b * SEQ; const int t0 = qt * 256, r0 = t0 + 32 * w;
        bf16x8 qf[2][4];
#pragma unroll
        for (int rb = 0; rb < 2; ++rb) {
            const bf16_t* qp = Qb + (rowbase + r0 + 16 * rb + fr) * DM + hh * 128 + 8 * fq; u32x4 raw[4]; float ss = 0.f;
#pragma unroll
            for (int ks = 0; ks < 4; ++ks) { raw[ks] = *(const u32x4*)(qp + 32 * ks);
#pragma unroll
                for (int j = 0; j < 4; ++j) { const float x0 = bflo(raw[ks][j]), x1 = bfhi(raw[ks][j]); ss += x0 * x0 + x1 * x1; } }
            ss += __shfl_xor(ss, 16); ss += __shfl_xor(ss, 32);
            const float rs = rsqrtf(ss * (1.0f / 128.0f) + EPS) * 0.08838834764831845f;
#pragma unroll
            for (int ks = 0; ks < 4; ++ks) { u32x4 o;
#pragma unroll
                for (int j = 0; j < 4; ++j) { const int d = 32 * ks + 8 * fq + 2 * j; o[j] = pk2(bflo(raw[ks][j]) * rs * gq[d], bfhi(raw[ks][j]) * rs * gq[d + 1]); }
                qf[rb][ks] = __builtin_bit_cast(bf16x8, o); }
        }
        f32x4 O[2][8];
#pragma unroll
        for (int rb = 0; rb < 2; ++rb)
#pragma unroll
            for (int db = 0; db < 8; ++db) O[rb][db] = (f32x4){0.f, 0.f, 0.f, 0.f};
        float carry[2] = {0.f, 0.f};
        bool alive = true;
        for (int kb = qt * 4 + 3; kb >= 0; --kb) {
#pragma unroll
            for (int i = 0; i < 2; ++i) { const int key = skey + 32 * i; const size_t grow = rowbase + kb * 64 + key;
                const u32x4 kr = *(const u32x4*)(Kb + grow * DM + hh * 128 + sp * 8); const u32x4 vr = *(const u32x4*)(Vb + grow * DM + hh * 128 + sp * 8);
                float x[8]; float ss = 0.f;
#pragma unroll
                for (int j = 0; j < 4; ++j) { x[2 * j] = bflo(kr[j]); x[2 * j + 1] = bfhi(kr[j]); ss += x[2 * j] * x[2 * j] + x[2 * j + 1] * x[2 * j + 1]; }
                ss += __shfl_xor(ss, 1); ss += __shfl_xor(ss, 2); ss += __shfl_xor(ss, 4); ss += __shfl_xor(ss, 8);
                const float rs = rsqrtf(ss * (1.0f / 128.0f) + EPS);
                u32x4 o;
#pragma unroll
                for (int j = 0; j < 4; ++j) o[j] = pk2(x[2 * j] * rs * gks[2 * j], x[2 * j + 1] * rs * gks[2 * j + 1]);
                *(LAS u32x4*)(Ks + key * KP + sp * 16) = o;
#pragma unroll
                for (int j = 0; j < 4; ++j) { *(LAS bf16_t*)(Vt + (sp * 8 + 2 * j) * VP + key * 2) = (bf16_t)(vr[j] & 0xffff); *(LAS bf16_t*)(Vt + (sp * 8 + 2 * j + 1) * VP + key * 2) = (bf16_t)(vr[j] >> 16); }
            }
            __syncthreads();
            const bool active = alive && (kb * 64 < r0 + 31);
            if (active) {
                f32x4 S[2][4];
#pragma unroll
                for (int nb = 0; nb < 4; ++nb) {
                    bf16x8 kf[4];
#pragma unroll
                    for (int ks = 0; ks < 4; ++ks) kf[ks] = *(const LAS bf16x8*)(Ks + (16 * nb + fr) * KP + (32 * ks + 8 * fq) * 2);
#pragma unroll
                    for (int rb = 0; rb < 2; ++rb) { f32x4 s = (f32x4){0.f, 0.f, 0.f, 0.f};
#pragma unroll
                        for (int ks = 0; ks < 4; ++ks) s = __builtin_amdgcn_mfma_f32_16x16x32_bf16(kf[ks], qf[rb][ks], s, 0, 0, 0);
                        S[rb][nb] = s; }
                }
                unsigned pw[2][4][2];
#pragma unroll
                for (int rb = 0; rb < 2; ++rb) {
                    const int q = r0 + 16 * rb + fr; float lbv[4][4], suf[4][4], T[4], ab[4];
#pragma unroll
                    for (int nb = 0; nb < 4; ++nb) { float run = 0.f;
#pragma unroll
                        for (int e = 3; e >= 0; --e) { const int key = kb * 64 + 16 * nb + 4 * fq + e; const float z = S[rb][nb][e];
                            const float lb = fminf(z, 0.f) - __logf(1.0f + __expf(-fabsf(z))); const bool mk = key < q;
                            lbv[nb][e] = mk ? lb : -1e30f; suf[nb][e] = run; run += mk ? (lb - z) : 0.f; }
                        const float g1 = __shfl_xor(run, 16), g2 = __shfl_xor(run, 32), g3 = __shfl_xor(g1, 32);
                        T[nb] = run + g1 + g2 + g3; ab[nb] = fq == 0 ? (g1 + g2 + g3) : fq == 1 ? (g2 + g3) : fq == 2 ? g1 : 0.f; }
                    float hi = carry[rb];
#pragma unroll
                    for (int nb = 3; nb >= 0; --nb) { const float base = hi + ab[nb]; float p[4];
#pragma unroll
                        for (int e = 0; e < 4; ++e) p[e] = __expf(lbv[nb][e] + base + suf[nb][e]);
                        pw[rb][nb][0] = pk2(p[0], p[1]); pw[rb][nb][1] = pk2(p[2], p[3]); hi += T[nb]; }
                    carry[rb] = hi;
                }
#pragma unroll
                for (int ks2 = 0; ks2 < 2; ++ks2) {
                    bf16x8 pf[2];
#pragma unroll
                    for (int rb = 0; rb < 2; ++rb) { u32x4 t; t.x = pw[rb][2 * ks2][0]; t.y = pw[rb][2 * ks2][1]; t.z = pw[rb][2 * ks2 + 1][0]; t.w = pw[rb][2 * ks2 + 1][1]; pf[rb] = __builtin_bit_cast(bf16x8, t); }
#pragma unroll
                    for (int db = 0; db < 8; ++db) { const LAS unsigned char* vp = Vt + (16 * db + fr) * VP + (32 * ks2 + 4 * fq) * 2;
                        const u32x2 va = *(const LAS u32x2*)vp, vb = *(const LAS u32x2*)(vp + 32); u32x4 t; t.x = va.x; t.y = va.y; t.z = vb.x; t.w = vb.y; const bf16x8 vf = __builtin_bit_cast(bf16x8, t);
#pragma unroll
                        for (int rb = 0; rb < 2; ++rb) O[rb][db] = __builtin_amdgcn_mfma_f32_16x16x32_bf16(vf, pf[rb], O[rb][db], 0, 0, 0); }
                }
                alive = !__all((carry[0] < DEAD) && (carry[1] < DEAD));
            }
            if (lane == 0) flags[w] = alive ? 1 : 0;
            __syncthreads();
            int any = 0;
#pragma unroll
            for (int ww = 0; ww < 8; ++ww) any |= flags[ww];
            if (!any) break;
        }
#pragma unroll
        for (int rb = 0; rb < 2; ++rb) { bf16_t* op = Qb + (rowbase + r0 + 16 * rb + fr) * DM + hh * 128 + 4 * fq;
#pragma unroll
            for (int db = 0; db < 8; ++db) { u32x2 o; o.x = pk2(O[rb][db][0], O[rb][db][1]); o.y = pk2(O[rb][db][2], O[rb][db][3]); *(u32x2*)(op + 16 * db) = o; } }
        __syncthreads();
    }
}
constexpr int XP = 272;
template <bool FINAL>
__device__ void rnn_phase(const Args& a, int l, LAS unsigned char* lds) {
    const int tid = opaque_tid(), w = __builtin_amdgcn_readfirstlane(tid >> 6), lane = tid & 63, fr = lane & 15, fq = lane >> 4;
    LAS unsigned char* XC = lds; LAS unsigned char* HT = lds + RT * XP;
    const bf16_t* XR = (const bf16_t*)(a.ws + WS_P + PBUF); const bf16_t* GY = (const bf16_t*)(a.ws + WS_P + 2 * PBUF); const bf16_t* SGA = (const bf16_t*)(a.ws + WS_P + 3 * PBUF);
    bf16_t* SGB = (bf16_t*)(a.ws + WS_P + 4 * PBUF); const bf16_t* YB = (const bf16_t*)(a.ws + WS_P);
    float* SUM = (float*)(a.ws + WS_SUM); const float* HIN = (const float*)(a.ws + WS_HIN);
    const bf16_t* gw = (const bf16_t*)(a.ws + WS_GW) + (size_t)l * 2 * 8 * 16384;
    const float* cw = a.in[6] + (size_t)l * 4 * DM; const float* cb = a.in[7] + (size_t)l * DM;
    const float* ba = a.in[9] + (size_t)l * DM; const float* bx = a.in[11] + (size_t)l * DM; const float* lam = a.in[12] + (size_t)l * DM;
    const int sp = tid & 15, stok = tid >> 4;
    const int nunits = NB * 8 * NT;
    for (int unit = blockIdx.x; unit < nunits; unit += gridDim.x) {
        const int hh = unit & 7, b = (unit >> 3) & 3, j = unit >> 5; const int t0 = j * RT; const size_t rowbase = (size_t)b * SEQ;
        const int cbase = hh * 128;
        { float wv[4][8], bv[8];
#pragma unroll
          for (int e = 0; e < 8; ++e) { bv[e] = cb[cbase + sp * 8 + e];
#pragma unroll
              for (int k = 0; k < 4; ++k) wv[k][e] = cw[k * DM + cbase + sp * 8 + e]; }
#pragma unroll
          for (int i = 0; i < 4; ++i) { const int t = t0 + stok + 32 * i; float acc[8];
#pragma unroll
              for (int e = 0; e < 8; ++e) acc[e] = bv[e];
#pragma unroll
              for (int k = 0; k < 4; ++k) { const int ts = t - 3 + k; if (ts >= 0) { const u32x4 r = *(const u32x4*)(XR + (rowbase + ts) * DM + cbase + sp * 8);
#pragma unroll
                  for (int jj = 0; jj < 4; ++jj) { acc[2 * jj] += wv[k][2 * jj] * bflo(r[jj]); acc[2 * jj + 1] += wv[k][2 * jj + 1] * bfhi(r[jj]); } } }
              u32x4 o; o.x = pk2(acc[0], acc[1]); o.y = pk2(acc[2], acc[3]); o.z = pk2(acc[4], acc[5]); o.w = pk2(acc[6], acc[7]);
              *(LAS u32x4*)(XC + (stok + 32 * i) * XP + sp * 16) = o; } }
        bf16x8 wa[4], wx[4];
        { const bf16_t* pa = gw + ((size_t)(0 * 8 + hh) * 128 + 16 * w + fr) * 128 + 8 * fq; const bf16_t* px = gw + ((size_t)(1 * 8 + hh) * 128 + 16 * w + fr) * 128 + 8 * fq;
#pragma unroll
          for (int ks = 0; ks < 4; ++ks) { wa[ks] = *(const bf16x8*)(pa + 32 * ks); wx[ks] = *(const bf16x8*)(px + 32 * ks); } }
        const int c = cbase + 16 * w + fr;
        const float bac = ba[c], bxc = bx[c]; const float lm = lam[c]; const float sp8 = 8.0f * (fmaxf(-lm, 0.f) + __logf(1.0f + __expf(-fabsf(lm))));
        __syncthreads();
        f32x4 A[8], U[8];
#pragma unroll
        for (int mb = 0; mb < 8; ++mb) { f32x4 ra = (f32x4){0.f, 0.f, 0.f, 0.f}, rx = ra;
#pragma unroll
            for (int ks = 0; ks < 4; ++ks) { const bf16x8 xf = *(const LAS bf16x8*)(XC + (16 * mb + fr) * XP + (32 * ks + 8 * fq) * 2);
                ra = __builtin_amdgcn_mfma_f32_16x16x32_bf16(xf, wa[ks], ra, 0, 0, 0); rx = __builtin_amdgcn_mfma_f32_16x16x32_bf16(xf, wx[ks], rx, 0, 0, 0); }
#pragma unroll
            for (int e = 0; e < 4; ++e) { const float r = sigmoidf_(ra[e] + bac), ig = sigmoidf_(rx[e] + bxc); const float la = -sp8 * r; const float av = __expf(la);
                const float x2 = 2.0f * la; const float om = x2 > -0.02f ? -x2 * (1.0f + x2 * (0.5f + x2 * (1.0f / 6.0f))) : 1.0f - av * av;
                const float xc = bf2f(*(const LAS bf16_t*)(XC + (16 * mb + 4 * fq + e) * XP + (16 * w + fr) * 2));
                ra[e] = av; rx[e] = sqrtf(om) * ig * xc; }
            A[mb] = ra; U[mb] = rx; }
        float H = 0.f, Pp = 1.0f;
        if (FINAL) H = HIN[((size_t)b * NT + j) * DM + c];
#pragma unroll
        for (int mb = 0; mb < 8; ++mb) {
            float Ag = A[mb][0] * A[mb][1] * A[mb][2] * A[mb][3];
            float Ug = ((U[mb][0] * A[mb][1] + U[mb][1]) * A[mb][2] + U[mb][2]) * A[mb][3] + U[mb][3];
            { const float a1 = __shfl_up(Ag, 16), u1 = __shfl_up(Ug, 16); if (fq >= 1) { Ug = Ag * u1 + Ug; Ag = Ag * a1; } }
            { const float a2 = __shfl_up(Ag, 32), u2 = __shfl_up(Ug, 32); if (fq >= 2) { Ug = Ag * u2 + Ug; Ag = Ag * a2; } }
            if (FINAL) {
                const float ap = __shfl_up(Ag, 16), up = __shfl_up(Ug, 16);
                float h = fq == 0 ? H : ap * H + up;
#pragma unroll
                for (int e = 0; e < 4; ++e) { h = A[mb][e] * h + U[mb][e]; *(LAS bf16_t*)(HT + (16 * mb + 4 * fq + e) * XP + (16 * w + fr) * 2) = (bf16_t)(pk2(h, h) & 0xffff); }
            }
            const float Am = __shfl(Ag, 48 + fr), Um = __shfl(Ug, 48 + fr);
            H = Am * H + Um; Pp *= Am;
        }
        if (!FINAL) { if (fq == 0) { float* s = SUM + (((size_t)b * NT + j) * DM + c) * 2; s[0] = Pp; s[1] = H; } }
        else {
            __syncthreads();
#pragma unroll
            for (int i = 0; i < 4; ++i) { const int tl = stok + 32 * i; const size_t go = (rowbase + t0 + tl) * DM + cbase + sp * 8;
                const u32x4 hv = *(const LAS u32x4*)(HT + tl * XP + sp * 16); const u32x4 g = *(const u32x4*)(GY + go), s1 = *(const u32x4*)(SGA + go), s2 = *(const u32x4*)(SGB + go), yb = *(const u32x4*)(YB + go);
                u32x4 o;
#pragma unroll
                for (int jj = 0; jj < 4; ++jj) o[jj] = pk2(bflo(s1[jj]) * bflo(hv[jj]) * bflo(g[jj]) + bflo(s2[jj]) * bflo(yb[jj]), bfhi(s1[jj]) * bfhi(hv[jj]) * bfhi(g[jj]) + bfhi(s2[jj]) * bfhi(yb[jj]));
                *(u32x4*)(SGB + go) = o; }
        }
        __syncthreads();
    }
}
__device__ void carry_phase(const Args& a) {
    const float* SUM = (const float*)(a.ws + WS_SUM); float* HIN = (float*)(a.ws + WS_HIN);
    const int gt = blockIdx.x * NTH + opaque_tid(); if (gt >= NB * DM) return;
    const int b = gt / DM, c = gt % DM; float H = 0.f;
#pragma unroll 8
    for (int j = 0; j < NT; ++j) { const size_t o = ((size_t)b * NT + j) * DM + c; HIN[o] = H; const float p = SUM[o * 2], h = SUM[o * 2 + 1]; H = p * H + h; }
}
__device__ void ffnconv_phase(const Args& a, int l, int half) {
    const bf16_t* UP = (const bf16_t*)(a.ws + WS_P); bf16_t* ACT = (bf16_t*)(a.ws + WS_P + UPH_BYTES);
    const float* cw = a.in[18] + (size_t)l * 3 * DFF2; const float* cb = a.in[19] + (size_t)l * DFF2;
    const int nitems = (MH / 16) * (DFF / 8);
    for (int it = blockIdx.x * NTH + opaque_tid(); it < nitems; it += gridDim.x * NTH) {
        const int cg = it % (DFF / 8), tr = it / (DFF / 8); const int c0 = cg * 8, tl0 = tr * 16;
        const int tseq0 = (half * MH + tl0) % SEQ;
        float wg[3][8], wv[3][8], bg[8], bv[8];
#pragma unroll
        for (int e = 0; e < 8; ++e) { bg[e] = cb[c0 + e]; bv[e] = cb[DFF + c0 + e];
#pragma unroll
            for (int k = 0; k < 3; ++k) { wg[k][e] = cw[k * DFF2 + c0 + e]; wv[k][e] = cw[k * DFF2 + DFF + c0 + e]; } }
        u32x4 g0 = (u32x4){0, 0, 0, 0}, g1 = g0, v0 = g0, v1 = g0;
        if (tseq0 >= 2) { g0 = *(const u32x4*)(UP + (size_t)(tl0 - 2) * DFF2 + c0); v0 = *(const u32x4*)(UP + (size_t)(tl0 - 2) * DFF2 + DFF + c0); }
        if (tseq0 >= 1) { g1 = *(const u32x4*)(UP + (size_t)(tl0 - 1) * DFF2 + c0); v1 = *(const u32x4*)(UP + (size_t)(tl0 - 1) * DFF2 + DFF + c0); }
#pragma unroll 4
        for (int r = 0; r < 16; ++r) {
            const u32x4 g2 = *(const u32x4*)(UP + (size_t)(tl0 + r) * DFF2 + c0), v2 = *(const u32x4*)(UP + (size_t)(tl0 + r) * DFF2 + DFF + c0);
            u32x4 o;
#pragma unroll
            for (int jj = 0; jj < 4; ++jj) {
                const float ga = bg[2 * jj] + wg[0][2 * jj] * bflo(g0[jj]) + wg[1][2 * jj] * bflo(g1[jj]) + wg[2][2 * jj] * bflo(g2[jj]);
                const float gb = bg[2 * jj + 1] + wg[0][2 * jj + 1] * bfhi(g0[jj]) + wg[1][2 * jj + 1] * bfhi(g1[jj]) + wg[2][2 * jj + 1] * bfhi(g2[jj]);
                const float va = bv[2 * jj] + wv[0][2 * jj] * bflo(v0[jj]) + wv[1][2 * jj] * bflo(v1[jj]) + wv[2][2 * jj] * bflo(v2[jj]);
                const float vb = bv[2 * jj + 1] + wv[0][2 * jj + 1] * bfhi(v0[jj]) + wv[1][2 * jj + 1] * bfhi(v1[jj]) + wv[2][2 * jj + 1] * bfhi(v2[jj]);
                o[jj] = pk2(gelu_tanh(ga) * va, gelu_tanh(gb) * vb); }
            *(u32x4*)(ACT + (size_t)(tl0 + r) * DFF + c0) = o;
            g0 = g1; g1 = g2; v0 = v1; v1 = v2;
        }
    }
}
constexpr int LDS_BYTES = 136 * 1024;
__global__ void __launch_bounds__(NTH, 2) mk_fwd(Args a) {
    extern __shared__ __attribute__((aligned(16))) unsigned char lds_raw[];
    LAS unsigned char* lds = (LAS unsigned char*)lds_raw;
    cg::grid_group grid = cg::this_grid();
    const int G = gridDim.x, bid = blockIdx.x;
    float* mod = (float*)(a.ws + WS_MOD);
    bf16_t* XN = (bf16_t*)(a.ws + WS_XN); bf16_t* P = (bf16_t*)(a.ws + WS_P);
    p0_mod(a, lds);
    p0_weights(a, lds);
    grid.sync();
    for (int l = 0; l < NL; ++l) {
        const float* modl = mod + (size_t)l * NB * 6144;
        const bf16_t* wl = (const bf16_t*)(a.ws + WS_W) + (size_t)l * W_LAYER_E;
        const float* xin = l == 0 ? a.in[0] : a.out;
        norm_phase(xin, a.in[4] + l * DM, modl, 0, 1, XN);
        grid.sync();
        { pg8::Gemm g{XN, wl + (size_t)4096 * DM, MTOK, 3072, DM}; pg8::StaticOrder S; S.init(MTOK, 3072, G, bid);
          EpiSplit E{P, (size_t)MTOK * DM, 0x0000}; pg8::gemm_phase<EpiSplit, pg8::StaticOrder, true, true>(lds, g, S, E); }
        grid.sync();
        attn_phase(a, l, lds);
        grid.sync();
        { pg8::Gemm g{XN, wl, MTOK, 4096, DM}; pg8::StaticOrder S; S.init(MTOK, 4096, G, bid);
          EpiSplit E{P + (size_t)MTOK * DM, (size_t)MTOK * DM, 0x2210}; pg8::gemm_phase<EpiSplit, pg8::StaticOrder, true, true>(lds, g, S, E); }
        grid.sync();
        rnn_phase<false>(a, l, lds);
        grid.sync();
        carry_phase(a);
        grid.sync();
        rnn_phase<true>(a, l, lds);
        grid.sync();
        { pg8::Gemm g{P + (size_t)4 * MTOK * DM, wl + W_IN_E, MTOK, DM, DM}; pg8::StaticOrder S; S.init(MTOK, DM, G, bid);
          EpiRes E{xin, a.out, modl + 2 * 1024, 0}; pg8::gemm_phase<EpiRes, pg8::StaticOrder, true, true>(lds, g, S, E); }
        grid.sync();
        norm_phase(a.out, a.in[16] + l * DM, modl, 3, 4, XN);
        grid.sync();
        for (int half = 0; half < 2; ++half) {
            { pg8::Gemm g{XN + (size_t)half * MH * DM, wl + W_IN_E + W_OUT_E, MH, DFF2, DM}; pg8::StaticOrder S; S.init(MH, DFF2, G, bid);
              EpiPlain E{P, DFF2}; pg8::gemm_phase<EpiPlain, pg8::StaticOrder, true, true>(lds, g, S, E); }
            grid.sync();
            ffnconv_phase(a, l, half);
            grid.sync();
            { pg8::Gemm g{(const bf16_t*)(a.ws + WS_P + UPH_BYTES), wl + W_IN_E + W_OUT_E + W_UP_E, MH, DM, DFF}; pg8::StaticOrder S; S.init(MH, DM, G, bid);
              EpiRes E{a.out, a.out, modl + 5 * 1024, half * MH}; pg8::gemm_phase<EpiRes, pg8::StaticOrder, true, true>(lds, g, S, E); }
            grid.sync();
        }
    }
}
extern "C" void kernel_launch(void* const* d_in, const int* in_sizes, int n_in, void* d_out, int out_size, void* d_ws, size_t ws_size, hipStream_t stream) {
    static int grid = 0;
    if (!grid) {
        int dev = 0, cus = 0, per_cu = 0;
        (void)hipGetDevice(&dev);
        (void)hipDeviceGetAttribute(&cus, hipDeviceAttributeMultiprocessorCount, dev);
        (void)hipFuncSetAttribute((const void*)mk_fwd, hipFuncAttributeMaxDynamicSharedMemorySize, LDS_BYTES);
        (void)hipOccupancyMaxActiveBlocksPerMultiprocessor(&per_cu, (const void*)mk_fwd, NTH, LDS_BYTES);
        if (per_cu < 1) per_cu = 1;
        grid = cus * per_cu;
        if (ws_size < WS_END) { fprintf(stderr, "kernel_launch: workspace too small: %zu < %zu\n", ws_size, (size_t)WS_END); grid = -1; }
        if (n_in != 21 || out_size != MTOK * DM) { fprintf(stderr, "kernel_launch: unexpected shapes\n"); grid = -1; }
    }
    if (grid < 0) return;
    Args a{};
    for (int i = 0; i < 21; ++i) a.in[i] = (const float*)d_in[i];
    a.out = (float*)d_out; a.ws = (unsigned char*)d_ws;
    void* args[] = {&a};
    hipError_t e = hipLaunchCooperativeKernel((const void*)mk_fwd, dim3(grid), dim3(NTH), args, LDS_BYTES, stream);
    if (e != hipSuccess) fprintf(stderr, "cooperative launch failed: %s (grid %d)\n", hipGetErrorString(e), grid);
}
```

```cpp
#include <hip/hip_runtime.h>
#include <hip/hip_cooperative_groups.h>
#include <cstdio>
#include <cstdint>
namespace cg = cooperative_groups;
__device__ __forceinline__ int opaque_tid() { int t = threadIdx.x; asm volatile("" : "+v"(t)); return t; }
__device__ __forceinline__ int opaque_bid() { int t = blockIdx.x; asm volatile("" : "+s"(t)); return t; }
namespace pg8 {
#define PG8_LAS __attribute__((address_space(3)))
typedef unsigned short bf16_t;
typedef short bf16x8 __attribute__((ext_vector_type(8)));
typedef float f32x4 __attribute__((ext_vector_type(4)));
typedef unsigned u32x4 __attribute__((ext_vector_type(4)));
constexpr int BM = 256, BK = 64, HALF = 128, HTB = HALF * BK * 2  , STAGE_BYTES = 8 * HTB, NXCD = 8, WGM = 8;

__host__ __device__ __forceinline__ int lds_byte(int r, int c) { const int st = (r >> 4) * 2 + (c >> 5), rr = r & 15, cc = c & 31, ob = rr * 64 + cc * 2; return st * 1024 + (ob ^ (((ob >> 9) & 1) << 5)); }
__host__ __device__ __forceinline__ void stage_rc(int b, int& R, int& C) { const int st = b / 1024, sb = b % 1024, swz = sb ^ (((sb >> 9) & 1) << 5); R = (st >> 1) * 16 + swz / 64; C = (st & 1) * 32 + (swz % 64) / 2; }
__host__ __device__ __forceinline__ int perm32(int rho) { const int n = rho >> 4, i = rho & 15; return 8 * (i >> 2) + 4 * n + (i & 3); }

struct Unit { int pm, pn; };
struct Gemm { const bf16_t* A; const bf16_t* Bt; int M, N, K; };

struct StaticOrder {
    int nM, nN, nwg, G, c;
    __host__ __device__ void init(int M, int N, int G_, int c_) { nM = M / BM; nN = N / BM; nwg = nM * nN; G = G_; c = c_; }
    __host__ __device__ bool next(int i, Unit& u) const {
        const long L = (long)i * G + c; if (L >= nwg) return false;
        int wgid = (int)L; { const int q = nwg / NXCD, r = nwg % NXCD, xcd = wgid % NXCD, off = wgid / NXCD; wgid = (xcd < r ? xcd * (q + 1) : r * (q + 1) + (xcd - r) * q) + off; }
        const int nig = WGM * nN, gid = wgid / nig, fm = gid * WGM, gsz = (nM - fm) < WGM ? (nM - fm) : WGM;
        u.pm = fm + ((wgid % nig) % gsz); u.pn = (wgid % nig) / gsz; return true;
    }
    __device__ __forceinline__ void a_ready(const Unit&) const {}
    __device__ __forceinline__ void done(const Unit&) const {}
};

template <class Epi, class Sched, bool ALIGN_EPI = false, bool SP2 = false>
__device__ __forceinline__ void gemm_phase(PG8_LAS unsigned char* lds, const Gemm g, const Sched& S, const Epi& E) {
    const int tid = opaque_tid(), wid = __builtin_amdgcn_readfirstlane(tid >> 6), lane = tid & 63, wr = wid >> 2, wc = wid & 3, fr = lane & 15, fq = lane >> 4;
    const int K = g.K, nt = K / BK;
    unsigned voffA[2], voffB[2];
#pragma unroll
    for (int i = 0; i < 2; ++i) { int R, C; stage_rc(tid * 16 + i * 8192, R, C); const int Rb = Epi::PERM ? ((R & ~31) + perm32(R & 31)) : R;
        voffA[i] = (unsigned)(R * K + C) * 2u; voffB[i] = (unsigned)(Rb * K + C) * 2u; }
    const size_t kstep = (size_t)(BK * 2);
    const size_t hstep = (size_t)HALF * K * 2;
    const size_t tstep = 2 * hstep;
    const unsigned ldsw = (unsigned)wid * 1024u;
    const int aoff = lds_byte(wr * 64 + fr, fq * 8), boff = lds_byte(wc * 32 + fr, fq * 8);
#define PG8_SA(b, h) (((b) * 2 + (h)) * HTB)
#define PG8_SB(b, h) ((4 + (b) * 2 + (h)) * HTB)
#define PG8_STAGE(bufoff, gbase, voff) do { _Pragma("unroll") for (int _i = 0; _i < 2; ++_i) \
        __builtin_amdgcn_global_load_lds((const unsigned*)((const char*)(gbase) + (voff)[_i]), (PG8_LAS unsigned*)(lds + (bufoff) + ldsw + _i * 8192), 16, 0, 0); } while (0)
#define PG8_LDA(dst, b, h) do { _Pragma("unroll") for (int m = 0; m < 4; ++m) _Pragma("unroll") for (int k = 0; k < 2; ++k) dst[m][k] = *(const PG8_LAS bf16x8*)(lds + PG8_SA(b, h) + aoff + m * 2048 + k * 1024); } while (0)
#define PG8_LDB(dst, b, h) do { _Pragma("unroll") for (int n = 0; n < 2; ++n) _Pragma("unroll") for (int k = 0; k < 2; ++k) dst[n][k] = *(const PG8_LAS bf16x8*)(lds + PG8_SB(b, h) + boff + n * 2048 + k * 1024); } while (0)
#define PG8_MMA(ai, bj, At, Bt) do { __builtin_amdgcn_s_setprio(1); _Pragma("unroll") for (int m = 0; m < 4; ++m) _Pragma("unroll") for (int n = 0; n < 2; ++n) _Pragma("unroll") for (int k = 0; k < 2; ++k) \
        acc[ai][bj][m][n] = __builtin_amdgcn_mfma_f32_16x16x32_bf16(Bt[n][k], At[m][k], acc[ai][bj][m][n], 0, 0, 0); __builtin_amdgcn_s_setprio(0); } while (0)
#define PG8_WAIT_V(n) asm volatile("s_waitcnt vmcnt(" #n ")" ::: "memory")
#define PG8_WAIT_L(n) asm volatile("s_waitcnt lgkmcnt(" #n ")" ::: "memory")
#define PG8_BAR __builtin_amdgcn_s_barrier()
#define PG8_SCHED __builtin_amdgcn_sched_barrier(0)
    Unit cur, nxt; int ui = 0;
    if (!S.next(0, cur)) return;
    f32x4 acc[2][2][4][2];
#pragma unroll
    for (int a = 0; a < 2; ++a)
#pragma unroll
        for (int b = 0; b < 2; ++b)
#pragma unroll
            for (int m = 0; m < 4; ++m)
#pragma unroll
                for (int n = 0; n < 2; ++n) acc[a][b][m][n] = (f32x4){0.f, 0.f, 0.f, 0.f};
    bf16x8 At[4][2], B0[2][2], B1[2][2];
    const char* cA = (const char*)g.A + (size_t)cur.pm * tstep; const char* cB = (const char*)g.Bt + (size_t)cur.pn * tstep;
    S.a_ready(cur);
    if constexpr (SP2) {
        PG8_STAGE(PG8_SB(0, 0), cB, voffB); PG8_STAGE(PG8_SB(0, 1), cB + hstep, voffB); PG8_STAGE(PG8_SA(0, 0), cA, voffA); PG8_STAGE(PG8_SA(0, 1), cA + hstep, voffA);
        if (wr == 1) PG8_BAR;
        PG8_WAIT_V(2); PG8_BAR;
        PG8_STAGE(PG8_SB(1, 0), cB + kstep, voffB); PG8_STAGE(PG8_SA(1, 0), cA + kstep, voffA); PG8_STAGE(PG8_SB(1, 1), cB + hstep + kstep, voffB);
        PG8_WAIT_V(6); PG8_BAR;
    } else {
        PG8_STAGE(PG8_SB(0, 0), cB, voffB); PG8_STAGE(PG8_SA(0, 0), cA, voffA); PG8_STAGE(PG8_SB(0, 1), cB + hstep, voffB); PG8_STAGE(PG8_SA(0, 1), cA + hstep, voffA);
        if (wr == 1) PG8_BAR;
        PG8_WAIT_V(4); PG8_BAR;
        PG8_STAGE(PG8_SB(1, 0), cB + kstep, voffB); PG8_STAGE(PG8_SA(1, 0), cA + kstep, voffA); PG8_STAGE(PG8_SB(1, 1), cB + hstep + kstep, voffB);
        PG8_WAIT_V(6); PG8_BAR;
    }
    for (;;) {
        const bool has_next = S.next(ui + 1, nxt);
        const char* nA = has_next ? (const char*)g.A + (size_t)nxt.pm * tstep : cA; const char* nB = has_next ? (const char*)g.Bt + (size_t)nxt.pn * tstep : cB;
        for (int t = 0; t < nt; t += 2) {
            const bool last = (t == nt - 2);
            const char* a1 = cA + (size_t)(t + 1) * kstep;
            const char* a2 = last ? nA : cA + (size_t)(t + 2) * kstep; const char* b2 = last ? nB : cB + (size_t)(t + 2) * kstep;
            const char* a3 = a2 + kstep; const char* b3 = b2 + kstep;
            if (last && has_next) S.a_ready(nxt);
            if constexpr (SP2) {
            PG8_LDB(B0, 0, 0); PG8_LDB(B1, 0, 1); PG8_SCHED; PG8_LDA(At, 0, 0); PG8_STAGE(PG8_SA(1, 1), a1 + hstep, voffA);
            PG8_WAIT_V(8); PG8_WAIT_L(0); PG8_BAR; PG8_MMA(0, 0, At, B0); PG8_MMA(0, 1, At, B1); PG8_BAR; PG8_SCHED;
            PG8_LDA(At, 0, 1); PG8_STAGE(PG8_SB(0, 0), b2, voffB); PG8_STAGE(PG8_SB(0, 1), b2 + hstep, voffB); PG8_STAGE(PG8_SA(0, 0), a2, voffA);
            PG8_WAIT_V(8); PG8_WAIT_L(0); PG8_BAR; PG8_MMA(1, 0, At, B0); PG8_MMA(1, 1, At, B1); PG8_BAR; PG8_SCHED;
            PG8_LDB(B0, 1, 0); PG8_LDB(B1, 1, 1); PG8_SCHED; PG8_LDA(At, 1, 0); PG8_STAGE(PG8_SA(0, 1), a2 + hstep, voffA);
            PG8_WAIT_V(8); PG8_WAIT_L(0); PG8_BAR; PG8_MMA(0, 0, At, B0); PG8_MMA(0, 1, At, B1); PG8_BAR; PG8_SCHED;
            PG8_LDA(At, 1, 1); PG8_STAGE(PG8_SB(1, 0), b3, voffB); PG8_STAGE(PG8_SB(1, 1), b3 + hstep, voffB); PG8_STAGE(PG8_SA(1, 0), a3, voffA);
            PG8_WAIT_V(8); PG8_WAIT_L(0); PG8_BAR; PG8_MMA(1, 0, At, B0); PG8_MMA(1, 1, At, B1); PG8_BAR; PG8_SCHED;
            } else {
            PG8_LDB(B0, 0, 0); PG8_SCHED; PG8_LDA(At, 0, 0); PG8_STAGE(PG8_SA(1, 1), a1 + hstep, voffA);
            PG8_WAIT_L(8); PG8_BAR; PG8_WAIT_L(0); PG8_MMA(0, 0, At, B0); PG8_BAR; PG8_SCHED;
            PG8_LDB(B1, 0, 1); PG8_STAGE(PG8_SB(0, 0), b2, voffB);
            PG8_BAR; PG8_WAIT_L(0); PG8_MMA(0, 1, At, B1); PG8_BAR;
            PG8_LDA(At, 0, 1); PG8_STAGE(PG8_SA(0, 0), a2, voffA);
            PG8_BAR; PG8_WAIT_L(0); PG8_MMA(1, 0, At, B0); PG8_BAR; PG8_SCHED;
            PG8_STAGE(PG8_SB(0, 1), b2 + hstep, voffB);
            PG8_WAIT_V(6); PG8_BAR; PG8_MMA(1, 1, At, B1); PG8_BAR;
            PG8_LDB(B0, 1, 0); PG8_SCHED; PG8_LDA(At, 1, 0); PG8_STAGE(PG8_SA(0, 1), a2 + hstep, voffA);
            PG8_WAIT_L(8); PG8_BAR; PG8_WAIT_L(0); PG8_MMA(0, 0, At, B0); PG8_BAR; PG8_SCHED;
            PG8_LDB(B1, 1, 1); PG8_STAGE(PG8_SB(1, 0), b3, voffB);
            PG8_BAR; PG8_WAIT_L(0); PG8_MMA(0, 1, At, B1); PG8_BAR;
            PG8_LDA(At, 1, 1); PG8_STAGE(PG8_SA(1, 0), a3, voffA);
            PG8_BAR; PG8_WAIT_L(0); PG8_MMA(1, 0, At, B0); PG8_BAR; PG8_SCHED;
            PG8_STAGE(PG8_SB(1, 1), b3 + hstep, voffB);
            PG8_WAIT_V(6); PG8_BAR; PG8_MMA(1, 1, At, B1); PG8_BAR;
            }
        }
        if constexpr (ALIGN_EPI) { if (wr == 0) PG8_BAR; }
        if constexpr (!Epi::AFTER_DRAIN) { E(acc, cur, wr, wc, fr, fq); S.done(cur); }
        if (!has_next) break;
#pragma unroll
        for (int a = 0; a < 2; ++a)
#pragma unroll
            for (int b = 0; b < 2; ++b)
#pragma unroll
                for (int m = 0; m < 4; ++m)
#pragma unroll
                    for (int n = 0; n < 2; ++n) acc[a][b][m][n] = (f32x4){0.f, 0.f, 0.f, 0.f};
        cur = nxt; cA = nA; cB = nB; ++ui;
        if constexpr (ALIGN_EPI) { if (wr == 1) PG8_BAR; }
    }
    PG8_WAIT_V(0);
    if constexpr (!ALIGN_EPI) { if (wr == 0) PG8_BAR; }
    PG8_BAR;
    if constexpr (Epi::AFTER_DRAIN) { E.fused(acc, cur, wr, wc, fr, fq, lds, wid, lane); S.done(cur); }
#undef PG8_SA
#undef PG8_SB
#undef PG8_STAGE
#undef PG8_LDA
#undef PG8_LDB
#undef PG8_MMA
#undef PG8_WAIT_V
#undef PG8_WAIT_L
#undef PG8_BAR
#undef PG8_SCHED
}
}
typedef pg8::bf16_t bf16_t;
typedef pg8::bf16x8 bf16x8;
typedef pg8::f32x4 f32x4;
typedef pg8::u32x4 u32x4;
typedef unsigned u32x2 __attribute__((ext_vector_type(2)));
#define LAS __attribute__((address_space(3)))

constexpr int DM = 1024, NB = 4, SEQ = 8192, MTOK = NB * SEQ, DIN = 7168, DFF = 3072, DFF2 = 6144, NL = 2;
constexpr int NTH = 512;
constexpr float EPS = 1e-6f;
constexpr int RT = 128, NT = SEQ / RT;
constexpr size_t WS_BAR = 0;
constexpr size_t WS_MOD = 16384;
constexpr size_t WS_GW = WS_MOD + (size_t)NL * NB * 6144 * 4;
constexpr size_t WS_SUM = WS_GW + (size_t)NL * 2 * 8 * 128 * 128 * 2;
constexpr size_t WS_HIN = WS_SUM + (size_t)NB * NT * 1024 * 2 * 4;
constexpr size_t WS_W = (WS_HIN + (size_t)NB * NT * 1024 * 4 + 4095) / 4096 * 4096;
constexpr size_t W_IN_E = (size_t)DIN * DM, W_OUT_E = (size_t)DM * DM, W_UP_E = (size_t)DFF2 * DM, W_DN_E = (size_t)DM * DFF, W_LAYER_E = W_IN_E + W_OUT_E + W_UP_E + W_DN_E;
constexpr size_t WS_XN = WS_W + NL * W_LAYER_E * 2;
constexpr size_t PBUF = (size_t)MTOK * DM * 2;
constexpr size_t WS_P = WS_XN + PBUF;
constexpr size_t WS_END = WS_P + 5 * PBUF;
constexpr int MH = MTOK / 2;
constexpr size_t UPH_BYTES = (size_t)MH * DFF2 * 2;

__device__ __forceinline__ float bf2f(bf16_t b) { return __uint_as_float(((unsigned)b) << 16); }
__device__ __forceinline__ unsigned pk2(float lo, float hi) { unsigned r; asm volatile("v_cvt_pk_bf16_f32 %0, %1, %2" : "=v"(r) : "v"(lo), "v"(hi)); return r; }
__device__ __forceinline__ float bflo(unsigned w) { return __uint_as_float(w << 16); }
__device__ __forceinline__ float bfhi(unsigned w) { return __uint_as_float(w & 0xffff0000u); }
__device__ __forceinline__ float sigmoidf_(float x) { return __builtin_amdgcn_rcpf(1.0f + __expf(-x)); }
__device__ __forceinline__ float gelu_tanh(float x) { const float u = 1.5957691216057308f * (x + 0.044715f * x * x * x); return x * sigmoidf_(u); }

struct EpiSplit {
    static constexpr bool PERM = true, AFTER_DRAIN = false;
    bf16_t* base; size_t tstride; int modes; int skip3;
    __device__ __forceinline__ void operator()(const f32x4 (&acc)[2][2][4][2], const pg8::Unit& u, int wr, int wc, int fr, int fq) const {
        const int colt = u.pn * 256, t = colt >> 10; const int mode = (modes >> (4 * t)) & 15;
        bf16_t* o = base + (size_t)(t + ((skip3 && t == 3) ? 1 : 0)) * tstride; const int col0 = (colt & 1023) + wc * 32 + 8 * fq; const int row0 = u.pm * 256 + wr * 64 + fr;
#pragma unroll
        for (int ai = 0; ai < 2; ++ai)
#pragma unroll
            for (int m = 0; m < 4; ++m) { bf16_t* rowp = o + (size_t)(row0 + ai * 128 + m * 16) * DM + col0;
#pragma unroll
                for (int bj = 0; bj < 2; ++bj) { f32x4 v0 = acc[ai][bj][m][0], v1 = acc[ai][bj][m][1];
                    if (mode == 1) {
#pragma unroll
                        for (int j = 0; j < 4; ++j) { v0[j] = gelu_tanh(v0[j]); v1[j] = gelu_tanh(v1[j]); } }
                    else if (mode == 2) {
#pragma unroll
                        for (int j = 0; j < 4; ++j) { v0[j] = sigmoidf_(v0[j]); v1[j] = sigmoidf_(v1[j]); } }
                    u32x4 w; w.x = pk2(v0[0], v0[1]); w.y = pk2(v0[2], v0[3]); w.z = pk2(v1[0], v1[1]); w.w = pk2(v1[2], v1[3]);
                    *(u32x4*)(rowp + bj * 128) = w; } }
    }
};
struct EpiPlain {
    static constexpr bool PERM = true, AFTER_DRAIN = false;
    bf16_t* o; int ldc;
    __device__ __forceinline__ void operator()(const f32x4 (&acc)[2][2][4][2], const pg8::Unit& u, int wr, int wc, int fr, int fq) const {
        const int col0 = u.pn * 256 + wc * 32 + 8 * fq; const int row0 = u.pm * 256 + wr * 64 + fr;
#pragma unroll
        for (int ai = 0; ai < 2; ++ai)
#pragma unroll
            for (int m = 0; m < 4; ++m) { bf16_t* rowp = o + (size_t)(row0 + ai * 128 + m * 16) * ldc + col0;
#pragma unroll
                for (int bj = 0; bj < 2; ++bj) { const f32x4 v0 = acc[ai][bj][m][0], v1 = acc[ai][bj][m][1];
                    u32x4 w; w.x = pk2(v0[0], v0[1]); w.y = pk2(v0[2], v0[3]); w.z = pk2(v1[0], v1[1]); w.w = pk2(v1[2], v1[3]);
                    *(u32x4*)(rowp + bj * 128) = w; } }
    }
};
struct EpiRes {
    static constexpr bool PERM = false, AFTER_DRAIN = false;
    const float* res; float* out; const float* gate  ; int row_off;
    __device__ __forceinline__ void operator()(const f32x4 (&acc)[2][2][4][2], const pg8::Unit& u, int wr, int wc, int fr, int fq) const {
        const int grow0 = row_off + u.pm * 256; const int b = grow0 / SEQ; const int row0 = grow0 + wr * 64 + fr, col0 = u.pn * 256 + wc * 32 + 4 * fq;
        f32x4 gv[2][2];
#pragma unroll
        for (int bj = 0; bj < 2; ++bj)
#pragma unroll
            for (int n = 0; n < 2; ++n) gv[bj][n] = *(const f32x4*)(gate + (size_t)b * 6144 + col0 + bj * 128 + n * 16);
#pragma unroll
        for (int ai = 0; ai < 2; ++ai)
#pragma unroll
            for (int m = 0; m < 4; ++m) { const size_t off = (size_t)(row0 + ai * 128 + m * 16) * DM + col0;
#pragma unroll
                for (int bj = 0; bj < 2; ++bj)
#pragma unroll
                    for (int n = 0; n < 2; ++n) { const f32x4 r = *(const f32x4*)(res + off + bj * 128 + n * 16); *(f32x4*)(out + off + bj * 128 + n * 16) = r + gv[bj][n] * acc[ai][bj][m][n]; }
                asm volatile("" ::: "memory"); }
    }
};


#define XB_TMO      128
#define XB_XCNT(j)  (256  + 64 * (j))
#define XB_XSUB(j)  (1280 + 64 * (j))
#define XB_XGEN(j)  (2304 + 64 * (j))
#define XB_TOP      3328
#define XB_TOPGEN   3392
#define XCD_BAR_WORDS 3456
#define XB_SPIN_CAP (1u << 22)
__device__ __forceinline__ unsigned xb_ld(unsigned* p)              { return __hip_atomic_load(p, __ATOMIC_RELAXED, __HIP_MEMORY_SCOPE_AGENT); }
__device__ __forceinline__ unsigned xb_add(unsigned* p, unsigned v) { return __hip_atomic_fetch_add(p, v, __ATOMIC_RELAXED, __HIP_MEMORY_SCOPE_AGENT); }
__device__ __forceinline__ unsigned xb_xcc_id() { return (unsigned)__builtin_amdgcn_s_getreg((3 << 11) | 20) & 0xFu; }
#define XB_SPIN(cond, bar) do { unsigned _sp = 0; while (cond) { __builtin_amdgcn_s_sleep(1); \
    if ((++_sp & 255u) == 0u) { if (xb_ld(&(bar)[XB_TMO])) break; if (_sp > XB_SPIN_CAP) { atomicAdd(&(bar)[XB_TMO], 1u); break; } } } } while (0)
struct XcdBarrier { unsigned* bar; unsigned x; volatile LAS unsigned* st; };
__device__ __forceinline__ XcdBarrier xcd_barrier_post(unsigned* bar, volatile LAS unsigned* st) {
    XcdBarrier b; b.bar = bar; b.x = xb_xcc_id(); b.st = st;
    if (threadIdx.x == 0) (void)xb_add(&bar[XB_XCNT(b.x)], 1u);
    return b;
}
__device__ __forceinline__ void xcd_barrier_complete(unsigned* bar, unsigned x, unsigned& nloc, unsigned& nx) {
    const unsigned G = gridDim.x * gridDim.y * gridDim.z;
    unsigned sum, cnt, mine, sp = 0u;
    for (;;) {
        sum = 0u; cnt = 0u; mine = 0u;
#pragma unroll
        for (unsigned j = 0; j < 16; ++j) { const unsigned c = xb_ld(&bar[XB_XCNT(j)]); sum += c; cnt += (c > 0u) ? 1u : 0u; mine = (j == x) ? c : mine; }
        if (sum == G) break;
        __builtin_amdgcn_s_sleep(1);
        if ((++sp & 255u) == 0u) { if (xb_ld(&bar[XB_TMO])) break; if (sp > XB_SPIN_CAP) { atomicAdd(&bar[XB_TMO], 1u); break; } }
    }
    nloc = mine > 0u ? mine : 1u; nx = cnt > 0u ? cnt : 1u;
}
__device__ __forceinline__ void xcd_barrier(const XcdBarrier& b) {
    asm volatile("s_waitcnt vmcnt(0)" ::: "memory");
    __syncthreads();
    if (threadIdx.x == 0) {
        unsigned* bar = b.bar;
        __builtin_amdgcn_s_waitcnt(0);
        unsigned nloc = b.st[0], nx = b.st[1];
        if (nloc == 0u) { xcd_barrier_complete(bar, b.x, nloc, nx); b.st[0] = nloc; b.st[1] = nx; }
        const unsigned old = xb_add(&bar[XB_XSUB(b.x)], 1u);
        const unsigned gen = old / nloc;
        if (old + 1u == (gen + 1u) * nloc) {
            __builtin_amdgcn_fence(__ATOMIC_RELEASE, "agent");
            asm volatile("s_waitcnt vmcnt(0)" ::: "memory");
            const unsigned og = xb_add(&bar[XB_TOP], 1u);
            const unsigned tg = og / nx;
            if (og + 1u == (tg + 1u) * nx) xb_add(&bar[XB_TOPGEN], 1u);
            else XB_SPIN(xb_ld(&bar[XB_TOPGEN]) == tg, bar);
            __builtin_amdgcn_fence(__ATOMIC_ACQUIRE, "agent");
            xb_add(&bar[XB_XGEN(b.x)], 1u);
            asm volatile("s_waitcnt vmcnt(0)" ::: "memory");
        } else {
            XB_SPIN(xb_ld(&bar[XB_XGEN(b.x)]) == gen, bar);
            __builtin_amdgcn_fence(__ATOMIC_ACQUIRE, "agent");
            asm volatile("s_waitcnt vmcnt(0)" ::: "memory");
        }
    }
    __syncthreads();
}

struct Args { const float* in[21]; float* out; unsigned char* ws; };

__device__ void p0_mod(const Args& a, LAS unsigned char* lds) {
    const int tid = opaque_tid(), w = tid >> 6, lane = tid & 63;
    const float* c = a.in[1]; const float* aw = a.in[2]; const float* ab = a.in[3]; float* mod = (float*)(a.ws + WS_MOD);
    LAS float* red = (LAS float*)lds;
    for (int grp = blockIdx.x; grp < NL * 6144 / 48; grp += gridDim.x) {
        const int gl = grp * 48 + (lane < 48 ? lane : 47), l = gl / 6144, j = gl % 6144;
        const float* wp = aw + (size_t)l * DM * 6144 + j;
        float s0 = 0.f, s1 = 0.f, s2 = 0.f, s3 = 0.f;
#pragma unroll 16
        for (int k = w * 128; k < w * 128 + 128; ++k) { const float wv = wp[(size_t)k * 6144]; s0 += c[k] * wv; s1 += c[DM + k] * wv; s2 += c[2 * DM + k] * wv; s3 += c[3 * DM + k] * wv; }
        red[(w * 4 + 0) * 64 + lane] = s0; red[(w * 4 + 1) * 64 + lane] = s1; red[(w * 4 + 2) * 64 + lane] = s2; red[(w * 4 + 3) * 64 + lane] = s3;
        __syncthreads();
        if (tid < 256 && lane < 48) { const int b = tid >> 6; float s = ab[(size_t)l * 6144 + j];
#pragma unroll
            for (int ww = 0; ww < 8; ++ww) s += red[(ww * 4 + b) * 64 + lane];
            mod[((size_t)l * NB + b) * 6144 + j] = s; }
        __syncthreads();
    }
    bf16_t* gw = (bf16_t*)(a.ws + WS_GW);
    for (size_t idx = (size_t)blockIdx.x * NTH + tid; idx < (size_t)NL * 2 * 8 * 128 * 128; idx += (size_t)gridDim.x * NTH) {
        const int i = idx & 127, j = (idx >> 7) & 127, h = (idx >> 14) & 7, mat = (idx >> 17) & 1, l = (int)(idx >> 18);
        const float* src = a.in[mat ? 10 : 8];
        const float v = src[(((size_t)l * 8 + h) * 128 + i) * 128 + j];
        gw[idx] = (bf16_t)(pk2(v, v) & 0xffff);
    }
}
struct TMat { const float* W; bf16_t* Wt; int K, N, rmode, ntn; };
__device__ __forceinline__ TMat tmat_of(const Args& a, int mi) {
    const int l = mi >> 2, k = mi & 3; bf16_t* wl = (bf16_t*)(a.ws + WS_W) + (size_t)l * W_LAYER_E; TMat m;
    if (k == 0) { m.W = a.in[5] + (size_t)l * DM * DIN; m.Wt = wl; m.K = DM; m.N = DIN; m.rmode = 1; }
    else if (k == 1) { m.W = a.in[15] + (size_t)l * DM * DM; m.Wt = wl + W_IN_E; m.K = DM; m.N = DM; m.rmode = 0; }
    else if (k == 2) { m.W = a.in[17] + (size_t)l * DM * DFF2; m.Wt = wl + W_IN_E + W_OUT_E; m.K = DM; m.N = DFF2; m.rmode = 0; }
    else { m.W = a.in[20] + (size_t)l * DFF * DM; m.Wt = wl + W_IN_E + W_OUT_E + W_UP_E; m.K = DFF; m.N = DM; m.rmode = 0; }
    m.ntn = m.N / 64; return m;
}
constexpr int TILES_IN = (DM / 64) * (DIN / 64), TILES_OUT = (DM / 64) * (DM / 64), TILES_UP = (DM / 64) * (DFF2 / 64), TILES_DN = (DFF / 64) * (DM / 64), TILES_L = TILES_IN + TILES_OUT + TILES_UP + TILES_DN;
__device__ __forceinline__ void tile_of(int g, int& mi, int& tile) {
    const int l = g / TILES_L; int r = g - l * TILES_L; int k = 0;
    if (r >= TILES_IN) { r -= TILES_IN; k = 1; if (r >= TILES_OUT) { r -= TILES_OUT; k = 2; if (r >= TILES_UP) { r -= TILES_UP; k = 3; } } }
    mi = l * 4 + k; tile = r;
}
__device__ void p0_weights(const Args& a, LAS unsigned char* lds) {
    LAS float* t = (LAS float*)lds;
    const int tid = opaque_tid(); const int G = gridDim.x;
    int g = blockIdx.x; if (g >= NL * TILES_L) return;
    int mi, tile; tile_of(g, mi, tile); TMat m = tmat_of(a, mi);
    f32x4 v0, v1;
    { const int k0 = (tile / m.ntn) * 64, n0 = (tile % m.ntn) * 64; const float* p = m.W + (size_t)(k0 + (tid >> 4)) * m.N + n0 + (tid & 15) * 4; v0 = *(const f32x4*)p; v1 = *(const f32x4*)(p + (size_t)32 * m.N); }
    for (;;) {
        const int k0 = (tile / m.ntn) * 64, n0 = (tile % m.ntn) * 64; const TMat cm = m;
        { const int k = tid >> 4, n = (tid & 15) * 4;
          t[k * 65 + n] = v0[0]; t[k * 65 + n + 1] = v0[1]; t[k * 65 + n + 2] = v0[2]; t[k * 65 + n + 3] = v0[3];
          t[(k + 32) * 65 + n] = v1[0]; t[(k + 32) * 65 + n + 1] = v1[1]; t[(k + 32) * 65 + n + 2] = v1[2]; t[(k + 32) * 65 + n + 3] = v1[3]; }
        g += G; const bool more = g < NL * TILES_L;
        if (more) { tile_of(g, mi, tile); m = tmat_of(a, mi); const int k1 = (tile / m.ntn) * 64, n1 = (tile % m.ntn) * 64;
            const float* p = m.W + (size_t)(k1 + (tid >> 4)) * m.N + n1 + (tid & 15) * 4; v0 = *(const f32x4*)p; v1 = *(const f32x4*)(p + (size_t)32 * m.N); }
        __syncthreads();
        { const int n = tid >> 3, p = tid & 7; float v[8];
#pragma unroll
          for (int e = 0; e < 8; ++e) v[e] = t[(p * 8 + e) * 65 + n];
          u32x4 w; w.x = pk2(v[0], v[1]); w.y = pk2(v[2], v[3]); w.z = pk2(v[4], v[5]); w.w = pk2(v[6], v[7]);
          int nr = n0 + n; if (cm.rmode == 1) nr = nr < 2048 ? nr : (nr < 5120 ? nr + 2048 : nr - 3072);
          *(u32x4*)(cm.Wt + (size_t)nr * cm.K + k0 + p * 8) = w; }
        __syncthreads();
        if (!more) break;
    }
}
__device__ void norm_phase(const float* __restrict__ x, const float* __restrict__ g, const float* __restrict__ modl  , int shk, int sck, bf16_t* __restrict__ xn) {
    const int tid = opaque_tid(); const int w = tid >> 6, lane = tid & 63;
    for (int row = blockIdx.x * 8 + w; row < MTOK; row += gridDim.x * 8) {
        const int b = row / SEQ; const float* xr = x + (size_t)row * DM; f32x4 v[4]; float ss = 0.f;
#pragma unroll
        for (int i = 0; i < 4; ++i) { v[i] = *(const f32x4*)(xr + lane * 4 + 256 * i); ss += v[i][0] * v[i][0] + v[i][1] * v[i][1] + v[i][2] * v[i][2] + v[i][3] * v[i][3]; }
#pragma unroll
        for (int o = 32; o >= 1; o >>= 1) ss += __shfl_xor(ss, o);
        const float rstd = rsqrtf(ss * (1.0f / DM) + EPS);
        const float* sh = modl + (size_t)b * 6144 + shk * 1024; const float* sc = modl + (size_t)b * 6144 + sck * 1024;
#pragma unroll
        for (int i = 0; i < 4; ++i) { const int c = lane * 4 + 256 * i; const f32x4 gg = *(const f32x4*)(g + c), s1 = *(const f32x4*)(sc + c), s0 = *(const f32x4*)(sh + c);
            f32x4 y;
#pragma unroll
            for (int j = 0; j < 4; ++j) y[j] = v[i][j] * rstd * gg[j] * (1.0f + s1[j]) + s0[j];
            u32x2 o; o.x = pk2(y[0], y[1]); o.y = pk2(y[2], y[3]); *(u32x2*)(xn + (size_t)row * DM + c) = o; }
    }
}
constexpr int KP = 272, VP = 136;
constexpr float DEAD = -110.0f;
__device__ void attn_phase(const Args& a, int l, LAS unsigned char* lds) {
    const int tid = opaque_tid(), w = __builtin_amdgcn_readfirstlane(tid >> 6), lane = tid & 63, fr = lane & 15, fq = lane >> 4;
    LAS unsigned char* Ks = lds; LAS unsigned char* Vt = lds + 64 * KP; LAS int* flags = (LAS int*)(lds + 64 * KP + 128 * VP);
    const bf16_t* Qb = (const bf16_t*)(a.ws + WS_P); bf16_t* Yb = (bf16_t*)(a.ws + WS_P + 3 * PBUF); const bf16_t* Kb = (const bf16_t*)(a.ws + WS_P + PBUF); const bf16_t* Vb = (const bf16_t*)(a.ws + WS_P + 2 * PBUF);
    const float* gq = a.in[13] + l * 128; const float* gk = a.in[14] + l * 128;
    const int sp = tid & 15, skey = tid >> 4;
    float gks[8];
#pragma unroll
    for (int e = 0; e < 8; ++e) gks[e] = gk[sp * 8 + e];
    const int nunits = NB * 8 * (SEQ / 256);
    for (int unit = blockIdx.x; unit < nunits; unit += gridDim.x) {
        const int qt = (SEQ / 256 - 1) - unit / (NB * 8), bh = unit % (NB * 8), b = bh >> 3, hh = bh & 7;
        const size_t rowbase = (size_t)b * SEQ; const int t0 = qt * 256, r0 = t0 + 32 * w;
        bf16x8 qf[2][4];
#pragma unroll
        for (int rb = 0; rb < 2; ++rb) {
            const bf16_t* qp = Qb + (rowbase + r0 + 16 * rb + fr) * DM + hh * 128 + 8 * fq; u32x4 raw[4]; float ss = 0.f;
#pragma unroll
            for (int ks = 0; ks < 4; ++ks) { raw[ks] = *(const u32x4*)(qp + 32 * ks);
#pragma unroll
                for (int j = 0; j < 4; ++j) { const float x0 = bflo(raw[ks][j]), x1 = bfhi(raw[ks][j]); ss += x0 * x0 + x1 * x1; } }
            ss += __shfl_xor(ss, 16); ss += __shfl_xor(ss, 32);
            const float rs = rsqrtf(ss * (1.0f / 128.0f) + EPS) * 0.08838834764831845f;
#pragma unroll
            for (int ks = 0; ks < 4; ++ks) { u32x4 o;
#pragma unroll
                for (int j = 0; j < 4; ++j) { const int d = 32 * ks + 8 * fq + 2 * j; o[j] = pk2(bflo(raw[ks][j]) * rs * gq[d], bfhi(raw[ks][j]) * rs * gq[d + 1]); }
                qf[rb][ks] = __builtin_bit_cast(bf16x8, o); }
        }
        f32x4 O[2][8];
#pragma unroll
        for (int rb = 0; rb < 2; ++rb)
#pragma unroll
            for (int db = 0; db < 8; ++db) O[rb][db] = (f32x4){0.f, 0.f, 0.f, 0.f};
        float carry[2] = {0.f, 0.f};
        bool alive = true;
        for (int kb = qt * 4 + 3; kb >= 0; --kb) {
#pragma unroll
            for (int i = 0; i < 2; ++i) { const int key = skey + 32 * i; const size_t grow = rowbase + kb * 64 + key;
                const u32x4 kr = *(const u32x4*)(Kb + grow * DM + hh * 128 + sp * 8); const u32x4 vr = *(const u32x4*)(Vb + grow * DM + hh * 128 + sp * 8);
                float x[8]; float ss = 0.f;
#pragma unroll
                for (int j = 0; j < 4; ++j) { x[2 * j] = bflo(kr[j]); x[2 * j + 1] = bfhi(kr[j]); ss += x[2 * j] * x[2 * j] + x[2 * j + 1] * x[2 * j + 1]; }
                ss += __shfl_xor(ss, 1); ss += __shfl_xor(ss, 2); ss += __shfl_xor(ss, 4); ss += __shfl_xor(ss, 8);
                const float rs = rsqrtf(ss * (1.0f / 128.0f) + EPS);
                u32x4 o;
#pragma unroll
                for (int j = 0; j < 4; ++j) o[j] = pk2(x[2 * j] * rs * gks[2 * j], x[2 * j + 1] * rs * gks[2 * j + 1]);
                *(LAS u32x4*)(Ks + key * KP + sp * 16) = o;
#pragma unroll
                for (int j = 0; j < 4; ++j) { *(LAS bf16_t*)(Vt + (sp * 8 + 2 * j) * VP + key * 2) = (bf16_t)(vr[j] & 0xffff); *(LAS bf16_t*)(Vt + (sp * 8 + 2 * j + 1) * VP + key * 2) = (bf16_t)(vr[j] >> 16); }
            }
            __syncthreads();
            const bool active = alive && (kb * 64 < r0 + 31);
            if (active) {
                f32x4 S[2][4];
#pragma unroll
                for (int nb = 0; nb < 4; ++nb) {
                    bf16x8 kf[4];
#pragma unroll
                    for (int ks = 0; ks < 4; ++ks) kf[ks] = *(const LAS bf16x8*)(Ks + (16 * nb + fr) * KP + (32 * ks + 8 * fq) * 2);
#pragma unroll
                    for (int rb = 0; rb < 2; ++rb) { f32x4 s = (f32x4){0.f, 0.f, 0.f, 0.f};
#pragma unroll
                        for (int ks = 0; ks < 4; ++ks) s = __builtin_amdgcn_mfma_f32_16x16x32_bf16(kf[ks], qf[rb][ks], s, 0, 0, 0);
                        S[rb][nb] = s; }
                }
                unsigned pw[2][4][2];
#pragma unroll
                for (int rb = 0; rb < 2; ++rb) {
                    const int q = r0 + 16 * rb + fr; float lbv[4][4], suf[4][4], T[4], ab[4];
#pragma unroll
                    for (int nb = 0; nb < 4; ++nb) { float run = 0.f;
#pragma unroll
                        for (int e = 3; e >= 0; --e) { const int key = kb * 64 + 16 * nb + 4 * fq + e; const float z = S[rb][nb][e];
                            const float lb = fminf(z, 0.f) - __logf(1.0f + __expf(-fabsf(z))); const bool mk = key < q;
                            lbv[nb][e] = mk ? lb : -1e30f; suf[nb][e] = run; run += mk ? (lb - z) : 0.f; }
                        const float g1 = __shfl_xor(run, 16), g2 = __shfl_xor(run, 32), g3 = __shfl_xor(g1, 32);
                        T[nb] = run + g1 + g2 + g3; ab[nb] = fq == 0 ? (g1 + g2 + g3) : fq == 1 ? (g2 + g3) : fq == 2 ? g1 : 0.f; }
                    float hi = carry[rb];
#pragma unroll
                    for (int nb = 3; nb >= 0; --nb) { const float base = hi + ab[nb]; float p[4];
#pragma unroll
                        for (int e = 0; e < 4; ++e) p[e] = __expf(lbv[nb][e] + base + suf[nb][e]);
                        pw[rb][nb][0] = pk2(p[0], p[1]); pw[rb][nb][1] = pk2(p[2], p[3]); hi += T[nb]; }
                    carry[rb] = hi;
                }
#pragma unroll
                for (int ks2 = 0; ks2 < 2; ++ks2) {
                    bf16x8 pf[2];
#pragma unroll
                    for (int rb = 0; rb < 2; ++rb) { u32x4 t; t.x = pw[rb][2 * ks2][0]; t.y = pw[rb][2 * ks2][1]; t.z = pw[rb][2 * ks2 + 1][0]; t.w = pw[rb][2 * ks2 + 1][1]; pf[rb] = __builtin_bit_cast(bf16x8, t); }
#pragma unroll
                    for (int db = 0; db < 8; ++db) { const LAS unsigned char* vp = Vt + (16 * db + fr) * VP + (32 * ks2 + 4 * fq) * 2;
                        const u32x2 va = *(const LAS u32x2*)vp, vb = *(const LAS u32x2*)(vp + 32); u32x4 t; t.x = va.x; t.y = va.y; t.z = vb.x; t.w = vb.y; const bf16x8 vf = __builtin_bit_cast(bf16x8, t);
#pragma unroll
                        for (int rb = 0; rb < 2; ++rb) O[rb][db] = __builtin_amdgcn_mfma_f32_16x16x32_bf16(vf, pf[rb], O[rb][db], 0, 0, 0); }
                }
                alive = !__all((carry[0] < DEAD) && (carry[1] < DEAD));
            }
            if (lane == 0) flags[w] = alive ? 1 : 0;
            __syncthreads();
            int any = 0;
#pragma unroll
            for (int ww = 0; ww < 8; ++ww) any |= flags[ww];
            if (!any) break;
        }
#pragma unroll
        for (int rb = 0; rb < 2; ++rb) { bf16_t* op = Yb + (rowbase + r0 + 16 * rb + fr) * DM + hh * 128 + 4 * fq;
#pragma unroll
            for (int db = 0; db < 8; ++db) { u32x2 o; o.x = pk2(O[rb][db][0], O[rb][db][1]); o.y = pk2(O[rb][db][2], O[rb][db][3]); *(u32x2*)(op + 16 * db) = o; } }
        __syncthreads();
    }
}
constexpr int XP = 272;
template <bool FINAL>
__device__ void rnn_phase(const Args& a, int l, LAS unsigned char* lds) {
    const int tid = opaque_tid(), w = __builtin_amdgcn_readfirstlane(tid >> 6), lane = tid & 63, fr = lane & 15, fq = lane >> 4;
    LAS unsigned char* XC = lds; LAS unsigned char* HT = lds + RT * XP;
    const bf16_t* XR = (const bf16_t*)(a.ws + WS_P); const bf16_t* GY = (const bf16_t*)(a.ws + WS_P + PBUF); const bf16_t* SGA = (const bf16_t*)(a.ws + WS_P + 2 * PBUF);
    const bf16_t* SGB = (const bf16_t*)(a.ws + WS_P + 4 * PBUF); const bf16_t* YB = (const bf16_t*)(a.ws + WS_P + 3 * PBUF); bf16_t* MIX = (bf16_t*)(a.ws + WS_XN);
    float* SUM = (float*)(a.ws + WS_SUM); const float* HIN = (const float*)(a.ws + WS_HIN);
    const bf16_t* gw = (const bf16_t*)(a.ws + WS_GW) + (size_t)l * 2 * 8 * 16384;
    const float* cw = a.in[6] + (size_t)l * 4 * DM; const float* cb = a.in[7] + (size_t)l * DM;
    const float* ba = a.in[9] + (size_t)l * DM; const float* bx = a.in[11] + (size_t)l * DM; const float* lam = a.in[12] + (size_t)l * DM;
    const int sp = tid & 15, stok = tid >> 4;
    const int nunits = NB * 8 * NT;
    for (int unit = blockIdx.x; unit < nunits; unit += gridDim.x) {
        const int hh = unit & 7, b = (unit >> 3) & 3, j = unit >> 5; const int t0 = j * RT; const size_t rowbase = (size_t)b * SEQ;
        const int cbase = hh * 128;
        { float wv[4][8], bv[8];
#pragma unroll
          for (int e = 0; e < 8; ++e) { bv[e] = cb[cbase + sp * 8 + e];
#pragma unroll
              for (int k = 0; k < 4; ++k) wv[k][e] = cw[k * DM + cbase + sp * 8 + e]; }
#pragma unroll
          for (int i = 0; i < 4; ++i) { const int t = t0 + stok + 32 * i; float acc[8];
#pragma unroll
              for (int e = 0; e < 8; ++e) acc[e] = bv[e];
#pragma unroll
              for (int k = 0; k < 4; ++k) { const int ts = t - 3 + k; if (ts >= 0) { const u32x4 r = *(const u32x4*)(XR + (rowbase + ts) * DM + cbase + sp * 8);
#pragma unroll
                  for (int jj = 0; jj < 4; ++jj) { acc[2 * jj] += wv[k][2 * jj] * bflo(r[jj]); acc[2 * jj + 1] += wv[k][2 * jj + 1] * bfhi(r[jj]); } } }
              u32x4 o; o.x = pk2(acc[0], acc[1]); o.y = pk2(acc[2], acc[3]); o.z = pk2(acc[4], acc[5]); o.w = pk2(acc[6], acc[7]);
              *(LAS u32x4*)(XC + (stok + 32 * i) * XP + sp * 16) = o; } }
        bf16x8 wa[4], wx[4];
        { const bf16_t* pa = gw + ((size_t)(0 * 8 + hh) * 128 + 16 * w + fr) * 128 + 8 * fq; const bf16_t* px = gw + ((size_t)(1 * 8 + hh) * 128 + 16 * w + fr) * 128 + 8 * fq;
#pragma unroll
          for (int ks = 0; ks < 4; ++ks) { wa[ks] = *(const bf16x8*)(pa + 32 * ks); wx[ks] = *(const bf16x8*)(px + 32 * ks); } }
        const int c = cbase + 16 * w + fr;
        const float bac = ba[c], bxc = bx[c]; const float lm = lam[c]; const float sp8 = 8.0f * (fmaxf(-lm, 0.f) + __logf(1.0f + __expf(-fabsf(lm))));
        __syncthreads();
        f32x4 A[8], U[8];
#pragma unroll
        for (int mb = 0; mb < 8; ++mb) { f32x4 ra = (f32x4){0.f, 0.f, 0.f, 0.f}, rx = ra;
#pragma unroll
            for (int ks = 0; ks < 4; ++ks) { const bf16x8 xf = *(const LAS bf16x8*)(XC + (16 * mb + fr) * XP + (32 * ks + 8 * fq) * 2);
                ra = __builtin_amdgcn_mfma_f32_16x16x32_bf16(xf, wa[ks], ra, 0, 0, 0); rx = __builtin_amdgcn_mfma_f32_16x16x32_bf16(xf, wx[ks], rx, 0, 0, 0); }
#pragma unroll
            for (int e = 0; e < 4; ++e) { const float r = sigmoidf_(ra[e] + bac), ig = sigmoidf_(rx[e] + bxc); const float la = -sp8 * r; const float av = __expf(la);
                const float x2 = 2.0f * la; const float om = x2 > -0.02f ? -x2 * (1.0f + x2 * (0.5f + x2 * (1.0f / 6.0f))) : 1.0f - av * av;
                const float xc = bf2f(*(const LAS bf16_t*)(XC + (16 * mb + 4 * fq + e) * XP + (16 * w + fr) * 2));
                ra[e] = av; rx[e] = sqrtf(om) * ig * xc; }
            A[mb] = ra; U[mb] = rx; }
        float H = 0.f, Pp = 1.0f;
        if (FINAL) H = HIN[((size_t)b * NT + j) * DM + c];
#pragma unroll
        for (int mb = 0; mb < 8; ++mb) {
            float Ag = A[mb][0] * A[mb][1] * A[mb][2] * A[mb][3];
            float Ug = ((U[mb][0] * A[mb][1] + U[mb][1]) * A[mb][2] + U[mb][2]) * A[mb][3] + U[mb][3];
            { const float a1 = __shfl_up(Ag, 16), u1 = __shfl_up(Ug, 16); if (fq >= 1) { Ug = Ag * u1 + Ug; Ag = Ag * a1; } }
            { const float a2 = __shfl_up(Ag, 32), u2 = __shfl_up(Ug, 32); if (fq >= 2) { Ug = Ag * u2 + Ug; Ag = Ag * a2; } }
            if (FINAL) {
                const float ap = __shfl_up(Ag, 16), up = __shfl_up(Ug, 16);
                float h = fq == 0 ? H : ap * H + up;
#pragma unroll
                for (int e = 0; e < 4; ++e) { h = A[mb][e] * h + U[mb][e]; *(LAS bf16_t*)(HT + (16 * mb + 4 * fq + e) * XP + (16 * w + fr) * 2) = (bf16_t)(pk2(h, h) & 0xffff); }
            }
            const float Am = __shfl(Ag, 48 + fr), Um = __shfl(Ug, 48 + fr);
            H = Am * H + Um; Pp *= Am;
        }
        if (!FINAL) { if (fq == 0) { float* s = SUM + (((size_t)b * NT + j) * DM + c) * 2; s[0] = Pp; s[1] = H; } }
        else {
            __syncthreads();
#pragma unroll
            for (int i = 0; i < 4; ++i) { const int tl = stok + 32 * i; const size_t go = (rowbase + t0 + tl) * DM + cbase + sp * 8;
                const u32x4 hv = *(const LAS u32x4*)(HT + tl * XP + sp * 16); const u32x4 g = *(const u32x4*)(GY + go), s1 = *(const u32x4*)(SGA + go), s2 = *(const u32x4*)(SGB + go), yb = *(const u32x4*)(YB + go);
                u32x4 o;
#pragma unroll
                for (int jj = 0; jj < 4; ++jj) o[jj] = pk2(bflo(s1[jj]) * bflo(hv[jj]) * bflo(g[jj]) + bflo(s2[jj]) * bflo(yb[jj]), bfhi(s1[jj]) * bfhi(hv[jj]) * bfhi(g[jj]) + bfhi(s2[jj]) * bfhi(yb[jj]));
                *(u32x4*)(MIX + go) = o; }
        }
        __syncthreads();
    }
}
__device__ void carry_phase(const Args& a) {
    const float* SUM = (const float*)(a.ws + WS_SUM); float* HIN = (float*)(a.ws + WS_HIN);
    const int gt = blockIdx.x * NTH + opaque_tid(); if (gt >= NB * DM) return;
    const int b = gt / DM, c = gt % DM; float H = 0.f;
#pragma unroll 8
    for (int j = 0; j < NT; ++j) { const size_t o = ((size_t)b * NT + j) * DM + c; HIN[o] = H; const float p = SUM[o * 2], h = SUM[o * 2 + 1]; H = p * H + h; }
}
__device__ void ffnconv_phase(const Args& a, int l, int half) {
    const bf16_t* UP = (const bf16_t*)(a.ws + WS_P); bf16_t* ACT = (bf16_t*)(a.ws + WS_P + UPH_BYTES);
    const float* cw = a.in[18] + (size_t)l * 3 * DFF2; const float* cb = a.in[19] + (size_t)l * DFF2;
    const int nitems = (MH / 16) * (DFF / 8);
    for (int it = blockIdx.x * NTH + opaque_tid(); it < nitems; it += gridDim.x * NTH) {
        const int cg = it % (DFF / 8), tr = it / (DFF / 8); const int c0 = cg * 8, tl0 = tr * 16;
        const int tseq0 = (half * MH + tl0) % SEQ;
        float wg[3][8], wv[3][8], bg[8], bv[8];
#pragma unroll
        for (int e = 0; e < 8; ++e) { bg[e] = cb[c0 + e]; bv[e] = cb[DFF + c0 + e];
#pragma unroll
            for (int k = 0; k < 3; ++k) { wg[k][e] = cw[k * DFF2 + c0 + e]; wv[k][e] = cw[k * DFF2 + DFF + c0 + e]; } }
        u32x4 g0 = (u32x4){0, 0, 0, 0}, g1 = g0, v0 = g0, v1 = g0;
        if (tseq0 >= 2) { g0 = *(const u32x4*)(UP + (size_t)(tl0 - 2) * DFF2 + c0); v0 = *(const u32x4*)(UP + (size_t)(tl0 - 2) * DFF2 + DFF + c0); }
        if (tseq0 >= 1) { g1 = *(const u32x4*)(UP + (size_t)(tl0 - 1) * DFF2 + c0); v1 = *(const u32x4*)(UP + (size_t)(tl0 - 1) * DFF2 + DFF + c0); }
#pragma unroll 4
        for (int r = 0; r < 16; ++r) {
            const u32x4 g2 = *(const u32x4*)(UP + (size_t)(tl0 + r) * DFF2 + c0), v2 = *(const u32x4*)(UP + (size_t)(tl0 + r) * DFF2 + DFF + c0);
            u32x4 o;
#pragma unroll
            for (int jj = 0; jj < 4; ++jj) {
                const float ga = bg[2 * jj] + wg[0][2 * jj] * bflo(g0[jj]) + wg[1][2 * jj] * bflo(g1[jj]) + wg[2][2 * jj] * bflo(g2[jj]);
                const float gb = bg[2 * jj + 1] + wg[0][2 * jj + 1] * bfhi(g0[jj]) + wg[1][2 * jj + 1] * bfhi(g1[jj]) + wg[2][2 * jj + 1] * bfhi(g2[jj]);
                const float va = bv[2 * jj] + wv[0][2 * jj] * bflo(v0[jj]) + wv[1][2 * jj] * bflo(v1[jj]) + wv[2][2 * jj] * bflo(v2[jj]);
                const float vb = bv[2 * jj + 1] + wv[0][2 * jj + 1] * bfhi(v0[jj]) + wv[1][2 * jj + 1] * bfhi(v1[jj]) + wv[2][2 * jj + 1] * bfhi(v2[jj]);
                o[jj] = pk2(gelu_tanh(ga) * va, gelu_tanh(gb) * vb); }
            *(u32x4*)(ACT + (size_t)(tl0 + r) * DFF + c0) = o;
            g0 = g1; g1 = g2; v0 = v1; v1 = v2;
        }
    }
}
constexpr int LDS_BYTES = 136 * 1024;
__global__ void __launch_bounds__(NTH, 2) mk_fwd(Args a) {
    extern __shared__ __attribute__((aligned(16))) unsigned char lds_raw[];
    LAS unsigned char* lds = (LAS unsigned char*)lds_raw;
    cg::grid_group grid = cg::this_grid();
    volatile LAS unsigned* xbst = (volatile LAS unsigned*)(lds + LDS_BYTES - 16);
    if (threadIdx.x < 4) xbst[threadIdx.x] = 0u;
    __syncthreads();
    const XcdBarrier xbar = xcd_barrier_post((unsigned*)(a.ws + WS_BAR), xbst);
    const int G = gridDim.x, bid = blockIdx.x;
    float* mod = (float*)(a.ws + WS_MOD);
    bf16_t* XN = (bf16_t*)(a.ws + WS_XN); bf16_t* P = (bf16_t*)(a.ws + WS_P);
#ifndef REPMASK
#define REPMASK 0
#endif
#ifndef XSYNC
#define XSYNC 0
#endif
#define RUN(k, ...) for (int _r = 0; _r < (((REPMASK >> (k)) & 1) ? 2 : 1); ++_r) { __VA_ARGS__ xcd_barrier(xbar); }
    for (int _r = 0; _r < ((REPMASK & 1) ? 2 : 1); ++_r) { p0_mod(a, lds); p0_weights(a, lds); grid.sync(); }
    for (int _x = 0; _x < XSYNC; ++_x) xcd_barrier(xbar);
    for (int l = 0; l < NL; ++l) {
        const float* modl = mod + (size_t)l * NB * 6144;
        const bf16_t* wl = (const bf16_t*)(a.ws + WS_W) + (size_t)l * W_LAYER_E;
        const float* xin = l == 0 ? a.in[0] : a.out;
        RUN(1, norm_phase(xin, a.in[4] + l * DM, modl, 0, 1, XN);)
        RUN(2, { pg8::Gemm g{XN, wl + (size_t)4096 * DM, MTOK, 3072, DM}; pg8::StaticOrder S; S.init(MTOK, 3072, G, bid);
          EpiSplit E{P, (size_t)MTOK * DM, 0x0000, 0}; pg8::gemm_phase<EpiSplit, pg8::StaticOrder, true, true>(lds, g, S, E); })
        RUN(3, attn_phase(a, l, lds);)
        RUN(4, { pg8::Gemm g{XN, wl, MTOK, 4096, DM}; pg8::StaticOrder S; S.init(MTOK, 4096, G, bid);
          EpiSplit E{P, (size_t)MTOK * DM, 0x2210, 1}; pg8::gemm_phase<EpiSplit, pg8::StaticOrder, true, true>(lds, g, S, E); })
        RUN(5, rnn_phase<false>(a, l, lds);)
        RUN(6, carry_phase(a);)
        RUN(7, rnn_phase<true>(a, l, lds);)
        RUN(13, { pg8::Gemm g{XN, wl + W_IN_E, MTOK, DM, DM}; pg8::StaticOrder S; S.init(MTOK, DM, G, bid);
          EpiRes E{xin, a.out, modl + 2 * 1024, 0}; pg8::gemm_phase<EpiRes, pg8::StaticOrder, true, true>(lds, g, S, E); })
        RUN(9, norm_phase(a.out, a.in[16] + l * DM, modl, 3, 4, XN);)
        for (int half = 0; half < 2; ++half) {
            RUN(10, { pg8::Gemm g{XN + (size_t)half * MH * DM, wl + W_IN_E + W_OUT_E, MH, DFF2, DM}; pg8::StaticOrder S; S.init(MH, DFF2, G, bid);
              EpiPlain E{P, DFF2}; pg8::gemm_phase<EpiPlain, pg8::StaticOrder, true, true>(lds, g, S, E); })
            RUN(11, ffnconv_phase(a, l, half);)
            RUN(13, { pg8::Gemm g{(const bf16_t*)(a.ws + WS_P + UPH_BYTES), wl + W_IN_E + W_OUT_E + W_UP_E, MH, DM, DFF}; pg8::StaticOrder S; S.init(MH, DM, G, bid);
              EpiRes E{a.out, a.out, modl + 5 * 1024, half * MH}; pg8::gemm_phase<EpiRes, pg8::StaticOrder, true, true>(lds, g, S, E); })
        }
    }
}
extern "C" void kernel_launch(void* const* d_in, const int* in_sizes, int n_in, void* d_out, int out_size, void* d_ws, size_t ws_size, hipStream_t stream) {
    static int grid = 0;
    if (!grid) {
        int dev = 0, cus = 0, per_cu = 0;
        (void)hipGetDevice(&dev);
        (void)hipDeviceGetAttribute(&cus, hipDeviceAttributeMultiprocessorCount, dev);
        (void)hipFuncSetAttribute((const void*)mk_fwd, hipFuncAttributeMaxDynamicSharedMemorySize, LDS_BYTES);
        (void)hipOccupancyMaxActiveBlocksPerMultiprocessor(&per_cu, (const void*)mk_fwd, NTH, LDS_BYTES);
        if (per_cu < 1) per_cu = 1;
        grid = cus * per_cu;
        if (ws_size < WS_END) { fprintf(stderr, "kernel_launch: workspace too small: %zu < %zu\n", ws_size, (size_t)WS_END); grid = -1; }
        if (n_in != 21 || out_size != MTOK * DM) { fprintf(stderr, "kernel_launch: unexpected shapes\n"); grid = -1; }
    }
    if (grid < 0) return;
    (void)hipMemsetAsync((char*)d_ws + WS_BAR, 0, XCD_BAR_WORDS * 4, stream);
    Args a{};
    for (int i = 0; i < 21; ++i) a.in[i] = (const float*)d_in[i];
    a.out = (float*)d_out; a.ws = (unsigned char*)d_ws;
    void* args[] = {&a};
    hipError_t e = hipLaunchCooperativeKernel((const void*)mk_fwd, dim3(grid), dim3(NTH), args, LDS_BYTES, stream);
    if (e != hipSuccess) fprintf(stderr, "cooperative launch failed: %s (grid %d)\n", hipGetErrorString(e), grid);
}
```

```cpp
#include <hip/hip_runtime.h>
#include <hip/hip_cooperative_groups.h>
#include <cstdio>
#include <cstdint>
namespace cg = cooperative_groups;
__device__ __forceinline__ int opaque_tid(int wv) { int t; asm volatile("v_mbcnt_lo_u32_b32 %0, -1, 0\n\tv_mbcnt_hi_u32_b32 %0, -1, %0" : "=v"(t)); return t | (wv << 6); }
__device__ __forceinline__ int opaque_bid() { int t = blockIdx.x; asm volatile("" : "+s"(t)); return t; }
namespace pg8 {
#define PG8_LAS __attribute__((address_space(3)))
typedef unsigned short bf16_t;
typedef short bf16x8 __attribute__((ext_vector_type(8)));
typedef float f32x4 __attribute__((ext_vector_type(4)));
typedef unsigned u32x4 __attribute__((ext_vector_type(4)));
constexpr int BM = 256, BK = 64, HALF = 128, HTB = HALF * BK * 2  , STAGE_BYTES = 8 * HTB, NXCD = 8, WGM = 8;

__host__ __device__ __forceinline__ int lds_byte(int r, int c) { const int st = (r >> 4) * 2 + (c >> 5), rr = r & 15, cc = c & 31, ob = rr * 64 + cc * 2; return st * 1024 + (ob ^ (((ob >> 9) & 1) << 5)); }
__host__ __device__ __forceinline__ void stage_rc(int b, int& R, int& C) { const int st = b / 1024, sb = b % 1024, swz = sb ^ (((sb >> 9) & 1) << 5); R = (st >> 1) * 16 + swz / 64; C = (st & 1) * 32 + (swz % 64) / 2; }
__host__ __device__ __forceinline__ int perm32(int rho) { const int n = rho >> 4, i = rho & 15; return 8 * (i >> 2) + 4 * n + (i & 3); }

struct Unit { int pm, pn; };
struct Gemm { const bf16_t* A; const bf16_t* Bt; int M, N, K; };

struct StaticOrder {
    int nM, nN, nwg, G, c;
    __host__ __device__ void init(int M, int N, int G_, int c_) { nM = M / BM; nN = N / BM; nwg = nM * nN; G = G_; c = c_; }
    __host__ __device__ bool next(int i, Unit& u) const {
        const long L = (long)i * G + c; if (L >= nwg) return false;
        int wgid = (int)L; { const int q = nwg / NXCD, r = nwg % NXCD, xcd = wgid % NXCD, off = wgid / NXCD; wgid = (xcd < r ? xcd * (q + 1) : r * (q + 1) + (xcd - r) * q) + off; }
        const int nig = WGM * nN, gid = wgid / nig, fm = gid * WGM, gsz = (nM - fm) < WGM ? (nM - fm) : WGM;
        u.pm = fm + ((wgid % nig) % gsz); u.pn = (wgid % nig) / gsz; return true;
    }
    __device__ __forceinline__ void a_ready(const Unit&) const {}
    __device__ __forceinline__ void done(const Unit&) const {}
};

template <class Epi, class Sched, bool ALIGN_EPI = false, bool SP2 = false, bool ROWPERM = false>
__device__ __forceinline__ void gemm_phase(PG8_LAS unsigned char* lds, const Gemm g, const Sched& S, const Epi& E, const int wv) {
    const int tid = opaque_tid(wv), wid = __builtin_amdgcn_readfirstlane(tid >> 6), lane = tid & 63, wr = wid >> 2, wc = wid & 3, fr = lane & 15, fq = lane >> 4;
    const int K = g.K, nt = K / BK;
    unsigned voffA[2], voffB[2];
#pragma unroll
    for (int i = 0; i < 2; ++i) { int R, C; stage_rc(tid * 16 + i * 8192, R, C); const int Rb = Epi::PERM ? ((R & ~31) + perm32(R & 31)) : R;
        const int Ra = ROWPERM ? (128 * (R >> 6) + 8 * (R & 15) + ((R >> 4) & 3)) : R;
        voffA[i] = (unsigned)(Ra * K + C) * 2u; voffB[i] = (unsigned)(Rb * K + C) * 2u; }
    const size_t kstep = (size_t)(BK * 2);
    const size_t hstep = (size_t)HALF * K * 2;
    const size_t tstep = 2 * hstep; const size_t hstepA = ROWPERM ? (size_t)4 * K * 2 : hstep;
    const unsigned ldsw = (unsigned)wid * 1024u;
    const int aoff = lds_byte(wr * 64 + fr, fq * 8), boff = lds_byte(wc * 32 + fr, fq * 8);
#define PG8_SA(b, h) (((b) * 2 + (h)) * HTB)
#define PG8_SB(b, h) ((4 + (b) * 2 + (h)) * HTB)
#define PG8_STAGE(bufoff, gbase, voff) do { _Pragma("unroll") for (int _i = 0; _i < 2; ++_i) \
        __builtin_amdgcn_global_load_lds((const unsigned*)((const char*)(gbase) + (voff)[_i]), (PG8_LAS unsigned*)(lds + (bufoff) + ldsw + _i * 8192), 16, 0, 0); } while (0)
#define PG8_LDA(dst, b, h) do { _Pragma("unroll") for (int m = 0; m < 4; ++m) _Pragma("unroll") for (int k = 0; k < 2; ++k) dst[m][k] = *(const PG8_LAS bf16x8*)(lds + PG8_SA(b, h) + aoff + m * 2048 + k * 1024); } while (0)
#define PG8_LDB(dst, b, h) do { _Pragma("unroll") for (int n = 0; n < 2; ++n) _Pragma("unroll") for (int k = 0; k < 2; ++k) dst[n][k] = *(const PG8_LAS bf16x8*)(lds + PG8_SB(b, h) + boff + n * 2048 + k * 1024); } while (0)
#define PG8_MMA(ai, bj, At, Bt) do { __builtin_amdgcn_s_setprio(1); _Pragma("unroll") for (int m = 0; m < 4; ++m) _Pragma("unroll") for (int n = 0; n < 2; ++n) _Pragma("unroll") for (int k = 0; k < 2; ++k) \
        acc[ai][bj][m][n] = __builtin_amdgcn_mfma_f32_16x16x32_bf16(Bt[n][k], At[m][k], acc[ai][bj][m][n], 0, 0, 0); __builtin_amdgcn_s_setprio(0); } while (0)
#define PG8_WAIT_V(n) asm volatile("s_waitcnt vmcnt(" #n ")" ::: "memory")
#define PG8_WAIT_L(n) asm volatile("s_waitcnt lgkmcnt(" #n ")" ::: "memory")
#define PG8_BAR __builtin_amdgcn_s_barrier()
#define PG8_SCHED __builtin_amdgcn_sched_barrier(0)
    Unit cur, nxt; int ui = 0;
    if (!S.next(0, cur)) return;
    f32x4 acc[2][2][4][2];
#pragma unroll
    for (int a = 0; a < 2; ++a)
#pragma unroll
        for (int b = 0; b < 2; ++b)
#pragma unroll
            for (int m = 0; m < 4; ++m)
#pragma unroll
                for (int n = 0; n < 2; ++n) acc[a][b][m][n] = (f32x4){0.f, 0.f, 0.f, 0.f};
    bf16x8 At[4][2], B0[2][2], B1[2][2];
    const char* cA = (const char*)g.A + (size_t)cur.pm * tstep; const char* cB = (const char*)g.Bt + (size_t)cur.pn * tstep;
    S.a_ready(cur);
    if constexpr (SP2) {
        PG8_STAGE(PG8_SB(0, 0), cB, voffB); PG8_STAGE(PG8_SB(0, 1), cB + hstep, voffB); PG8_STAGE(PG8_SA(0, 0), cA, voffA); PG8_STAGE(PG8_SA(0, 1), cA + hstepA, voffA);
        if (wr == 1) PG8_BAR;
        PG8_WAIT_V(2); PG8_BAR;
        PG8_STAGE(PG8_SB(1, 0), cB + kstep, voffB); PG8_STAGE(PG8_SA(1, 0), cA + kstep, voffA); PG8_STAGE(PG8_SB(1, 1), cB + hstep + kstep, voffB);
        PG8_WAIT_V(6); PG8_BAR;
    } else {
        PG8_STAGE(PG8_SB(0, 0), cB, voffB); PG8_STAGE(PG8_SA(0, 0), cA, voffA); PG8_STAGE(PG8_SB(0, 1), cB + hstep, voffB); PG8_STAGE(PG8_SA(0, 1), cA + hstepA, voffA);
        if (wr == 1) PG8_BAR;
        PG8_WAIT_V(4); PG8_BAR;
        PG8_STAGE(PG8_SB(1, 0), cB + kstep, voffB); PG8_STAGE(PG8_SA(1, 0), cA + kstep, voffA); PG8_STAGE(PG8_SB(1, 1), cB + hstep + kstep, voffB);
        PG8_WAIT_V(6); PG8_BAR;
    }
    for (;;) {
        const bool has_next = S.next(ui + 1, nxt);
        const char* nA = has_next ? (const char*)g.A + (size_t)nxt.pm * tstep : cA; const char* nB = has_next ? (const char*)g.Bt + (size_t)nxt.pn * tstep : cB;
        for (int t = 0; t < nt; t += 2) {
            const bool last = (t == nt - 2);
            const char* a1 = cA + (size_t)(t + 1) * kstep;
            const char* a2 = last ? nA : cA + (size_t)(t + 2) * kstep; const char* b2 = last ? nB : cB + (size_t)(t + 2) * kstep;
            const char* a3 = a2 + kstep; const char* b3 = b2 + kstep;
            if (last && has_next) S.a_ready(nxt);
            if constexpr (SP2) {
            PG8_LDB(B0, 0, 0); PG8_LDB(B1, 0, 1); PG8_SCHED; PG8_LDA(At, 0, 0); PG8_STAGE(PG8_SA(1, 1), a1 + hstepA, voffA);
            PG8_WAIT_V(8); PG8_WAIT_L(0); PG8_BAR; PG8_MMA(0, 0, At, B0); PG8_MMA(0, 1, At, B1); PG8_BAR; PG8_SCHED;
            PG8_LDA(At, 0, 1); PG8_STAGE(PG8_SB(0, 0), b2, voffB); PG8_STAGE(PG8_SB(0, 1), b2 + hstep, voffB); PG8_STAGE(PG8_SA(0, 0), a2, voffA);
            PG8_WAIT_V(8); PG8_WAIT_L(0); PG8_BAR; PG8_MMA(1, 0, At, B0); PG8_MMA(1, 1, At, B1); PG8_BAR; PG8_SCHED;
            PG8_LDB(B0, 1, 0); PG8_LDB(B1, 1, 1); PG8_SCHED; PG8_LDA(At, 1, 0); PG8_STAGE(PG8_SA(0, 1), a2 + hstepA, voffA);
            PG8_WAIT_V(8); PG8_WAIT_L(0); PG8_BAR; PG8_MMA(0, 0, At, B0); PG8_MMA(0, 1, At, B1); PG8_BAR; PG8_SCHED;
            PG8_LDA(At, 1, 1); PG8_STAGE(PG8_SB(1, 0), b3, voffB); PG8_STAGE(PG8_SB(1, 1), b3 + hstep, voffB); PG8_STAGE(PG8_SA(1, 0), a3, voffA);
            PG8_WAIT_V(8); PG8_WAIT_L(0); PG8_BAR; PG8_MMA(1, 0, At, B0); PG8_MMA(1, 1, At, B1); PG8_BAR; PG8_SCHED;
            } else {
            PG8_LDB(B0, 0, 0); PG8_SCHED; PG8_LDA(At, 0, 0); PG8_STAGE(PG8_SA(1, 1), a1 + hstepA, voffA);
            PG8_WAIT_L(8); PG8_BAR; PG8_WAIT_L(0); PG8_MMA(0, 0, At, B0); PG8_BAR; PG8_SCHED;
            PG8_LDB(B1, 0, 1); PG8_STAGE(PG8_SB(0, 0), b2, voffB);
            PG8_BAR; PG8_WAIT_L(0); PG8_MMA(0, 1, At, B1); PG8_BAR;
            PG8_LDA(At, 0, 1); PG8_STAGE(PG8_SA(0, 0), a2, voffA);
            PG8_BAR; PG8_WAIT_L(0); PG8_MMA(1, 0, At, B0); PG8_BAR; PG8_SCHED;
            PG8_STAGE(PG8_SB(0, 1), b2 + hstep, voffB);
            PG8_WAIT_V(6); PG8_BAR; PG8_MMA(1, 1, At, B1); PG8_BAR;
            PG8_LDB(B0, 1, 0); PG8_SCHED; PG8_LDA(At, 1, 0); PG8_STAGE(PG8_SA(0, 1), a2 + hstepA, voffA);
            PG8_WAIT_L(8); PG8_BAR; PG8_WAIT_L(0); PG8_MMA(0, 0, At, B0); PG8_BAR; PG8_SCHED;
            PG8_LDB(B1, 1, 1); PG8_STAGE(PG8_SB(1, 0), b3, voffB);
            PG8_BAR; PG8_WAIT_L(0); PG8_MMA(0, 1, At, B1); PG8_BAR;
            PG8_LDA(At, 1, 1); PG8_STAGE(PG8_SA(1, 0), a3, voffA);
            PG8_BAR; PG8_WAIT_L(0); PG8_MMA(1, 0, At, B0); PG8_BAR; PG8_SCHED;
            PG8_STAGE(PG8_SB(1, 1), b3 + hstep, voffB);
            PG8_WAIT_V(6); PG8_BAR; PG8_MMA(1, 1, At, B1); PG8_BAR;
            }
        }
        if constexpr (ALIGN_EPI) { if (wr == 0) PG8_BAR; }
        if constexpr (!Epi::AFTER_DRAIN) { E(acc, cur, wr, wc, fr, fq); S.done(cur); }
        if (!has_next) break;
#pragma unroll
        for (int a = 0; a < 2; ++a)
#pragma unroll
            for (int b = 0; b < 2; ++b)
#pragma unroll
                for (int m = 0; m < 4; ++m)
#pragma unroll
                    for (int n = 0; n < 2; ++n) acc[a][b][m][n] = (f32x4){0.f, 0.f, 0.f, 0.f};
        cur = nxt; cA = nA; cB = nB; ++ui;
        if constexpr (ALIGN_EPI) { if (wr == 1) PG8_BAR; }
    }
    PG8_WAIT_V(0);
    if constexpr (!ALIGN_EPI) { if (wr == 0) PG8_BAR; }
    PG8_BAR;
    if constexpr (Epi::AFTER_DRAIN) { E.fused(acc, cur, wr, wc, fr, fq, lds, wid, lane); S.done(cur); }
#undef PG8_SA
#undef PG8_SB
#undef PG8_STAGE
#undef PG8_LDA
#undef PG8_LDB
#undef PG8_MMA
#undef PG8_WAIT_V
#undef PG8_WAIT_L
#undef PG8_BAR
#undef PG8_SCHED
}
}
typedef pg8::bf16_t bf16_t;
typedef pg8::bf16x8 bf16x8;
typedef pg8::f32x4 f32x4;
typedef pg8::u32x4 u32x4;
typedef unsigned u32x2 __attribute__((ext_vector_type(2)));
#define LAS __attribute__((address_space(3)))

constexpr int DM = 1024, NB = 4, SEQ = 8192, MTOK = NB * SEQ, DIN = 7168, DFF = 3072, DFF2 = 6144, NL = 2;
constexpr int NTH = 512;
constexpr float EPS = 1e-6f;
constexpr int RT = 128, NT = SEQ / RT;
constexpr size_t WS_BAR = 0;
constexpr size_t WS_MOD = 16384;
constexpr size_t WS_GW = WS_MOD + (size_t)NL * NB * 6144 * 4;
constexpr size_t WS_SUM = WS_GW + (size_t)NL * 2 * 8 * 128 * 128 * 2;
constexpr size_t WS_HIN = WS_SUM + (size_t)NB * NT * 1024 * 2 * 4;
constexpr size_t WS_W = (WS_HIN + (size_t)NB * NT * 1024 * 4 + 4095) / 4096 * 4096;
constexpr size_t W_IN_E = (size_t)DIN * DM, W_OUT_E = (size_t)DM * DM, W_UP_E = (size_t)DFF2 * DM, W_DN_E = (size_t)DM * DFF, W_LAYER_E = W_IN_E + W_OUT_E + W_UP_E + W_DN_E;
constexpr size_t WS_XN = WS_W + NL * W_LAYER_E * 2;
constexpr size_t PBUF = (size_t)MTOK * DM * 2;
constexpr size_t WS_P = WS_XN + PBUF;
constexpr size_t WS_END = WS_P + 5 * PBUF;
constexpr size_t ACT_BYTES = (size_t)MTOK * DFF * 2;

__device__ __forceinline__ float bf2f(bf16_t b) { return __uint_as_float(((unsigned)b) << 16); }
__device__ __forceinline__ unsigned pk2(float lo, float hi) { unsigned r; asm volatile("v_cvt_pk_bf16_f32 %0, %1, %2" : "=v"(r) : "v"(lo), "v"(hi)); return r; }
__device__ __forceinline__ float bflo(unsigned w) { return __uint_as_float(w << 16); }
__device__ __forceinline__ float bfhi(unsigned w) { return __uint_as_float(w & 0xffff0000u); }
__device__ __forceinline__ float sigmoidf_(float x) { return __builtin_amdgcn_rcpf(1.0f + __expf(-x)); }
__device__ __forceinline__ float gelu_tanh(float x) { const float u = 1.5957691216057308f * (x + 0.044715f * x * x * x); return x * sigmoidf_(u); }

struct EpiSplit {
    static constexpr bool PERM = true, AFTER_DRAIN = false;
    bf16_t* base; size_t tstride; int modes; int skip3;
    __device__ __forceinline__ void operator()(const f32x4 (&acc)[2][2][4][2], const pg8::Unit& u, int wr, int wc, int fr, int fq) const {
        const int colt = u.pn * 256, t = colt >> 10; const int mode = (modes >> (4 * t)) & 15;
        bf16_t* o = base + (size_t)(t + ((skip3 && t == 3) ? 1 : 0)) * tstride; const int col0 = (colt & 1023) + wc * 32 + 8 * fq; const int row0 = u.pm * 256 + wr * 64 + fr;
#pragma unroll
        for (int ai = 0; ai < 2; ++ai)
#pragma unroll
            for (int m = 0; m < 4; ++m) { bf16_t* rowp = o + (size_t)(row0 + ai * 128 + m * 16) * DM + col0;
#pragma unroll
                for (int bj = 0; bj < 2; ++bj) { f32x4 v0 = acc[ai][bj][m][0], v1 = acc[ai][bj][m][1];
                    if (mode == 1) {
#pragma unroll
                        for (int j = 0; j < 4; ++j) { v0[j] = gelu_tanh(v0[j]); v1[j] = gelu_tanh(v1[j]); } }
                    else if (mode == 2) {
#pragma unroll
                        for (int j = 0; j < 4; ++j) { v0[j] = sigmoidf_(v0[j]); v1[j] = sigmoidf_(v1[j]); } }
                    u32x4 w; w.x = pk2(v0[0], v0[1]); w.y = pk2(v0[2], v0[3]); w.z = pk2(v1[0], v1[1]); w.w = pk2(v1[2], v1[3]);
                    *(u32x4*)(rowp + bj * 128) = w; } }
    }
};
struct EpiPlain {
    static constexpr bool PERM = true, AFTER_DRAIN = false;
    bf16_t* o; int ldc;
    __device__ __forceinline__ void operator()(const f32x4 (&acc)[2][2][4][2], const pg8::Unit& u, int wr, int wc, int fr, int fq) const {
        const int col0 = u.pn * 256 + wc * 32 + 8 * fq; const int row0 = u.pm * 256 + wr * 64 + fr;
#pragma unroll
        for (int ai = 0; ai < 2; ++ai)
#pragma unroll
            for (int m = 0; m < 4; ++m) { bf16_t* rowp = o + (size_t)(row0 + ai * 128 + m * 16) * ldc + col0;
#pragma unroll
                for (int bj = 0; bj < 2; ++bj) { const f32x4 v0 = acc[ai][bj][m][0], v1 = acc[ai][bj][m][1];
                    u32x4 w; w.x = pk2(v0[0], v0[1]); w.y = pk2(v0[2], v0[3]); w.z = pk2(v1[0], v1[1]); w.w = pk2(v1[2], v1[3]);
                    *(u32x4*)(rowp + bj * 128) = w; } }
    }
};
struct EpiRes {
    static constexpr bool PERM = false, AFTER_DRAIN = false;
    const float* res; float* out; const float* gate  ; int row_off;
    __device__ __forceinline__ void operator()(const f32x4 (&acc)[2][2][4][2], const pg8::Unit& u, int wr, int wc, int fr, int fq) const {
        const int grow0 = row_off + u.pm * 256; const int b = grow0 / SEQ; const int row0 = grow0 + wr * 64 + fr, col0 = u.pn * 256 + wc * 32 + 4 * fq;
        f32x4 gv[2][2];
#pragma unroll
        for (int bj = 0; bj < 2; ++bj)
#pragma unroll
            for (int n = 0; n < 2; ++n) gv[bj][n] = *(const f32x4*)(gate + (size_t)b * 6144 + col0 + bj * 128 + n * 16);
#pragma unroll
        for (int ai = 0; ai < 2; ++ai)
#pragma unroll
            for (int m = 0; m < 4; ++m) { const size_t off = (size_t)(row0 + ai * 128 + m * 16) * DM + col0;
#pragma unroll
                for (int bj = 0; bj < 2; ++bj)
#pragma unroll
                    for (int n = 0; n < 2; ++n) { const f32x4 r = *(const f32x4*)(res + off + bj * 128 + n * 16); *(f32x4*)(out + off + bj * 128 + n * 16) = r + gv[bj][n] * acc[ai][bj][m][n]; }
                asm volatile("" ::: "memory"); }
    }
};


#define XB_TMO      128
#define XB_XCNT(j)  (256  + 64 * (j))
#define XB_XSUB(j)  (1280 + 64 * (j))
#define XB_XGEN(j)  (2304 + 64 * (j))
#define XB_TOP      3328
#define XB_TOPGEN   3392
#define XCD_BAR_WORDS 3456
#define XB_SPIN_CAP (1u << 22)
__device__ __forceinline__ unsigned xb_ld(unsigned* p)              { return __hip_atomic_load(p, __ATOMIC_RELAXED, __HIP_MEMORY_SCOPE_AGENT); }
__device__ __forceinline__ unsigned xb_add(unsigned* p, unsigned v) { return __hip_atomic_fetch_add(p, v, __ATOMIC_RELAXED, __HIP_MEMORY_SCOPE_AGENT); }
__device__ __forceinline__ unsigned xb_xcc_id() { return (unsigned)__builtin_amdgcn_s_getreg((3 << 11) | 20) & 0xFu; }
#define XB_SPIN(cond, bar) do { unsigned _sp = 0; while (cond) { __builtin_amdgcn_s_sleep(1); \
    if ((++_sp & 255u) == 0u) { if (xb_ld(&(bar)[XB_TMO])) break; if (_sp > XB_SPIN_CAP) { atomicAdd(&(bar)[XB_TMO], 1u); break; } } } } while (0)
struct XcdBarrier { unsigned* bar; unsigned x; volatile LAS unsigned* st; };
__device__ __forceinline__ XcdBarrier xcd_barrier_post(unsigned* bar, volatile LAS unsigned* st) {
    XcdBarrier b; b.bar = bar; b.x = xb_xcc_id(); b.st = st;
    if (threadIdx.x == 0) (void)xb_add(&bar[XB_XCNT(b.x)], 1u);
    return b;
}
__device__ __forceinline__ void xcd_barrier_complete(unsigned* bar, unsigned x, unsigned& nloc, unsigned& nx) {
    const unsigned G = gridDim.x * gridDim.y * gridDim.z;
    unsigned sum, cnt, mine, sp = 0u;
    for (;;) {
        sum = 0u; cnt = 0u; mine = 0u;
#pragma unroll
        for (unsigned j = 0; j < 16; ++j) { const unsigned c = xb_ld(&bar[XB_XCNT(j)]); sum += c; cnt += (c > 0u) ? 1u : 0u; mine = (j == x) ? c : mine; }
        if (sum == G) break;
        __builtin_amdgcn_s_sleep(1);
        if ((++sp & 255u) == 0u) { if (xb_ld(&bar[XB_TMO])) break; if (sp > XB_SPIN_CAP) { atomicAdd(&bar[XB_TMO], 1u); break; } }
    }
    nloc = mine > 0u ? mine : 1u; nx = cnt > 0u ? cnt : 1u;
}
__device__ __forceinline__ void xcd_barrier(const XcdBarrier& b, const int wv) {
    asm volatile("s_waitcnt vmcnt(0)" ::: "memory");
    __syncthreads();
    if (opaque_tid(wv) == 0) {
        unsigned* bar = b.bar;
        __builtin_amdgcn_s_waitcnt(0);
        unsigned nloc = b.st[0], nx = b.st[1];
        if (nloc == 0u) { xcd_barrier_complete(bar, b.x, nloc, nx); b.st[0] = nloc; b.st[1] = nx; }
        const unsigned old = xb_add(&bar[XB_XSUB(b.x)], 1u);
        const unsigned gen = old / nloc;
        if (old + 1u == (gen + 1u) * nloc) {
            __builtin_amdgcn_fence(__ATOMIC_RELEASE, "agent");
            asm volatile("s_waitcnt vmcnt(0)" ::: "memory");
            const unsigned og = xb_add(&bar[XB_TOP], 1u);
            const unsigned tg = og / nx;
            if (og + 1u == (tg + 1u) * nx) xb_add(&bar[XB_TOPGEN], 1u);
            else XB_SPIN(xb_ld(&bar[XB_TOPGEN]) == tg, bar);
            __builtin_amdgcn_fence(__ATOMIC_ACQUIRE, "agent");
            xb_add(&bar[XB_XGEN(b.x)], 1u);
            asm volatile("s_waitcnt vmcnt(0)" ::: "memory");
        } else {
            XB_SPIN(xb_ld(&bar[XB_XGEN(b.x)]) == gen, bar);
            __builtin_amdgcn_fence(__ATOMIC_ACQUIRE, "agent");
            asm volatile("s_waitcnt vmcnt(0)" ::: "memory");
        }
    }
    __syncthreads();
}

__device__ __forceinline__ float dpp_shr1(float x) { return __builtin_bit_cast(float, __builtin_amdgcn_update_dpp(0, __builtin_bit_cast(int, x), 0x111, 0xf, 0xf, false)); }
struct EpiConvAct {
    static constexpr bool PERM = true, AFTER_DRAIN = false;
    bf16_t* act; bf16_t* halo; const float* cw; const float* cb;
    __device__ __forceinline__ void operator()(const f32x4 (&acc)[2][2][4][2], const pg8::Unit& u, int wr, int wc, int fr, int fq) const {
        const int tb = u.pm * 256 + 128 * wr, c0 = u.pn * 128 + wc * 32 + 8 * fq;
        bf16_t* hp = halo + (size_t)(tb >> 7) * 4 * DFF2;
#pragma unroll
        for (int n = 0; n < 2; ++n) {
            const int c = c0 + 4 * n;
            const f32x4 bg = *(const f32x4*)(cb + c), bv = *(const f32x4*)(cb + DFF + c);
            const f32x4 wg0 = *(const f32x4*)(cw + c), wg1 = *(const f32x4*)(cw + DFF2 + c), wg2 = *(const f32x4*)(cw + 2 * DFF2 + c);
            const f32x4 wv0 = *(const f32x4*)(cw + DFF + c), wv1 = *(const f32x4*)(cw + DFF2 + DFF + c), wv2 = *(const f32x4*)(cw + 2 * DFF2 + DFF + c);
            f32x4 pg6, pg7, pv6, pv7;
#pragma unroll
            for (int j = 0; j < 4; ++j) { pg6[j] = dpp_shr1(acc[1][0][2][n][j]); pg7[j] = dpp_shr1(acc[1][0][3][n][j]); pv6[j] = dpp_shr1(acc[1][1][2][n][j]); pv7[j] = dpp_shr1(acc[1][1][3][n][j]); }
#pragma unroll
            for (int q = 0; q < 8; ++q) {
                const f32x4 g = acc[q >> 2][0][q & 3][n], v = acc[q >> 2][1][q & 3][n];
                const f32x4 g1 = q >= 1 ? acc[(q - 1 + 8) % 8 >> 2][0][(q - 1 + 8) % 8 & 3][n] : pg7, g2 = q >= 2 ? acc[(q - 2 + 8) % 8 >> 2][0][(q - 2 + 8) % 8 & 3][n] : (q == 1 ? pg7 : pg6);
                const f32x4 v1 = q >= 1 ? acc[(q - 1 + 8) % 8 >> 2][1][(q - 1 + 8) % 8 & 3][n] : pv7, v2 = q >= 2 ? acc[(q - 2 + 8) % 8 >> 2][1][(q - 2 + 8) % 8 & 3][n] : (q == 1 ? pv7 : pv6);
                const f32x4 g1e = q == 0 ? pg7 : g1, g2e = q == 0 ? pg6 : g2, v1e = q == 0 ? pv7 : v1, v2e = q == 0 ? pv6 : v2;
                float o[4];
#pragma unroll
                for (int j = 0; j < 4; ++j) { const float cg = bg[j] + wg0[j] * g2e[j] + wg1[j] * g1e[j] + wg2[j] * g[j]; const float cv = bv[j] + wv0[j] * v2e[j] + wv1[j] * v1e[j] + wv2[j] * v[j]; o[j] = gelu_tanh(cg) * cv; }
                if (fr > 0 || q >= 2) { u32x2 w; w.x = pk2(o[0], o[1]); w.y = pk2(o[2], o[3]); *(u32x2*)(act + (size_t)(tb + 8 * fr + q) * DFF + c) = w; }
                if ((fr == 0 && q < 2) || (fr == 15 && q >= 6)) { const int r = q < 2 ? q : q - 4; u32x2 wgp, wvp; wgp.x = pk2(g[0], g[1]); wgp.y = pk2(g[2], g[3]); wvp.x = pk2(v[0], v[1]); wvp.y = pk2(v[2], v[3]);
                    *(u32x2*)(hp + (size_t)r * DFF2 + c) = wgp; *(u32x2*)(hp + (size_t)r * DFF2 + DFF + c) = wvp; }
            }
        }
    }
};

struct Args { const float* in[21]; float* out; unsigned char* ws; };
typedef const __attribute__((address_space(4))) Args* ArgsP;

__device__ void p0_mod(ArgsP a, LAS unsigned char* lds, const int wv) {
    const int tid = opaque_tid(wv), w = tid >> 6, lane = tid & 63;
    const float* c = a->in[1]; const float* aw = a->in[2]; const float* ab = a->in[3]; float* mod = (float*)(a->ws + WS_MOD);
    LAS float* red = (LAS float*)lds;
    for (int grp = blockIdx.x; grp < NL * 6144 / 48; grp += gridDim.x) {
        const int gl = grp * 48 + (lane < 48 ? lane : 47), l = gl / 6144, j = gl % 6144;
        const float* wp = aw + (size_t)l * DM * 6144 + j;
        float s0 = 0.f, s1 = 0.f, s2 = 0.f, s3 = 0.f;
#pragma unroll 16
        for (int k = w * 128; k < w * 128 + 128; ++k) { const float wv = wp[(size_t)k * 6144]; s0 += c[k] * wv; s1 += c[DM + k] * wv; s2 += c[2 * DM + k] * wv; s3 += c[3 * DM + k] * wv; }
        red[(w * 4 + 0) * 64 + lane] = s0; red[(w * 4 + 1) * 64 + lane] = s1; red[(w * 4 + 2) * 64 + lane] = s2; red[(w * 4 + 3) * 64 + lane] = s3;
        __syncthreads();
        if (tid < 256 && lane < 48) { const int b = tid >> 6; float s = ab[(size_t)l * 6144 + j];
#pragma unroll
            for (int ww = 0; ww < 8; ++ww) s += red[(ww * 4 + b) * 64 + lane];
            mod[((size_t)l * NB + b) * 6144 + j] = s; }
        __syncthreads();
    }
    bf16_t* gw = (bf16_t*)(a->ws + WS_GW);
    for (size_t idx = (size_t)blockIdx.x * NTH + tid; idx < (size_t)NL * 2 * 8 * 128 * 128; idx += (size_t)gridDim.x * NTH) {
        const int i = idx & 127, j = (idx >> 7) & 127, h = (idx >> 14) & 7, mat = (idx >> 17) & 1, l = (int)(idx >> 18);
        const float* src = a->in[mat ? 10 : 8];
        const float v = src[(((size_t)l * 8 + h) * 128 + i) * 128 + j];
        gw[idx] = (bf16_t)(pk2(v, v) & 0xffff);
    }
}
struct TMat { const float* W; bf16_t* Wt; int K, N, rmode, ntn; };
__device__ __forceinline__ TMat tmat_of(ArgsP a, int mi) {
    const int l = mi >> 2, k = mi & 3; bf16_t* wl = (bf16_t*)(a->ws + WS_W) + (size_t)l * W_LAYER_E; TMat m;
    if (k == 0) { m.W = a->in[5] + (size_t)l * DM * DIN; m.Wt = wl; m.K = DM; m.N = DIN; m.rmode = 1; }
    else if (k == 1) { m.W = a->in[15] + (size_t)l * DM * DM; m.Wt = wl + W_IN_E; m.K = DM; m.N = DM; m.rmode = 0; }
    else if (k == 2) { m.W = a->in[17] + (size_t)l * DM * DFF2; m.Wt = wl + W_IN_E + W_OUT_E; m.K = DM; m.N = DFF2; m.rmode = 2; }
    else { m.W = a->in[20] + (size_t)l * DFF * DM; m.Wt = wl + W_IN_E + W_OUT_E + W_UP_E; m.K = DFF; m.N = DM; m.rmode = 0; }
    m.ntn = m.N / 64; return m;
}
constexpr int TILES_IN = (DM / 64) * (DIN / 64), TILES_OUT = (DM / 64) * (DM / 64), TILES_UP = (DM / 64) * (DFF2 / 64), TILES_DN = (DFF / 64) * (DM / 64), TILES_L = TILES_IN + TILES_OUT + TILES_UP + TILES_DN;
__device__ __forceinline__ void tile_of(int g, int& mi, int& tile) {
    const int l = g / TILES_L; int r = g - l * TILES_L; int k = 0;
    if (r >= TILES_IN) { r -= TILES_IN; k = 1; if (r >= TILES_OUT) { r -= TILES_OUT; k = 2; if (r >= TILES_UP) { r -= TILES_UP; k = 3; } } }
    mi = l * 4 + k; tile = r;
}
__device__ void p0_weights(ArgsP a, LAS unsigned char* lds, const int wv) {
    LAS float* t = (LAS float*)lds;
    const int tid = opaque_tid(wv); const int G = gridDim.x;
    int g = blockIdx.x; if (g >= NL * TILES_L) return;
    int mi, tile; tile_of(g, mi, tile); TMat m = tmat_of(a, mi);
    f32x4 v0, v1;
    { const int k0 = (tile / m.ntn) * 64, n0 = (tile % m.ntn) * 64; const float* p = m.W + (size_t)(k0 + (tid >> 4)) * m.N + n0 + (tid & 15) * 4; v0 = *(const f32x4*)p; v1 = *(const f32x4*)(p + (size_t)32 * m.N); }
    for (;;) {
        const int k0 = (tile / m.ntn) * 64, n0 = (tile % m.ntn) * 64; const TMat cm = m;
        { const int k = tid >> 4, n = (tid & 15) * 4;
          t[k * 65 + n] = v0[0]; t[k * 65 + n + 1] = v0[1]; t[k * 65 + n + 2] = v0[2]; t[k * 65 + n + 3] = v0[3];
          t[(k + 32) * 65 + n] = v1[0]; t[(k + 32) * 65 + n + 1] = v1[1]; t[(k + 32) * 65 + n + 2] = v1[2]; t[(k + 32) * 65 + n + 3] = v1[3]; }
        g += G; const bool more = g < NL * TILES_L;
        if (more) { tile_of(g, mi, tile); m = tmat_of(a, mi); const int k1 = (tile / m.ntn) * 64, n1 = (tile % m.ntn) * 64;
            const float* p = m.W + (size_t)(k1 + (tid >> 4)) * m.N + n1 + (tid & 15) * 4; v0 = *(const f32x4*)p; v1 = *(const f32x4*)(p + (size_t)32 * m.N); }
        __syncthreads();
        { const int n = tid >> 3, p = tid & 7; float v[8];
#pragma unroll
          for (int e = 0; e < 8; ++e) v[e] = t[(p * 8 + e) * 65 + n];
          u32x4 w; w.x = pk2(v[0], v[1]); w.y = pk2(v[2], v[3]); w.z = pk2(v[4], v[5]); w.w = pk2(v[6], v[7]);
          int nr = n0 + n; if (cm.rmode == 1) nr = nr < 2048 ? nr : (nr < 5120 ? nr + 2048 : nr - 3072);
          else if (cm.rmode == 2) nr = nr < DFF ? ((nr >> 7) * 256 + (nr & 127)) : (((nr - DFF) >> 7) * 256 + 128 + ((nr - DFF) & 127));
          *(u32x4*)(cm.Wt + (size_t)nr * cm.K + k0 + p * 8) = w; }
        __syncthreads();
        if (!more) break;
    }
}
__device__ void norm_phase(const float* __restrict__ x, const float* __restrict__ g, const float* __restrict__ modl  , int shk, int sck, bf16_t* __restrict__ xn, const int wv) {
    const int tid = opaque_tid(wv); const int w = tid >> 6, lane = tid & 63;
    for (int row = blockIdx.x * 8 + w; row < MTOK; row += gridDim.x * 8) {
        const int b = row / SEQ; const float* xr = x + (size_t)row * DM; f32x4 v[4]; float ss = 0.f;
#pragma unroll
        for (int i = 0; i < 4; ++i) { v[i] = *(const f32x4*)(xr + lane * 4 + 256 * i); ss += v[i][0] * v[i][0] + v[i][1] * v[i][1] + v[i][2] * v[i][2] + v[i][3] * v[i][3]; }
#pragma unroll
        for (int o = 32; o >= 1; o >>= 1) ss += __shfl_xor(ss, o);
        const float rstd = rsqrtf(ss * (1.0f / DM) + EPS);
        const float* sh = modl + (size_t)b * 6144 + shk * 1024; const float* sc = modl + (size_t)b * 6144 + sck * 1024;
#pragma unroll
        for (int i = 0; i < 4; ++i) { const int c = lane * 4 + 256 * i; const f32x4 gg = *(const f32x4*)(g + c), s1 = *(const f32x4*)(sc + c), s0 = *(const f32x4*)(sh + c);
            f32x4 y;
#pragma unroll
            for (int j = 0; j < 4; ++j) y[j] = v[i][j] * rstd * gg[j] * (1.0f + s1[j]) + s0[j];
            u32x2 o; o.x = pk2(y[0], y[1]); o.y = pk2(y[2], y[3]); *(u32x2*)(xn + (size_t)row * DM + c) = o; }
    }
}
constexpr int KP = 272, VP = 136;
constexpr float DEAD = -110.0f;
__device__ void attn_phase(ArgsP a, int l, LAS unsigned char* lds, const int wv) {
    const int tid = opaque_tid(wv), w = __builtin_amdgcn_readfirstlane(tid >> 6), lane = tid & 63, fr = lane & 15, fq = lane >> 4;
    LAS unsigned char* Ks = lds; LAS unsigned char* Vt = lds + 64 * KP; LAS int* flags = (LAS int*)(lds + 64 * KP + 128 * VP);
    const bf16_t* Qb = (const bf16_t*)(a->ws + WS_P); bf16_t* Yb = (bf16_t*)(a->ws + WS_P + 3 * PBUF); const bf16_t* Kb = (const bf16_t*)(a->ws + WS_P + PBUF); const bf16_t* Vb = (const bf16_t*)(a->ws + WS_P + 2 * PBUF);
    const float* gq = a->in[13] + l * 128; const float* gk = a->in[14] + l * 128;
    const int sp = tid & 15, skey = tid >> 4;
    float gks[8];
#pragma unroll
    for (int e = 0; e < 8; ++e) gks[e] = gk[sp * 8 + e];
    const int nunits = NB * 8 * (SEQ / 256);
    for (int unit = blockIdx.x; unit < nunits; unit += gridDim.x) {
        const int qt = (SEQ / 256 - 1) - unit / (NB * 8), bh = unit % (NB * 8), b = bh >> 3, hh = bh & 7;
        const size_t rowbase = (size_t)b * SEQ; const int t0 = qt * 256, r0 = t0 + 32 * w;
        bf16x8 qf[2][4];
#pragma unroll
        for (int rb = 0; rb < 2; ++rb) {
            const bf16_t* qp = Qb + (rowbase + r0 + 16 * rb + fr) * DM + hh * 128 + 8 * fq; u32x4 raw[4]; float ss = 0.f;
#pragma unroll
            for (int ks = 0; ks < 4; ++ks) { raw[ks] = *(const u32x4*)(qp + 32 * ks);
#pragma unroll
                for (int j = 0; j < 4; ++j) { const float x0 = bflo(raw[ks][j]), x1 = bfhi(raw[ks][j]); ss += x0 * x0 + x1 * x1; } }
            ss += __shfl_xor(ss, 16); ss += __shfl_xor(ss, 32);
            const float rs = rsqrtf(ss * (1.0f / 128.0f) + EPS) * 0.08838834764831845f;
#pragma unroll
            for (int ks = 0; ks < 4; ++ks) { u32x4 o;
#pragma unroll
                for (int j = 0; j < 4; ++j) { const int d = 32 * ks + 8 * fq + 2 * j; o[j] = pk2(bflo(raw[ks][j]) * rs * gq[d], bfhi(raw[ks][j]) * rs * gq[d + 1]); }
                qf[rb][ks] = __builtin_bit_cast(bf16x8, o); }
        }
        f32x4 O[2][8];
#pragma unroll
        for (int rb = 0; rb < 2; ++rb)
#pragma unroll
            for (int db = 0; db < 8; ++db) O[rb][db] = (f32x4){0.f, 0.f, 0.f, 0.f};
        float carry[2] = {0.f, 0.f};
        bool alive = true;
        for (int kb = qt * 4 + 3; kb >= 0; --kb) {
#pragma unroll
            for (int i = 0; i < 2; ++i) { const int key = skey + 32 * i; const size_t grow = rowbase + kb * 64 + key;
                const u32x4 kr = *(const u32x4*)(Kb + grow * DM + hh * 128 + sp * 8); const u32x4 vr = *(const u32x4*)(Vb + grow * DM + hh * 128 + sp * 8);
                float x[8]; float ss = 0.f;
#pragma unroll
                for (int j = 0; j < 4; ++j) { x[2 * j] = bflo(kr[j]); x[2 * j + 1] = bfhi(kr[j]); ss += x[2 * j] * x[2 * j] + x[2 * j + 1] * x[2 * j + 1]; }
                ss += __shfl_xor(ss, 1); ss += __shfl_xor(ss, 2); ss += __shfl_xor(ss, 4); ss += __shfl_xor(ss, 8);
                const float rs = rsqrtf(ss * (1.0f / 128.0f) + EPS);
                u32x4 o;
#pragma unroll
                for (int j = 0; j < 4; ++j) o[j] = pk2(x[2 * j] * rs * gks[2 * j], x[2 * j + 1] * rs * gks[2 * j + 1]);
                *(LAS u32x4*)(Ks + key * KP + sp * 16) = o;
#pragma unroll
                for (int j = 0; j < 4; ++j) { *(LAS bf16_t*)(Vt + (sp * 8 + 2 * j) * VP + key * 2) = (bf16_t)(vr[j] & 0xffff); *(LAS bf16_t*)(Vt + (sp * 8 + 2 * j + 1) * VP + key * 2) = (bf16_t)(vr[j] >> 16); }
            }
            __syncthreads();
            const bool active = alive && (kb * 64 < r0 + 31);
            if (active) {
                f32x4 S[2][4];
#pragma unroll
                for (int nb = 0; nb < 4; ++nb) {
                    bf16x8 kf[4];
#pragma unroll
                    for (int ks = 0; ks < 4; ++ks) kf[ks] = *(const LAS bf16x8*)(Ks + (16 * nb + fr) * KP + (32 * ks + 8 * fq) * 2);
#pragma unroll
                    for (int rb = 0; rb < 2; ++rb) { f32x4 s = (f32x4){0.f, 0.f, 0.f, 0.f};
#pragma unroll
                        for (int ks = 0; ks < 4; ++ks) s = __builtin_amdgcn_mfma_f32_16x16x32_bf16(kf[ks], qf[rb][ks], s, 0, 0, 0);
                        S[rb][nb] = s; }
                }
                unsigned pw[2][4][2];
#pragma unroll
                for (int rb = 0; rb < 2; ++rb) {
                    const int q = r0 + 16 * rb + fr; float lbv[4][4], suf[4][4], T[4], ab[4];
#pragma unroll
                    for (int nb = 0; nb < 4; ++nb) { float run = 0.f;
#pragma unroll
                        for (int e = 3; e >= 0; --e) { const int key = kb * 64 + 16 * nb + 4 * fq + e; const float z = S[rb][nb][e];
                            const float lb = fminf(z, 0.f) - __logf(1.0f + __expf(-fabsf(z))); const bool mk = key < q;
                            lbv[nb][e] = mk ? lb : -1e30f; suf[nb][e] = run; run += mk ? (lb - z) : 0.f; }
                        const float g1 = __shfl_xor(run, 16), g2 = __shfl_xor(run, 32), g3 = __shfl_xor(g1, 32);
                        T[nb] = run + g1 + g2 + g3; ab[nb] = fq == 0 ? (g1 + g2 + g3) : fq == 1 ? (g2 + g3) : fq == 2 ? g1 : 0.f; }
                    float hi = carry[rb];
#pragma unroll
                    for (int nb = 3; nb >= 0; --nb) { const float base = hi + ab[nb]; float p[4];
#pragma unroll
                        for (int e = 0; e < 4; ++e) p[e] = __expf(lbv[nb][e] + base + suf[nb][e]);
                        pw[rb][nb][0] = pk2(p[0], p[1]); pw[rb][nb][1] = pk2(p[2], p[3]); hi += T[nb]; }
                    carry[rb] = hi;
                }
#pragma unroll
                for (int ks2 = 0; ks2 < 2; ++ks2) {
                    bf16x8 pf[2];
#pragma unroll
                    for (int rb = 0; rb < 2; ++rb) { u32x4 t; t.x = pw[rb][2 * ks2][0]; t.y = pw[rb][2 * ks2][1]; t.z = pw[rb][2 * ks2 + 1][0]; t.w = pw[rb][2 * ks2 + 1][1]; pf[rb] = __builtin_bit_cast(bf16x8, t); }
#pragma unroll
                    for (int db = 0; db < 8; ++db) { const LAS unsigned char* vp = Vt + (16 * db + fr) * VP + (32 * ks2 + 4 * fq) * 2;
                        const u32x2 va = *(const LAS u32x2*)vp, vb = *(const LAS u32x2*)(vp + 32); u32x4 t; t.x = va.x; t.y = va.y; t.z = vb.x; t.w = vb.y; const bf16x8 vf = __builtin_bit_cast(bf16x8, t);
#pragma unroll
                        for (int rb = 0; rb < 2; ++rb) O[rb][db] = __builtin_amdgcn_mfma_f32_16x16x32_bf16(vf, pf[rb], O[rb][db], 0, 0, 0); }
                }
                alive = !__all((carry[0] < DEAD) && (carry[1] < DEAD));
            }
            if (lane == 0) flags[w] = alive ? 1 : 0;
            __syncthreads();
            int any = 0;
#pragma unroll
            for (int ww = 0; ww < 8; ++ww) any |= flags[ww];
            if (!any) break;
        }
#pragma unroll
        for (int rb = 0; rb < 2; ++rb) { bf16_t* op = Yb + (rowbase + r0 + 16 * rb + fr) * DM + hh * 128 + 4 * fq;
#pragma unroll
            for (int db = 0; db < 8; ++db) { u32x2 o; o.x = pk2(O[rb][db][0], O[rb][db][1]); o.y = pk2(O[rb][db][2], O[rb][db][3]); *(u32x2*)(op + 16 * db) = o; } }
        __syncthreads();
    }
}
constexpr int XP = 272;
template <bool FINAL>
__device__ void rnn_phase(ArgsP a, int l, LAS unsigned char* lds, const int wv) {
    const int tid = opaque_tid(wv), w = __builtin_amdgcn_readfirstlane(tid >> 6), lane = tid & 63, fr = lane & 15, fq = lane >> 4;
    LAS unsigned char* XC = lds; LAS unsigned char* HT = lds + RT * XP;
    const bf16_t* XR = (const bf16_t*)(a->ws + WS_P); const bf16_t* GY = (const bf16_t*)(a->ws + WS_P + PBUF); const bf16_t* SGA = (const bf16_t*)(a->ws + WS_P + 2 * PBUF);
    const bf16_t* SGB = (const bf16_t*)(a->ws + WS_P + 4 * PBUF); const bf16_t* YB = (const bf16_t*)(a->ws + WS_P + 3 * PBUF); bf16_t* MIX = (bf16_t*)(a->ws + WS_XN);
    float* SUM = (float*)(a->ws + WS_SUM); const float* HIN = (const float*)(a->ws + WS_HIN);
    const bf16_t* gw = (const bf16_t*)(a->ws + WS_GW) + (size_t)l * 2 * 8 * 16384;
    const float* cw = a->in[6] + (size_t)l * 4 * DM; const float* cb = a->in[7] + (size_t)l * DM;
    const float* ba = a->in[9] + (size_t)l * DM; const float* bx = a->in[11] + (size_t)l * DM; const float* lam = a->in[12] + (size_t)l * DM;
    const int sp = tid & 15, stok = tid >> 4;
    const int nunits = NB * 8 * NT;
    for (int unit = blockIdx.x; unit < nunits; unit += gridDim.x) {
        const int hh = unit & 7, b = (unit >> 3) & 3, j = unit >> 5; const int t0 = j * RT; const size_t rowbase = (size_t)b * SEQ;
        const int cbase = hh * 128;
        { float wv[4][8], bv[8];
#pragma unroll
          for (int e = 0; e < 8; ++e) { bv[e] = cb[cbase + sp * 8 + e];
#pragma unroll
              for (int k = 0; k < 4; ++k) wv[k][e] = cw[k * DM + cbase + sp * 8 + e]; }
#pragma unroll
          for (int i = 0; i < 4; ++i) { const int t = t0 + stok + 32 * i; float acc[8];
#pragma unroll
              for (int e = 0; e < 8; ++e) acc[e] = bv[e];
#pragma unroll
              for (int k = 0; k < 4; ++k) { const int ts = t - 3 + k; if (ts >= 0) { const u32x4 r = *(const u32x4*)(XR + (rowbase + ts) * DM + cbase + sp * 8);
#pragma unroll
                  for (int jj = 0; jj < 4; ++jj) { acc[2 * jj] += wv[k][2 * jj] * bflo(r[jj]); acc[2 * jj + 1] += wv[k][2 * jj + 1] * bfhi(r[jj]); } } }
              u32x4 o; o.x = pk2(acc[0], acc[1]); o.y = pk2(acc[2], acc[3]); o.z = pk2(acc[4], acc[5]); o.w = pk2(acc[6], acc[7]);
              *(LAS u32x4*)(XC + (stok + 32 * i) * XP + sp * 16) = o; } }
        bf16x8 wa[4], wx[4];
        { const bf16_t* pa = gw + ((size_t)(0 * 8 + hh) * 128 + 16 * w + fr) * 128 + 8 * fq; const bf16_t* px = gw + ((size_t)(1 * 8 + hh) * 128 + 16 * w + fr) * 128 + 8 * fq;
#pragma unroll
          for (int ks = 0; ks < 4; ++ks) { wa[ks] = *(const bf16x8*)(pa + 32 * ks); wx[ks] = *(const bf16x8*)(px + 32 * ks); } }
        const int c = cbase + 16 * w + fr;
        const float bac = ba[c], bxc = bx[c]; const float lm = lam[c]; const float sp8 = 8.0f * (fmaxf(-lm, 0.f) + __logf(1.0f + __expf(-fabsf(lm))));
        __syncthreads();
        f32x4 A[8], U[8];
#pragma unroll
        for (int mb = 0; mb < 8; ++mb) { f32x4 ra = (f32x4){0.f, 0.f, 0.f, 0.f}, rx = ra;
#pragma unroll
            for (int ks = 0; ks < 4; ++ks) { const bf16x8 xf = *(const LAS bf16x8*)(XC + (16 * mb + fr) * XP + (32 * ks + 8 * fq) * 2);
                ra = __builtin_amdgcn_mfma_f32_16x16x32_bf16(xf, wa[ks], ra, 0, 0, 0); rx = __builtin_amdgcn_mfma_f32_16x16x32_bf16(xf, wx[ks], rx, 0, 0, 0); }
#pragma unroll
            for (int e = 0; e < 4; ++e) { const float r = sigmoidf_(ra[e] + bac), ig = sigmoidf_(rx[e] + bxc); const float la = -sp8 * r; const float av = __expf(la);
                const float x2 = 2.0f * la; const float om = x2 > -0.02f ? -x2 * (1.0f + x2 * (0.5f + x2 * (1.0f / 6.0f))) : 1.0f - av * av;
                const float xc = bf2f(*(const LAS bf16_t*)(XC + (16 * mb + 4 * fq + e) * XP + (16 * w + fr) * 2));
                ra[e] = av; rx[e] = sqrtf(om) * ig * xc; }
            A[mb] = ra; U[mb] = rx; }
        float H = 0.f, Pp = 1.0f;
        if (FINAL) H = HIN[((size_t)b * NT + j) * DM + c];
#pragma unroll
        for (int mb = 0; mb < 8; ++mb) {
            float Ag = A[mb][0] * A[mb][1] * A[mb][2] * A[mb][3];
            float Ug = ((U[mb][0] * A[mb][1] + U[mb][1]) * A[mb][2] + U[mb][2]) * A[mb][3] + U[mb][3];
            { const float a1 = __shfl_up(Ag, 16), u1 = __shfl_up(Ug, 16); if (fq >= 1) { Ug = Ag * u1 + Ug; Ag = Ag * a1; } }
            { const float a2 = __shfl_up(Ag, 32), u2 = __shfl_up(Ug, 32); if (fq >= 2) { Ug = Ag * u2 + Ug; Ag = Ag * a2; } }
            if (FINAL) {
                const float ap = __shfl_up(Ag, 16), up = __shfl_up(Ug, 16);
                float h = fq == 0 ? H : ap * H + up;
#pragma unroll
                for (int e = 0; e < 4; ++e) { h = A[mb][e] * h + U[mb][e]; *(LAS bf16_t*)(HT + (16 * mb + 4 * fq + e) * XP + (16 * w + fr) * 2) = (bf16_t)(pk2(h, h) & 0xffff); }
            }
            const float Am = __shfl(Ag, 48 + fr), Um = __shfl(Ug, 48 + fr);
            H = Am * H + Um; Pp *= Am;
        }
        if (!FINAL) { if (fq == 0) { float* s = SUM + (((size_t)b * NT + j) * DM + c) * 2; s[0] = Pp; s[1] = H; } }
        else {
            __syncthreads();
#pragma unroll
            for (int i = 0; i < 4; ++i) { const int tl = stok + 32 * i; const size_t go = (rowbase + t0 + tl) * DM + cbase + sp * 8;
                const u32x4 hv = *(const LAS u32x4*)(HT + tl * XP + sp * 16); const u32x4 g = *(const u32x4*)(GY + go), s1 = *(const u32x4*)(SGA + go), s2 = *(const u32x4*)(SGB + go), yb = *(const u32x4*)(YB + go);
                u32x4 o;
#pragma unroll
                for (int jj = 0; jj < 4; ++jj) o[jj] = pk2(bflo(s1[jj]) * bflo(hv[jj]) * bflo(g[jj]) + bflo(s2[jj]) * bflo(yb[jj]), bfhi(s1[jj]) * bfhi(hv[jj]) * bfhi(g[jj]) + bfhi(s2[jj]) * bfhi(yb[jj]));
                *(u32x4*)(MIX + go) = o; }
        }
        __syncthreads();
    }
}
__device__ void carry_phase(ArgsP a, const int wv) {
    const float* SUM = (const float*)(a->ws + WS_SUM); float* HIN = (float*)(a->ws + WS_HIN);
    const int gt = blockIdx.x * NTH + opaque_tid(wv); if (gt >= NB * DM) return;
    const int b = gt / DM, c = gt % DM; float H = 0.f;
#pragma unroll 8
    for (int j = 0; j < NT; ++j) { const size_t o = ((size_t)b * NT + j) * DM + c; HIN[o] = H; const float p = SUM[o * 2], h = SUM[o * 2 + 1]; H = p * H + h; }
}
__device__ void ffn_fixup(ArgsP a, int l, const int wv) {
    bf16_t* ACT = (bf16_t*)(a->ws + WS_P); const bf16_t* HALO = (const bf16_t*)(a->ws + WS_P + ACT_BYTES);
    const float* cw = a->in[18] + (size_t)l * 3 * DFF2; const float* cb = a->in[19] + (size_t)l * DFF2;
    const int nitems = (MTOK / 128) * (DFF / 8);
    for (int it = blockIdx.x * NTH + opaque_tid(wv); it < nitems; it += gridDim.x * NTH) {
        const int cgp = it % (DFF / 8), wb = it / (DFF / 8); const int c0 = cgp * 8, t0 = wb * 128; const bool first = (t0 & (SEQ - 1)) == 0;
        const bf16_t* hc = HALO + (size_t)wb * 4 * DFF2; const bf16_t* hpv = hc - 4 * DFF2;
        u32x4 z = (u32x4){0, 0, 0, 0}; u32x4 gm2 = z, gm1 = z, vm2 = z, vm1 = z;
        if (!first) { gm2 = *(const u32x4*)(hpv + 2 * DFF2 + c0); gm1 = *(const u32x4*)(hpv + 3 * DFF2 + c0); vm2 = *(const u32x4*)(hpv + 2 * DFF2 + DFF + c0); vm1 = *(const u32x4*)(hpv + 3 * DFF2 + DFF + c0); }
        const u32x4 g0 = *(const u32x4*)(hc + c0), g1 = *(const u32x4*)(hc + DFF2 + c0), v0 = *(const u32x4*)(hc + DFF + c0), v1 = *(const u32x4*)(hc + DFF2 + DFF + c0);
        u32x4 o0, o1;
#pragma unroll
        for (int jj = 0; jj < 4; ++jj) {
            float r0[2], r1[2];
#pragma unroll
            for (int hl = 0; hl < 2; ++hl) { const int c = c0 + 2 * jj + hl;
                const float wg0 = cw[c], wg1 = cw[DFF2 + c], wg2 = cw[2 * DFF2 + c], wv0 = cw[DFF + c], wv1 = cw[DFF2 + DFF + c], wv2 = cw[2 * DFF2 + DFF + c], bg = cb[c], bv = cb[DFF + c];
                const float G2 = hl ? bfhi(gm2[jj]) : bflo(gm2[jj]), G1 = hl ? bfhi(gm1[jj]) : bflo(gm1[jj]), Ga = hl ? bfhi(g0[jj]) : bflo(g0[jj]), Gb = hl ? bfhi(g1[jj]) : bflo(g1[jj]);
                const float V2 = hl ? bfhi(vm2[jj]) : bflo(vm2[jj]), V1 = hl ? bfhi(vm1[jj]) : bflo(vm1[jj]), Va = hl ? bfhi(v0[jj]) : bflo(v0[jj]), Vb = hl ? bfhi(v1[jj]) : bflo(v1[jj]);
                r0[hl] = gelu_tanh(bg + wg0 * G2 + wg1 * G1 + wg2 * Ga) * (bv + wv0 * V2 + wv1 * V1 + wv2 * Va);
                r1[hl] = gelu_tanh(bg + wg0 * G1 + wg1 * Ga + wg2 * Gb) * (bv + wv0 * V1 + wv1 * Va + wv2 * Vb); }
            o0[jj] = pk2(r0[0], r0[1]); o1[jj] = pk2(r1[0], r1[1]); }
        *(u32x4*)(ACT + (size_t)t0 * DFF + c0) = o0; *(u32x4*)(ACT + (size_t)(t0 + 1) * DFF + c0) = o1;
    }
}
constexpr int LDS_BYTES = 136 * 1024;
__global__ void __launch_bounds__(NTH, 2) mk_fwd(Args a_unused) {
    ArgsP a = (ArgsP)__builtin_amdgcn_kernarg_segment_ptr(); asm volatile("" : "+s"(a));
    const int wv = __builtin_amdgcn_readfirstlane(threadIdx.x >> 6);
    extern __shared__ __attribute__((aligned(16))) unsigned char lds_raw[];
    LAS unsigned char* lds = (LAS unsigned char*)lds_raw;
    cg::grid_group grid = cg::this_grid();
    volatile LAS unsigned* xbst = (volatile LAS unsigned*)(lds + LDS_BYTES - 16);
    if (threadIdx.x < 4) xbst[threadIdx.x] = 0u;
    __syncthreads();
    const XcdBarrier xbar = xcd_barrier_post((unsigned*)(a->ws + WS_BAR), xbst);
    const int G = gridDim.x, bid = blockIdx.x;
    float* mod = (float*)(a->ws + WS_MOD);
    bf16_t* XN = (bf16_t*)(a->ws + WS_XN); bf16_t* P = (bf16_t*)(a->ws + WS_P);
#ifndef REPMASK
#define REPMASK 0
#endif
#ifndef XSYNC
#define XSYNC 0
#endif
#define RUN(k, ...) for (int _r = 0; _r < (((REPMASK >> (k)) & 1) ? 2 : 1); ++_r) { __VA_ARGS__ xcd_barrier(xbar, wv); }
    for (int _r = 0; _r < ((REPMASK & 1) ? 2 : 1); ++_r) { p0_mod(a, lds, wv); p0_weights(a, lds, wv); grid.sync(); }
    for (int _x = 0; _x < XSYNC; ++_x) xcd_barrier(xbar, wv);
    for (int l = 0; l < NL; ++l) {
        const float* modl = mod + (size_t)l * NB * 6144;
        const bf16_t* wl = (const bf16_t*)(a->ws + WS_W) + (size_t)l * W_LAYER_E;
        const float* xin = l == 0 ? a->in[0] : a->out;
        RUN(1, norm_phase(xin, a->in[4] + l * DM, modl, 0, 1, XN, wv);)
        RUN(2, { pg8::Gemm g{XN, wl + (size_t)4096 * DM, MTOK, 3072, DM}; pg8::StaticOrder S; S.init(MTOK, 3072, G, bid);
          EpiSplit E{P, (size_t)MTOK * DM, 0x0000, 0}; pg8::gemm_phase<EpiSplit, pg8::StaticOrder, true, true>(lds, g, S, E, wv); })
        RUN(3, attn_phase(a, l, lds, wv);)
        RUN(4, { pg8::Gemm g{XN, wl, MTOK, 4096, DM}; pg8::StaticOrder S; S.init(MTOK, 4096, G, bid);
          EpiSplit E{P, (size_t)MTOK * DM, 0x2210, 1}; pg8::gemm_phase<EpiSplit, pg8::StaticOrder, true, true>(lds, g, S, E, wv); })
        RUN(5, rnn_phase<false>(a, l, lds, wv);)
        RUN(6, carry_phase(a, wv);)
        RUN(7, rnn_phase<true>(a, l, lds, wv);)
        RUN(13, { pg8::Gemm g{XN, wl + W_IN_E, MTOK, DM, DM}; pg8::StaticOrder S; S.init(MTOK, DM, G, bid);
          EpiRes E{xin, a->out, modl + 2 * 1024, 0}; pg8::gemm_phase<EpiRes, pg8::StaticOrder, true, true>(lds, g, S, E, wv); })
        RUN(9, norm_phase(a->out, a->in[16] + l * DM, modl, 3, 4, XN, wv);)
        RUN(10, { pg8::Gemm g{XN, wl + W_IN_E + W_OUT_E, MTOK, DFF2, DM}; pg8::StaticOrder S; S.init(MTOK, DFF2, G, bid);
          EpiConvAct E{P, (bf16_t*)(a->ws + WS_P + ACT_BYTES), a->in[18] + (size_t)l * 3 * DFF2, a->in[19] + (size_t)l * DFF2};
          pg8::gemm_phase<EpiConvAct, pg8::StaticOrder, true, true, true>(lds, g, S, E, wv); })
        RUN(11, ffn_fixup(a, l, wv);)
        RUN(13, { pg8::Gemm g{P, wl + W_IN_E + W_OUT_E + W_UP_E, MTOK, DM, DFF}; pg8::StaticOrder S; S.init(MTOK, DM, G, bid);
          EpiRes E{a->out, a->out, modl + 5 * 1024, 0}; pg8::gemm_phase<EpiRes, pg8::StaticOrder, true, true>(lds, g, S, E, wv); })
    }
}
extern "C" void kernel_launch(void* const* d_in, const int* in_sizes, int n_in, void* d_out, int out_size, void* d_ws, size_t ws_size, hipStream_t stream) {
    static int grid = 0;
    if (!grid) {
        int dev = 0, cus = 0, per_cu = 0;
        (void)hipGetDevice(&dev);
        (void)hipDeviceGetAttribute(&cus, hipDeviceAttributeMultiprocessorCount, dev);
        (void)hipFuncSetAttribute((const void*)mk_fwd, hipFuncAttributeMaxDynamicSharedMemorySize, LDS_BYTES);
        (void)hipOccupancyMaxActiveBlocksPerMultiprocessor(&per_cu, (const void*)mk_fwd, NTH, LDS_BYTES);
        if (per_cu < 1) per_cu = 1;
        grid = cus * per_cu;
        if (ws_size < WS_END) { fprintf(stderr, "kernel_launch: workspace too small: %zu < %zu\n", ws_size, (size_t)WS_END); grid = -1; }
        if (n_in != 21 || out_size != MTOK * DM) { fprintf(stderr, "kernel_launch: unexpected shapes\n"); grid = -1; }
    }
    if (grid < 0) return;
    (void)hipMemsetAsync((char*)d_ws + WS_BAR, 0, XCD_BAR_WORDS * 4, stream);
    Args a{};
    for (int i = 0; i < 21; ++i) a.in[i] = (const float*)d_in[i];
    a.out = (float*)d_out; a.ws = (unsigned char*)d_ws;
    void* args[] = {&a};
    hipError_t e = hipLaunchCooperativeKernel((const void*)mk_fwd, dim3(grid), dim3(NTH), args, LDS_BYTES, stream);
    if (e != hipSuccess) fprintf(stderr, "cooperative launch failed: %s (grid %d)\n", hipGetErrorString(e), grid);
}
```

```cpp
#include <hip/hip_runtime.h>
#include <hip/hip_cooperative_groups.h>
#include <cstdio>
#include <cstdint>
namespace cg = cooperative_groups;
__device__ __forceinline__ int opaque_tid(int wv) { int t; asm volatile("v_mbcnt_lo_u32_b32 %0, -1, 0\n\tv_mbcnt_hi_u32_b32 %0, -1, %0" : "=v"(t)); return t | (wv << 6); }
__device__ __forceinline__ int opaque_bid() { int t = blockIdx.x; asm volatile("" : "+s"(t)); return t; }
namespace pg8 {
#define PG8_LAS __attribute__((address_space(3)))
typedef unsigned short bf16_t;
typedef short bf16x8 __attribute__((ext_vector_type(8)));
typedef float f32x4 __attribute__((ext_vector_type(4)));
typedef unsigned u32x4 __attribute__((ext_vector_type(4)));
constexpr int BM = 256, BK = 64, HALF = 128, HTB = HALF * BK * 2  , STAGE_BYTES = 8 * HTB, NXCD = 8, WGM = 8;

__host__ __device__ __forceinline__ int lds_byte(int r, int c) { const int st = (r >> 4) * 2 + (c >> 5), rr = r & 15, cc = c & 31, ob = rr * 64 + cc * 2; return st * 1024 + (ob ^ (((ob >> 9) & 1) << 5)); }
__host__ __device__ __forceinline__ void stage_rc(int b, int& R, int& C) { const int st = b / 1024, sb = b % 1024, swz = sb ^ (((sb >> 9) & 1) << 5); R = (st >> 1) * 16 + swz / 64; C = (st & 1) * 32 + (swz % 64) / 2; }
__host__ __device__ __forceinline__ int perm32(int rho) { const int n = rho >> 4, i = rho & 15; return 8 * (i >> 2) + 4 * n + (i & 3); }

struct Unit { int pm, pn; };
struct Gemm { const bf16_t* A; const bf16_t* Bt; int M, N, K; };

struct StaticOrder {
    int nM, nN, nwg, G, c;
    __host__ __device__ void init(int M, int N, int G_, int c_) { nM = M / BM; nN = N / BM; nwg = nM * nN; G = G_; c = c_; }
    __host__ __device__ bool next(int i, Unit& u) const {
        const long L = (long)i * G + c; if (L >= nwg) return false;
        int wgid = (int)L; { const int q = nwg / NXCD, r = nwg % NXCD, xcd = wgid % NXCD, off = wgid / NXCD; wgid = (xcd < r ? xcd * (q + 1) : r * (q + 1) + (xcd - r) * q) + off; }
        const int nig = WGM * nN, gid = wgid / nig, fm = gid * WGM, gsz = (nM - fm) < WGM ? (nM - fm) : WGM;
        u.pm = fm + ((wgid % nig) % gsz); u.pn = (wgid % nig) / gsz; return true;
    }
    __device__ __forceinline__ void a_ready(const Unit&) const {}
    __device__ __forceinline__ void done(const Unit&) const {}
};

template <class Epi, class Sched, bool ALIGN_EPI = false, bool SP2 = false, bool ROWPERM = false>
__device__ __forceinline__ void gemm_phase(PG8_LAS unsigned char* lds, const Gemm g, const Sched& S, const Epi& E, const int wv) {
    const int tid = opaque_tid(wv), wid = __builtin_amdgcn_readfirstlane(tid >> 6), lane = tid & 63, wr = wid >> 2, wc = wid & 3, fr = lane & 15, fq = lane >> 4;
    const int K = g.K, nt = K / BK;
    unsigned voffA[2], voffB[2];
#pragma unroll
    for (int i = 0; i < 2; ++i) { int R, C; stage_rc(tid * 16 + i * 8192, R, C); const int Rb = Epi::PERM ? ((R & ~31) + perm32(R & 31)) : R;
        const int Ra = ROWPERM ? (128 * (R >> 6) + 8 * (R & 15) + ((R >> 4) & 3)) : R;
        voffA[i] = (unsigned)(Ra * K + C) * 2u; voffB[i] = (unsigned)(Rb * K + C) * 2u; }
    const size_t kstep = (size_t)(BK * 2);
    const size_t hstep = (size_t)HALF * K * 2;
    const size_t tstep = 2 * hstep; const size_t hstepA = ROWPERM ? (size_t)4 * K * 2 : hstep;
    const unsigned ldsw = (unsigned)wid * 1024u;
    const int aoff = lds_byte(wr * 64 + fr, fq * 8), boff = lds_byte(wc * 32 + fr, fq * 8);
#define PG8_SA(b, h) (((b) * 2 + (h)) * HTB)
#define PG8_SB(b, h) ((4 + (b) * 2 + (h)) * HTB)
#define PG8_STAGE(bufoff, gbase, voff) do { _Pragma("unroll") for (int _i = 0; _i < 2; ++_i) \
        __builtin_amdgcn_global_load_lds((const unsigned*)((const char*)(gbase) + (voff)[_i]), (PG8_LAS unsigned*)(lds + (bufoff) + ldsw + _i * 8192), 16, 0, 0); } while (0)
#define PG8_LDA(dst, b, h) do { _Pragma("unroll") for (int m = 0; m < 4; ++m) _Pragma("unroll") for (int k = 0; k < 2; ++k) dst[m][k] = *(const PG8_LAS bf16x8*)(lds + PG8_SA(b, h) + aoff + m * 2048 + k * 1024); } while (0)
#define PG8_LDB(dst, b, h) do { _Pragma("unroll") for (int n = 0; n < 2; ++n) _Pragma("unroll") for (int k = 0; k < 2; ++k) dst[n][k] = *(const PG8_LAS bf16x8*)(lds + PG8_SB(b, h) + boff + n * 2048 + k * 1024); } while (0)
#define PG8_MMA(ai, bj, At, Bt) do { __builtin_amdgcn_s_setprio(1); _Pragma("unroll") for (int m = 0; m < 4; ++m) _Pragma("unroll") for (int n = 0; n < 2; ++n) _Pragma("unroll") for (int k = 0; k < 2; ++k) \
        acc[ai][bj][m][n] = __builtin_amdgcn_mfma_f32_16x16x32_bf16(Bt[n][k], At[m][k], acc[ai][bj][m][n], 0, 0, 0); __builtin_amdgcn_s_setprio(0); } while (0)
#define PG8_WAIT_V(n) asm volatile("s_waitcnt vmcnt(" #n ")" ::: "memory")
#define PG8_WAIT_L(n) asm volatile("s_waitcnt lgkmcnt(" #n ")" ::: "memory")
#define PG8_BAR __builtin_amdgcn_s_barrier()
#define PG8_SCHED __builtin_amdgcn_sched_barrier(0)
    Unit cur, nxt; int ui = 0;
    if (!S.next(0, cur)) return;
    f32x4 acc[2][2][4][2];
#pragma unroll
    for (int a = 0; a < 2; ++a)
#pragma unroll
        for (int b = 0; b < 2; ++b)
#pragma unroll
            for (int m = 0; m < 4; ++m)
#pragma unroll
                for (int n = 0; n < 2; ++n) acc[a][b][m][n] = (f32x4){0.f, 0.f, 0.f, 0.f};
    bf16x8 At[4][2], B0[2][2], B1[2][2];
    const char* cA = (const char*)g.A + (size_t)cur.pm * tstep; const char* cB = (const char*)g.Bt + (size_t)cur.pn * tstep;
    S.a_ready(cur);
    if constexpr (SP2) {
        PG8_STAGE(PG8_SB(0, 0), cB, voffB); PG8_STAGE(PG8_SB(0, 1), cB + hstep, voffB); PG8_STAGE(PG8_SA(0, 0), cA, voffA); PG8_STAGE(PG8_SA(0, 1), cA + hstepA, voffA);
        if (wr == 1) PG8_BAR;
        PG8_WAIT_V(2); PG8_BAR;
        PG8_STAGE(PG8_SB(1, 0), cB + kstep, voffB); PG8_STAGE(PG8_SA(1, 0), cA + kstep, voffA); PG8_STAGE(PG8_SB(1, 1), cB + hstep + kstep, voffB);
        PG8_WAIT_V(6); PG8_BAR;
    } else {
        PG8_STAGE(PG8_SB(0, 0), cB, voffB); PG8_STAGE(PG8_SA(0, 0), cA, voffA); PG8_STAGE(PG8_SB(0, 1), cB + hstep, voffB); PG8_STAGE(PG8_SA(0, 1), cA + hstepA, voffA);
        if (wr == 1) PG8_BAR;
        PG8_WAIT_V(4); PG8_BAR;
        PG8_STAGE(PG8_SB(1, 0), cB + kstep, voffB); PG8_STAGE(PG8_SA(1, 0), cA + kstep, voffA); PG8_STAGE(PG8_SB(1, 1), cB + hstep + kstep, voffB);
        PG8_WAIT_V(6); PG8_BAR;
    }
    for (;;) {
        const bool has_next = S.next(ui + 1, nxt);
        const char* nA = has_next ? (const char*)g.A + (size_t)nxt.pm * tstep : cA; const char* nB = has_next ? (const char*)g.Bt + (size_t)nxt.pn * tstep : cB;
        for (int t = 0; t < nt; t += 2) {
            const bool last = (t == nt - 2);
            const char* a1 = cA + (size_t)(t + 1) * kstep;
            const char* a2 = last ? nA : cA + (size_t)(t + 2) * kstep; const char* b2 = last ? nB : cB + (size_t)(t + 2) * kstep;
            const char* a3 = a2 + kstep; const char* b3 = b2 + kstep;
            if (last && has_next) S.a_ready(nxt);
            if constexpr (SP2) {
            PG8_LDB(B0, 0, 0); PG8_LDB(B1, 0, 1); PG8_SCHED; PG8_LDA(At, 0, 0); PG8_STAGE(PG8_SA(1, 1), a1 + hstepA, voffA);
            PG8_WAIT_V(8); PG8_WAIT_L(0); PG8_BAR; PG8_MMA(0, 0, At, B0); PG8_MMA(0, 1, At, B1); PG8_BAR; PG8_SCHED;
            PG8_LDA(At, 0, 1); PG8_STAGE(PG8_SB(0, 0), b2, voffB); PG8_STAGE(PG8_SB(0, 1), b2 + hstep, voffB); PG8_STAGE(PG8_SA(0, 0), a2, voffA);
            PG8_WAIT_V(8); PG8_WAIT_L(0); PG8_BAR; PG8_MMA(1, 0, At, B0); PG8_MMA(1, 1, At, B1); PG8_BAR; PG8_SCHED;
            PG8_LDB(B0, 1, 0); PG8_LDB(B1, 1, 1); PG8_SCHED; PG8_LDA(At, 1, 0); PG8_STAGE(PG8_SA(0, 1), a2 + hstepA, voffA);
            PG8_WAIT_V(8); PG8_WAIT_L(0); PG8_BAR; PG8_MMA(0, 0, At, B0); PG8_MMA(0, 1, At, B1); PG8_BAR; PG8_SCHED;
            PG8_LDA(At, 1, 1); PG8_STAGE(PG8_SB(1, 0), b3, voffB); PG8_STAGE(PG8_SB(1, 1), b3 + hstep, voffB); PG8_STAGE(PG8_SA(1, 0), a3, voffA);
            PG8_WAIT_V(8); PG8_WAIT_L(0); PG8_BAR; PG8_MMA(1, 0, At, B0); PG8_MMA(1, 1, At, B1); PG8_BAR; PG8_SCHED;
            } else {
            PG8_LDB(B0, 0, 0); PG8_SCHED; PG8_LDA(At, 0, 0); PG8_STAGE(PG8_SA(1, 1), a1 + hstepA, voffA);
            PG8_WAIT_L(8); PG8_BAR; PG8_WAIT_L(0); PG8_MMA(0, 0, At, B0); PG8_BAR; PG8_SCHED;
            PG8_LDB(B1, 0, 1); PG8_STAGE(PG8_SB(0, 0), b2, voffB);
            PG8_BAR; PG8_WAIT_L(0); PG8_MMA(0, 1, At, B1); PG8_BAR;
            PG8_LDA(At, 0, 1); PG8_STAGE(PG8_SA(0, 0), a2, voffA);
            PG8_BAR; PG8_WAIT_L(0); PG8_MMA(1, 0, At, B0); PG8_BAR; PG8_SCHED;
            PG8_STAGE(PG8_SB(0, 1), b2 + hstep, voffB);
            PG8_WAIT_V(6); PG8_BAR; PG8_MMA(1, 1, At, B1); PG8_BAR;
            PG8_LDB(B0, 1, 0); PG8_SCHED; PG8_LDA(At, 1, 0); PG8_STAGE(PG8_SA(0, 1), a2 + hstepA, voffA);
            PG8_WAIT_L(8); PG8_BAR; PG8_WAIT_L(0); PG8_MMA(0, 0, At, B0); PG8_BAR; PG8_SCHED;
            PG8_LDB(B1, 1, 1); PG8_STAGE(PG8_SB(1, 0), b3, voffB);
            PG8_BAR; PG8_WAIT_L(0); PG8_MMA(0, 1, At, B1); PG8_BAR;
            PG8_LDA(At, 1, 1); PG8_STAGE(PG8_SA(1, 0), a3, voffA);
            PG8_BAR; PG8_WAIT_L(0); PG8_MMA(1, 0, At, B0); PG8_BAR; PG8_SCHED;
            PG8_STAGE(PG8_SB(1, 1), b3 + hstep, voffB);
            PG8_WAIT_V(6); PG8_BAR; PG8_MMA(1, 1, At, B1); PG8_BAR;
            }
        }
        if constexpr (ALIGN_EPI) { if (wr == 0) PG8_BAR; }
        if constexpr (!Epi::AFTER_DRAIN) { E(acc, cur, wr, wc, fr, fq); S.done(cur); }
        if (!has_next) break;
#pragma unroll
        for (int a = 0; a < 2; ++a)
#pragma unroll
            for (int b = 0; b < 2; ++b)
#pragma unroll
                for (int m = 0; m < 4; ++m)
#pragma unroll
                    for (int n = 0; n < 2; ++n) acc[a][b][m][n] = (f32x4){0.f, 0.f, 0.f, 0.f};
        cur = nxt; cA = nA; cB = nB; ++ui;
        if constexpr (ALIGN_EPI) { if (wr == 1) PG8_BAR; }
    }
    PG8_WAIT_V(0);
    if constexpr (!ALIGN_EPI) { if (wr == 0) PG8_BAR; }
    PG8_BAR;
    if constexpr (Epi::AFTER_DRAIN) { E.fused(acc, cur, wr, wc, fr, fq, lds, wid, lane); S.done(cur); }
#undef PG8_SA
#undef PG8_SB
#undef PG8_STAGE
#undef PG8_LDA
#undef PG8_LDB
#undef PG8_MMA
#undef PG8_WAIT_V
#undef PG8_WAIT_L
#undef PG8_BAR
#undef PG8_SCHED
}
}
typedef pg8::bf16_t bf16_t;
typedef pg8::bf16x8 bf16x8;
typedef pg8::f32x4 f32x4;
typedef pg8::u32x4 u32x4;
typedef unsigned u32x2 __attribute__((ext_vector_type(2)));
#define LAS __attribute__((address_space(3)))

constexpr int DM = 1024, NB = 4, SEQ = 8192, MTOK = NB * SEQ, DIN = 7168, DFF = 3072, DFF2 = 6144, NL = 2;
constexpr int NTH = 512;
constexpr float EPS = 1e-6f;
constexpr int RT = 128, NT = SEQ / RT;
constexpr size_t WS_BAR = 0;
constexpr size_t WS_MOD = 16384;
constexpr size_t WS_GW = WS_MOD + (size_t)NL * NB * 6144 * 4;
constexpr size_t WS_SUM = WS_GW + (size_t)NL * 2 * 8 * 128 * 128 * 2;
constexpr size_t WS_HIN = WS_SUM + (size_t)NB * NT * 1024 * 2 * 4;
constexpr size_t WS_W = (WS_HIN + (size_t)NB * NT * 1024 * 4 + 4095) / 4096 * 4096;
constexpr size_t W_IN_E = (size_t)DIN * DM, W_OUT_E = (size_t)DM * DM, W_UP_E = (size_t)DFF2 * DM, W_DN_E = (size_t)DM * DFF, W_LAYER_E = W_IN_E + W_OUT_E + W_UP_E + W_DN_E;
constexpr size_t WS_XN = WS_W + NL * W_LAYER_E * 2;
constexpr size_t PBUF = (size_t)MTOK * DM * 2;
constexpr size_t WS_P = WS_XN + PBUF;
constexpr size_t WS_END = WS_P + 5 * PBUF;
constexpr size_t ACT_BYTES = (size_t)MTOK * DFF * 2;

__device__ __forceinline__ float bf2f(bf16_t b) { return __uint_as_float(((unsigned)b) << 16); }
__device__ __forceinline__ unsigned pk2(float lo, float hi) { unsigned r; asm volatile("v_cvt_pk_bf16_f32 %0, %1, %2" : "=v"(r) : "v"(lo), "v"(hi)); return r; }
__device__ __forceinline__ float bflo(unsigned w) { return __uint_as_float(w << 16); }
__device__ __forceinline__ float bfhi(unsigned w) { return __uint_as_float(w & 0xffff0000u); }
__device__ __forceinline__ float sigmoidf_(float x) { return __builtin_amdgcn_rcpf(1.0f + __expf(-x)); }
__device__ __forceinline__ float gelu_tanh(float x) { const float u = 1.5957691216057308f * (x + 0.044715f * x * x * x); return x * sigmoidf_(u); }

struct EpiSplit {
    static constexpr bool PERM = true, AFTER_DRAIN = false;
    bf16_t* base; size_t tstride; int modes; int skip3;
    __device__ __forceinline__ void operator()(const f32x4 (&acc)[2][2][4][2], const pg8::Unit& u, int wr, int wc, int fr, int fq) const {
        const int colt = u.pn * 256, t = colt >> 10; const int mode = (modes >> (4 * t)) & 15;
        bf16_t* o = base + (size_t)(t + ((skip3 && t == 3) ? 1 : 0)) * tstride; const int col0 = (colt & 1023) + wc * 32 + 8 * fq; const int row0 = u.pm * 256 + wr * 64 + fr;
#pragma unroll
        for (int ai = 0; ai < 2; ++ai)
#pragma unroll
            for (int m = 0; m < 4; ++m) { bf16_t* rowp = o + (size_t)(row0 + ai * 128 + m * 16) * DM + col0;
#pragma unroll
                for (int bj = 0; bj < 2; ++bj) { f32x4 v0 = acc[ai][bj][m][0], v1 = acc[ai][bj][m][1];
                    if (mode == 1) {
#pragma unroll
                        for (int j = 0; j < 4; ++j) { v0[j] = gelu_tanh(v0[j]); v1[j] = gelu_tanh(v1[j]); } }
                    else if (mode == 2) {
#pragma unroll
                        for (int j = 0; j < 4; ++j) { v0[j] = sigmoidf_(v0[j]); v1[j] = sigmoidf_(v1[j]); } }
                    u32x4 w; w.x = pk2(v0[0], v0[1]); w.y = pk2(v0[2], v0[3]); w.z = pk2(v1[0], v1[1]); w.w = pk2(v1[2], v1[3]);
                    *(u32x4*)(rowp + bj * 128) = w; } }
    }
};
struct EpiPlain {
    static constexpr bool PERM = true, AFTER_DRAIN = false;
    bf16_t* o; int ldc;
    __device__ __forceinline__ void operator()(const f32x4 (&acc)[2][2][4][2], const pg8::Unit& u, int wr, int wc, int fr, int fq) const {
        const int col0 = u.pn * 256 + wc * 32 + 8 * fq; const int row0 = u.pm * 256 + wr * 64 + fr;
#pragma unroll
        for (int ai = 0; ai < 2; ++ai)
#pragma unroll
            for (int m = 0; m < 4; ++m) { bf16_t* rowp = o + (size_t)(row0 + ai * 128 + m * 16) * ldc + col0;
#pragma unroll
                for (int bj = 0; bj < 2; ++bj) { const f32x4 v0 = acc[ai][bj][m][0], v1 = acc[ai][bj][m][1];
                    u32x4 w; w.x = pk2(v0[0], v0[1]); w.y = pk2(v0[2], v0[3]); w.z = pk2(v1[0], v1[1]); w.w = pk2(v1[2], v1[3]);
                    *(u32x4*)(rowp + bj * 128) = w; } }
    }
};
struct EpiRes {
    static constexpr bool PERM = false, AFTER_DRAIN = false;
    const float* res; float* out; const float* gate  ; int row_off;
    __device__ __forceinline__ void operator()(const f32x4 (&acc)[2][2][4][2], const pg8::Unit& u, int wr, int wc, int fr, int fq) const {
        const int grow0 = row_off + u.pm * 256; const int b = grow0 / SEQ; const int row0 = grow0 + wr * 64 + fr, col0 = u.pn * 256 + wc * 32 + 4 * fq;
        f32x4 gv[2][2];
#pragma unroll
        for (int bj = 0; bj < 2; ++bj)
#pragma unroll
            for (int n = 0; n < 2; ++n) gv[bj][n] = *(const f32x4*)(gate + (size_t)b * 6144 + col0 + bj * 128 + n * 16);
#pragma unroll
        for (int ai = 0; ai < 2; ++ai)
#pragma unroll
            for (int m = 0; m < 4; ++m) { const size_t off = (size_t)(row0 + ai * 128 + m * 16) * DM + col0;
#pragma unroll
                for (int bj = 0; bj < 2; ++bj)
#pragma unroll
                    for (int n = 0; n < 2; ++n) { const f32x4 r = *(const f32x4*)(res + off + bj * 128 + n * 16); *(f32x4*)(out + off + bj * 128 + n * 16) = r + gv[bj][n] * acc[ai][bj][m][n]; }
                asm volatile("" ::: "memory"); }
    }
};


#define XB_TMO      128
#define XB_XCNT(j)  (256  + 64 * (j))
#define XB_XSUB(j)  (1280 + 64 * (j))
#define XB_XGEN(j)  (2304 + 64 * (j))
#define XB_TOP      3328
#define XB_TOPGEN   3392
#define XCD_BAR_WORDS 3456
#define XB_SPIN_CAP (1u << 22)
__device__ __forceinline__ unsigned xb_ld(unsigned* p)              { return __hip_atomic_load(p, __ATOMIC_RELAXED, __HIP_MEMORY_SCOPE_AGENT); }
__device__ __forceinline__ unsigned xb_add(unsigned* p, unsigned v) { return __hip_atomic_fetch_add(p, v, __ATOMIC_RELAXED, __HIP_MEMORY_SCOPE_AGENT); }
__device__ __forceinline__ unsigned xb_xcc_id() { return (unsigned)__builtin_amdgcn_s_getreg((3 << 11) | 20) & 0xFu; }
#define XB_SPIN(cond, bar) do { unsigned _sp = 0; while (cond) { __builtin_amdgcn_s_sleep(1); \
    if ((++_sp & 255u) == 0u) { if (xb_ld(&(bar)[XB_TMO])) break; if (_sp > XB_SPIN_CAP) { atomicAdd(&(bar)[XB_TMO], 1u); break; } } } } while (0)
struct XcdBarrier { unsigned* bar; unsigned x; volatile LAS unsigned* st; };
__device__ __forceinline__ XcdBarrier xcd_barrier_post(unsigned* bar, volatile LAS unsigned* st) {
    XcdBarrier b; b.bar = bar; b.x = xb_xcc_id(); b.st = st;
    if (threadIdx.x == 0) (void)xb_add(&bar[XB_XCNT(b.x)], 1u);
    return b;
}
__device__ __forceinline__ void xcd_barrier_complete(unsigned* bar, unsigned x, unsigned& nloc, unsigned& nx) {
    const unsigned G = gridDim.x * gridDim.y * gridDim.z;
    unsigned sum, cnt, mine, sp = 0u;
    for (;;) {
        sum = 0u; cnt = 0u; mine = 0u;
#pragma unroll
        for (unsigned j = 0; j < 16; ++j) { const unsigned c = xb_ld(&bar[XB_XCNT(j)]); sum += c; cnt += (c > 0u) ? 1u : 0u; mine = (j == x) ? c : mine; }
        if (sum == G) break;
        __builtin_amdgcn_s_sleep(1);
        if ((++sp & 255u) == 0u) { if (xb_ld(&bar[XB_TMO])) break; if (sp > XB_SPIN_CAP) { atomicAdd(&bar[XB_TMO], 1u); break; } }
    }
    nloc = mine > 0u ? mine : 1u; nx = cnt > 0u ? cnt : 1u;
}
__device__ __forceinline__ void xcd_barrier(const XcdBarrier& b, const int wv) {
    asm volatile("s_waitcnt vmcnt(0)" ::: "memory");
    __syncthreads();
    if (opaque_tid(wv) == 0) {
        unsigned* bar = b.bar;
        __builtin_amdgcn_s_waitcnt(0);
        unsigned nloc = b.st[0], nx = b.st[1];
        if (nloc == 0u) { xcd_barrier_complete(bar, b.x, nloc, nx); b.st[0] = nloc; b.st[1] = nx; }
        const unsigned old = xb_add(&bar[XB_XSUB(b.x)], 1u);
        const unsigned gen = old / nloc;
        if (old + 1u == (gen + 1u) * nloc) {
            __builtin_amdgcn_fence(__ATOMIC_RELEASE, "agent");
            asm volatile("s_waitcnt vmcnt(0)" ::: "memory");
            const unsigned og = xb_add(&bar[XB_TOP], 1u);
            const unsigned tg = og / nx;
            if (og + 1u == (tg + 1u) * nx) xb_add(&bar[XB_TOPGEN], 1u);
            else XB_SPIN(xb_ld(&bar[XB_TOPGEN]) == tg, bar);
            __builtin_amdgcn_fence(__ATOMIC_ACQUIRE, "agent");
            xb_add(&bar[XB_XGEN(b.x)], 1u);
            asm volatile("s_waitcnt vmcnt(0)" ::: "memory");
        } else {
            XB_SPIN(xb_ld(&bar[XB_XGEN(b.x)]) == gen, bar);
            __builtin_amdgcn_fence(__ATOMIC_ACQUIRE, "agent");
            asm volatile("s_waitcnt vmcnt(0)" ::: "memory");
        }
    }
    __syncthreads();
}

__device__ __forceinline__ float dpp_shr1(float x) { return __builtin_bit_cast(float, __builtin_amdgcn_update_dpp(0, __builtin_bit_cast(int, x), 0x111, 0xf, 0xf, false)); }
struct EpiConvAct {
    static constexpr bool PERM = true, AFTER_DRAIN = false;
    bf16_t* act; bf16_t* halo; const float* cw; const float* cb;
    __device__ __forceinline__ void operator()(const f32x4 (&acc)[2][2][4][2], const pg8::Unit& u, int wr, int wc, int fr, int fq) const {
        const int tb = u.pm * 256 + 128 * wr, c0 = u.pn * 128 + wc * 32 + 8 * fq;
        bf16_t* hp = halo + (size_t)(tb >> 7) * 4 * DFF2;
#pragma unroll
        for (int n = 0; n < 2; ++n) {
            const int c = c0 + 4 * n;
            const f32x4 bg = *(const f32x4*)(cb + c), bv = *(const f32x4*)(cb + DFF + c);
            const f32x4 wg0 = *(const f32x4*)(cw + c), wg1 = *(const f32x4*)(cw + DFF2 + c), wg2 = *(const f32x4*)(cw + 2 * DFF2 + c);
            const f32x4 wv0 = *(const f32x4*)(cw + DFF + c), wv1 = *(const f32x4*)(cw + DFF2 + DFF + c), wv2 = *(const f32x4*)(cw + 2 * DFF2 + DFF + c);
            f32x4 pg6, pg7, pv6, pv7;
#pragma unroll
            for (int j = 0; j < 4; ++j) { pg6[j] = dpp_shr1(acc[1][0][2][n][j]); pg7[j] = dpp_shr1(acc[1][0][3][n][j]); pv6[j] = dpp_shr1(acc[1][1][2][n][j]); pv7[j] = dpp_shr1(acc[1][1][3][n][j]); }
#pragma unroll
            for (int q = 0; q < 8; ++q) {
                const f32x4 g = acc[q >> 2][0][q & 3][n], v = acc[q >> 2][1][q & 3][n];
                const f32x4 g1 = q >= 1 ? acc[(q - 1 + 8) % 8 >> 2][0][(q - 1 + 8) % 8 & 3][n] : pg7, g2 = q >= 2 ? acc[(q - 2 + 8) % 8 >> 2][0][(q - 2 + 8) % 8 & 3][n] : (q == 1 ? pg7 : pg6);
                const f32x4 v1 = q >= 1 ? acc[(q - 1 + 8) % 8 >> 2][1][(q - 1 + 8) % 8 & 3][n] : pv7, v2 = q >= 2 ? acc[(q - 2 + 8) % 8 >> 2][1][(q - 2 + 8) % 8 & 3][n] : (q == 1 ? pv7 : pv6);
                const f32x4 g1e = q == 0 ? pg7 : g1, g2e = q == 0 ? pg6 : g2, v1e = q == 0 ? pv7 : v1, v2e = q == 0 ? pv6 : v2;
                float o[4];
#pragma unroll
                for (int j = 0; j < 4; ++j) { const float cg = bg[j] + wg0[j] * g2e[j] + wg1[j] * g1e[j] + wg2[j] * g[j]; const float cv = bv[j] + wv0[j] * v2e[j] + wv1[j] * v1e[j] + wv2[j] * v[j]; o[j] = gelu_tanh(cg) * cv; }
                if (fr > 0 || q >= 2) { u32x2 w; w.x = pk2(o[0], o[1]); w.y = pk2(o[2], o[3]); *(u32x2*)(act + (size_t)(tb + 8 * fr + q) * DFF + c) = w; }
                if ((fr == 0 && q < 2) || (fr == 15 && q >= 6)) { const int r = q < 2 ? q : q - 4; u32x2 wgp, wvp; wgp.x = pk2(g[0], g[1]); wgp.y = pk2(g[2], g[3]); wvp.x = pk2(v[0], v[1]); wvp.y = pk2(v[2], v[3]);
                    *(u32x2*)(hp + (size_t)r * DFF2 + c) = wgp; *(u32x2*)(hp + (size_t)r * DFF2 + DFF + c) = wvp; }
            }
        }
    }
};

struct Args { const float* in[21]; float* out; unsigned char* ws; };
typedef const __attribute__((address_space(4))) Args* ArgsP;

__device__ void p0_mod(ArgsP a, LAS unsigned char* lds, const int wv) {
    const int tid = opaque_tid(wv), w = tid >> 6, lane = tid & 63;
    const float* c = a->in[1]; const float* aw = a->in[2]; const float* ab = a->in[3]; float* mod = (float*)(a->ws + WS_MOD);
    LAS float* red = (LAS float*)lds;
    for (int grp = blockIdx.x; grp < NL * 6144 / 48; grp += gridDim.x) {
        const int gl = grp * 48 + (lane < 48 ? lane : 47), l = gl / 6144, j = gl % 6144;
        const float* wp = aw + (size_t)l * DM * 6144 + j;
        float s0 = 0.f, s1 = 0.f, s2 = 0.f, s3 = 0.f;
#pragma unroll 16
        for (int k = w * 128; k < w * 128 + 128; ++k) { const float wv = wp[(size_t)k * 6144]; s0 += c[k] * wv; s1 += c[DM + k] * wv; s2 += c[2 * DM + k] * wv; s3 += c[3 * DM + k] * wv; }
        red[(w * 4 + 0) * 64 + lane] = s0; red[(w * 4 + 1) * 64 + lane] = s1; red[(w * 4 + 2) * 64 + lane] = s2; red[(w * 4 + 3) * 64 + lane] = s3;
        __syncthreads();
        if (tid < 256 && lane < 48) { const int b = tid >> 6; float s = ab[(size_t)l * 6144 + j];
#pragma unroll
            for (int ww = 0; ww < 8; ++ww) s += red[(ww * 4 + b) * 64 + lane];
            mod[((size_t)l * NB + b) * 6144 + j] = s; }
        __syncthreads();
    }
    bf16_t* gw = (bf16_t*)(a->ws + WS_GW);
    for (size_t idx = (size_t)blockIdx.x * NTH + tid; idx < (size_t)NL * 2 * 8 * 128 * 128; idx += (size_t)gridDim.x * NTH) {
        const int i = idx & 127, j = (idx >> 7) & 127, h = (idx >> 14) & 7, mat = (idx >> 17) & 1, l = (int)(idx >> 18);
        const float* src = a->in[mat ? 10 : 8];
        const float v = src[(((size_t)l * 8 + h) * 128 + i) * 128 + j];
        gw[idx] = (bf16_t)(pk2(v, v) & 0xffff);
    }
}
struct TMat { const float* W; bf16_t* Wt; int K, N, rmode, ntn; };
__device__ __forceinline__ TMat tmat_of(ArgsP a, int mi) {
    const int l = mi >> 2, k = mi & 3; bf16_t* wl = (bf16_t*)(a->ws + WS_W) + (size_t)l * W_LAYER_E; TMat m;
    if (k == 0) { m.W = a->in[5] + (size_t)l * DM * DIN; m.Wt = wl; m.K = DM; m.N = DIN; m.rmode = 1; }
    else if (k == 1) { m.W = a->in[15] + (size_t)l * DM * DM; m.Wt = wl + W_IN_E; m.K = DM; m.N = DM; m.rmode = 0; }
    else if (k == 2) { m.W = a->in[17] + (size_t)l * DM * DFF2; m.Wt = wl + W_IN_E + W_OUT_E; m.K = DM; m.N = DFF2; m.rmode = 2; }
    else { m.W = a->in[20] + (size_t)l * DFF * DM; m.Wt = wl + W_IN_E + W_OUT_E + W_UP_E; m.K = DFF; m.N = DM; m.rmode = 0; }
    m.ntn = m.N / 64; return m;
}
constexpr int TILES_IN = (DM / 64) * (DIN / 64), TILES_OUT = (DM / 64) * (DM / 64), TILES_UP = (DM / 64) * (DFF2 / 64), TILES_DN = (DFF / 64) * (DM / 64), TILES_L = TILES_IN + TILES_OUT + TILES_UP + TILES_DN;
__device__ __forceinline__ void tile_of(int g, int& mi, int& tile) {
    const int l = g / TILES_L; int r = g - l * TILES_L; int k = 0;
    if (r >= TILES_IN) { r -= TILES_IN; k = 1; if (r >= TILES_OUT) { r -= TILES_OUT; k = 2; if (r >= TILES_UP) { r -= TILES_UP; k = 3; } } }
    mi = l * 4 + k; tile = r;
}
__device__ void p0_weights(ArgsP a, LAS unsigned char* lds, const int wv) {
    LAS float* t = (LAS float*)lds;
    const int tid = opaque_tid(wv); const int G = gridDim.x;
    int g = blockIdx.x; if (g >= NL * TILES_L) return;
    int mi, tile; tile_of(g, mi, tile); TMat m = tmat_of(a, mi);
    f32x4 v0, v1;
    { const int k0 = (tile / m.ntn) * 64, n0 = (tile % m.ntn) * 64; const float* p = m.W + (size_t)(k0 + (tid >> 4)) * m.N + n0 + (tid & 15) * 4; v0 = *(const f32x4*)p; v1 = *(const f32x4*)(p + (size_t)32 * m.N); }
    for (;;) {
        const int k0 = (tile / m.ntn) * 64, n0 = (tile % m.ntn) * 64; const TMat cm = m;
        { const int k = tid >> 4, n = (tid & 15) * 4;
          t[k * 65 + n] = v0[0]; t[k * 65 + n + 1] = v0[1]; t[k * 65 + n + 2] = v0[2]; t[k * 65 + n + 3] = v0[3];
          t[(k + 32) * 65 + n] = v1[0]; t[(k + 32) * 65 + n + 1] = v1[1]; t[(k + 32) * 65 + n + 2] = v1[2]; t[(k + 32) * 65 + n + 3] = v1[3]; }
        g += G; const bool more = g < NL * TILES_L;
        if (more) { tile_of(g, mi, tile); m = tmat_of(a, mi); const int k1 = (tile / m.ntn) * 64, n1 = (tile % m.ntn) * 64;
            const float* p = m.W + (size_t)(k1 + (tid >> 4)) * m.N + n1 + (tid & 15) * 4; v0 = *(const f32x4*)p; v1 = *(const f32x4*)(p + (size_t)32 * m.N); }
        __syncthreads();
        { const int n = tid >> 3, p = tid & 7; float v[8];
#pragma unroll
          for (int e = 0; e < 8; ++e) v[e] = t[(p * 8 + e) * 65 + n];
          u32x4 w; w.x = pk2(v[0], v[1]); w.y = pk2(v[2], v[3]); w.z = pk2(v[4], v[5]); w.w = pk2(v[6], v[7]);
          int nr = n0 + n; if (cm.rmode == 1) nr = nr < 2048 ? nr : (nr < 5120 ? nr + 2048 : nr - 3072);
          else if (cm.rmode == 2) nr = nr < DFF ? ((nr >> 7) * 256 + (nr & 127)) : (((nr - DFF) >> 7) * 256 + 128 + ((nr - DFF) & 127));
          *(u32x4*)(cm.Wt + (size_t)nr * cm.K + k0 + p * 8) = w; }
        __syncthreads();
        if (!more) break;
    }
}
__device__ void norm_phase(const float* __restrict__ x, const float* __restrict__ g, const float* __restrict__ modl  , int shk, int sck, bf16_t* __restrict__ xn, const int wv) {
    const int tid = opaque_tid(wv); const int w = tid >> 6, lane = tid & 63;
    for (int row = blockIdx.x * 8 + w; row < MTOK; row += gridDim.x * 8) {
        const int b = row / SEQ; const float* xr = x + (size_t)row * DM; f32x4 v[4]; float ss = 0.f;
#pragma unroll
        for (int i = 0; i < 4; ++i) { v[i] = *(const f32x4*)(xr + lane * 4 + 256 * i); ss += v[i][0] * v[i][0] + v[i][1] * v[i][1] + v[i][2] * v[i][2] + v[i][3] * v[i][3]; }
#pragma unroll
        for (int o = 32; o >= 1; o >>= 1) ss += __shfl_xor(ss, o);
        const float rstd = rsqrtf(ss * (1.0f / DM) + EPS);
        const float* sh = modl + (size_t)b * 6144 + shk * 1024; const float* sc = modl + (size_t)b * 6144 + sck * 1024;
#pragma unroll
        for (int i = 0; i < 4; ++i) { const int c = lane * 4 + 256 * i; const f32x4 gg = *(const f32x4*)(g + c), s1 = *(const f32x4*)(sc + c), s0 = *(const f32x4*)(sh + c);
            f32x4 y;
#pragma unroll
            for (int j = 0; j < 4; ++j) y[j] = v[i][j] * rstd * gg[j] * (1.0f + s1[j]) + s0[j];
            u32x2 o; o.x = pk2(y[0], y[1]); o.y = pk2(y[2], y[3]); *(u32x2*)(xn + (size_t)row * DM + c) = o; }
    }
}
constexpr int KP = 272, VP = 136;
constexpr float DEAD = 1e-30f;
__device__ void attn_phase(ArgsP a, int l, LAS unsigned char* lds, const int wv) {
    const int tid = opaque_tid(wv), w = __builtin_amdgcn_readfirstlane(tid >> 6), lane = tid & 63, fr = lane & 15, fq = lane >> 4;
    LAS unsigned char* Ks = lds; LAS unsigned char* Vt = lds + 64 * KP; LAS int* flags = (LAS int*)(lds + 64 * KP + 128 * VP);
    const bf16_t* Qb = (const bf16_t*)(a->ws + WS_P); bf16_t* Yb = (bf16_t*)(a->ws + WS_P + 3 * PBUF); const bf16_t* Kb = (const bf16_t*)(a->ws + WS_P + PBUF); const bf16_t* Vb = (const bf16_t*)(a->ws + WS_P + 2 * PBUF);
    const float* gq = a->in[13] + l * 128; const float* gk = a->in[14] + l * 128;
    const int sp = tid & 15, skp = tid >> 4;
    float gks[8];
#pragma unroll
    for (int e = 0; e < 8; ++e) gks[e] = gk[sp * 8 + e];
    const int nunits = NB * 8 * (SEQ / 256);
    for (int unit = blockIdx.x; unit < nunits; unit += gridDim.x) {
        const int qt = (SEQ / 256 - 1) - unit / (NB * 8), bh = unit % (NB * 8), b = bh >> 3, hh = bh & 7;
        const size_t rowbase = (size_t)b * SEQ; const int t0 = qt * 256, r0 = t0 + 32 * w;
        int kb = qt * 4 + 3;
        u32x4 kr[2], vr[2];
#pragma unroll
        for (int i = 0; i < 2; ++i) { const size_t grow = rowbase + kb * 64 + 2 * skp + i; kr[i] = *(const u32x4*)(Kb + grow * DM + hh * 128 + sp * 8); vr[i] = *(const u32x4*)(Vb + grow * DM + hh * 128 + sp * 8); }
        bf16x8 qf[2][4];
#pragma unroll
        for (int rb = 0; rb < 2; ++rb) {
            const bf16_t* qp = Qb + (rowbase + r0 + 16 * rb + fr) * DM + hh * 128 + 8 * fq; u32x4 raw[4]; float ss = 0.f;
#pragma unroll
            for (int ks = 0; ks < 4; ++ks) { raw[ks] = *(const u32x4*)(qp + 32 * ks);
#pragma unroll
                for (int j = 0; j < 4; ++j) { const float x0 = bflo(raw[ks][j]), x1 = bfhi(raw[ks][j]); ss += x0 * x0 + x1 * x1; } }
            ss += __shfl_xor(ss, 16); ss += __shfl_xor(ss, 32);
            const float rs = rsqrtf(ss * (1.0f / 128.0f) + EPS) * (0.08838834764831845f * 1.4426950408889634f);
#pragma unroll
            for (int ks = 0; ks < 4; ++ks) { u32x4 o;
#pragma unroll
                for (int j = 0; j < 4; ++j) { const int d = 32 * ks + 8 * fq + 2 * j; o[j] = pk2(bflo(raw[ks][j]) * rs * gq[d], bfhi(raw[ks][j]) * rs * gq[d + 1]); }
                qf[rb][ks] = __builtin_bit_cast(bf16x8, o); }
        }
        f32x4 O[2][8];
#pragma unroll
        for (int rb = 0; rb < 2; ++rb)
#pragma unroll
            for (int db = 0; db < 8; ++db) O[rb][db] = (f32x4){0.f, 0.f, 0.f, 0.f};
        float carry[2] = {1.f, 1.f};
        bool alive = true;
        for (;;) {
#pragma unroll
            for (int i = 0; i < 2; ++i) { float x[8]; float ss = 0.f;
#pragma unroll
                for (int j = 0; j < 4; ++j) { x[2 * j] = bflo(kr[i][j]); x[2 * j + 1] = bfhi(kr[i][j]); ss += x[2 * j] * x[2 * j] + x[2 * j + 1] * x[2 * j + 1]; }
                ss += __shfl_xor(ss, 1); ss += __shfl_xor(ss, 2); ss += __shfl_xor(ss, 4); ss += __shfl_xor(ss, 8);
                const float rs = rsqrtf(ss * (1.0f / 128.0f) + EPS);
                u32x4 o;
#pragma unroll
                for (int j = 0; j < 4; ++j) o[j] = pk2(x[2 * j] * rs * gks[2 * j], x[2 * j + 1] * rs * gks[2 * j + 1]);
                *(LAS u32x4*)(Ks + (2 * skp + i) * KP + sp * 16) = o; }
            { const int wsz = skp ^ (sp & 14);
#pragma unroll
              for (int j = 0; j < 4; ++j) { *(LAS unsigned*)(Vt + (sp * 8 + 2 * j) * VP + wsz * 4) = (vr[0][j] & 0xffffu) | (vr[1][j] << 16); *(LAS unsigned*)(Vt + (sp * 8 + 2 * j + 1) * VP + wsz * 4) = (vr[0][j] >> 16) | (vr[1][j] & 0xffff0000u); } }
            __syncthreads();
            if (kb > 0) {
#pragma unroll
                for (int i = 0; i < 2; ++i) { const size_t grow = rowbase + (kb - 1) * 64 + 2 * skp + i; kr[i] = *(const u32x4*)(Kb + grow * DM + hh * 128 + sp * 8); vr[i] = *(const u32x4*)(Vb + grow * DM + hh * 128 + sp * 8); } }
            const bool active = alive && (kb * 64 < r0 + 31);
            if (active) {
                f32x4 S[2][4];
#pragma unroll
                for (int nb = 0; nb < 4; ++nb) {
                    bf16x8 kf[4];
#pragma unroll
                    for (int ks = 0; ks < 4; ++ks) kf[ks] = *(const LAS bf16x8*)(Ks + (16 * nb + fr) * KP + (32 * ks + 8 * fq) * 2);
#pragma unroll
                    for (int rb = 0; rb < 2; ++rb) { f32x4 sacc = (f32x4){0.f, 0.f, 0.f, 0.f};
#pragma unroll
                        for (int ks = 0; ks < 4; ++ks) sacc = __builtin_amdgcn_mfma_f32_16x16x32_bf16(kf[ks], qf[rb][ks], sacc, 0, 0, 0);
                        S[rb][nb] = sacc; }
                }
                const bool diag = (kb * 64 + 63 >= r0);
                unsigned pw[2][4][2];
#pragma unroll
                for (int rb = 0; rb < 2; ++rb) {
                    const int q = r0 + 16 * rb + fr; float bt[4][4], suf[4][4], T[4], ab[4];
#pragma unroll
                    for (int nb = 0; nb < 4; ++nb) { float run = 1.f;
#pragma unroll
                        for (int e = 3; e >= 0; --e) { const float z2 = __builtin_amdgcn_fmed3f(S[rb][nb][e], -115.f, 115.f);
                            const float E = __builtin_amdgcn_exp2f(-z2); float be = __builtin_amdgcn_rcpf(1.0f + E); float om = E * be;
                            if (diag) { const bool mk = (kb * 64 + 16 * nb + 4 * fq + e) < q; be = mk ? be : 0.f; om = mk ? om : 1.f; }
                            bt[nb][e] = be; suf[nb][e] = run; run *= om; }
                        const float g1 = __shfl_xor(run, 16), g2 = __shfl_xor(run, 32), g3 = __shfl_xor(g1, 32);
                        T[nb] = (run * g1) * (g2 * g3); ab[nb] = fq == 0 ? (g1 * g2 * g3) : fq == 1 ? (g2 * g3) : fq == 2 ? g1 : 1.f; }
                    float hi = carry[rb];
#pragma unroll
                    for (int nb = 3; nb >= 0; --nb) { const float base = hi * ab[nb];
                        pw[rb][nb][0] = pk2(bt[nb][0] * base * suf[nb][0], bt[nb][1] * base * suf[nb][1]); pw[rb][nb][1] = pk2(bt[nb][2] * base * suf[nb][2], bt[nb][3] * base * suf[nb][3]); hi *= T[nb]; }
                    carry[rb] = hi;
                }
#pragma unroll
                for (int ks2 = 0; ks2 < 2; ++ks2) {
                    bf16x8 pf[2];
#pragma unroll
                    for (int rb = 0; rb < 2; ++rb) { u32x4 t; t.x = pw[rb][2 * ks2][0]; t.y = pw[rb][2 * ks2][1]; t.z = pw[rb][2 * ks2 + 1][0]; t.w = pw[rb][2 * ks2 + 1][1]; pf[rb] = __builtin_bit_cast(bf16x8, t); }
#pragma unroll
                    for (int db = 0; db < 8; ++db) { const LAS unsigned char* vrow = Vt + (16 * db + fr) * VP;
                        const u32x2 va = *(const LAS u32x2*)(vrow + 4 * ((16 * ks2 + 2 * fq) ^ (2 * db))), vb = *(const LAS u32x2*)(vrow + 4 * ((16 * ks2 + 8 + 2 * fq) ^ (2 * db)));
                        u32x4 t; t.x = va.x; t.y = va.y; t.z = vb.x; t.w = vb.y; const bf16x8 vf = __builtin_bit_cast(bf16x8, t);
#pragma unroll
                        for (int rb = 0; rb < 2; ++rb) O[rb][db] = __builtin_amdgcn_mfma_f32_16x16x32_bf16(vf, pf[rb], O[rb][db], 0, 0, 0); }
                }
                alive = !__all((carry[0] < DEAD) && (carry[1] < DEAD));
            }
            if (lane == 0) flags[w] = alive ? 1 : 0;
            __syncthreads();
            int any = 0;
#pragma unroll
            for (int ww = 0; ww < 8; ++ww) any |= flags[ww];
            --kb;
            if (!any || kb < 0) break;
        }
#pragma unroll
        for (int rb = 0; rb < 2; ++rb) { bf16_t* op = Yb + (rowbase + r0 + 16 * rb + fr) * DM + hh * 128 + 4 * fq;
#pragma unroll
            for (int db = 0; db < 8; ++db) { u32x2 o; o.x = pk2(O[rb][db][0], O[rb][db][1]); o.y = pk2(O[rb][db][2], O[rb][db][3]); *(u32x2*)(op + 16 * db) = o; } }
    }
}
constexpr int XP = 272;
template <bool FINAL>
__device__ void rnn_phase(ArgsP a, int l, LAS unsigned char* lds, const int wv) {
    const int tid = opaque_tid(wv), w = __builtin_amdgcn_readfirstlane(tid >> 6), lane = tid & 63, fr = lane & 15, fq = lane >> 4;
    LAS unsigned char* XC = lds; LAS unsigned char* HT = lds + RT * XP;
    const bf16_t* XR = (const bf16_t*)(a->ws + WS_P); const bf16_t* GY = (const bf16_t*)(a->ws + WS_P + PBUF); const bf16_t* SGA = (const bf16_t*)(a->ws + WS_P + 2 * PBUF);
    const bf16_t* SGB = (const bf16_t*)(a->ws + WS_P + 4 * PBUF); const bf16_t* YB = (const bf16_t*)(a->ws + WS_P + 3 * PBUF); bf16_t* MIX = (bf16_t*)(a->ws + WS_XN);
    float* SUM = (float*)(a->ws + WS_SUM); const float* HIN = (const float*)(a->ws + WS_HIN);
    const bf16_t* gw = (const bf16_t*)(a->ws + WS_GW) + (size_t)l * 2 * 8 * 16384;
    const float* cw = a->in[6] + (size_t)l * 4 * DM; const float* cb = a->in[7] + (size_t)l * DM;
    const float* ba = a->in[9] + (size_t)l * DM; const float* bx = a->in[11] + (size_t)l * DM; const float* lam = a->in[12] + (size_t)l * DM;
    const int sp = tid & 15, stok = tid >> 4;
    const int nunits = NB * 8 * NT;
    for (int unit = blockIdx.x; unit < nunits; unit += gridDim.x) {
        const int hh = unit & 7, b = (unit >> 3) & 3, j = unit >> 5; const int t0 = j * RT; const size_t rowbase = (size_t)b * SEQ;
        const int cbase = hh * 128;
        { float wv[4][8], bv[8];
#pragma unroll
          for (int e = 0; e < 8; ++e) { bv[e] = cb[cbase + sp * 8 + e];
#pragma unroll
              for (int k = 0; k < 4; ++k) wv[k][e] = cw[k * DM + cbase + sp * 8 + e]; }
#pragma unroll
          for (int i = 0; i < 4; ++i) { const int t = t0 + stok + 32 * i; float acc[8];
#pragma unroll
              for (int e = 0; e < 8; ++e) acc[e] = bv[e];
#pragma unroll
              for (int k = 0; k < 4; ++k) { const int ts = t - 3 + k; if (ts >= 0) { const u32x4 r = *(const u32x4*)(XR + (rowbase + ts) * DM + cbase + sp * 8);
#pragma unroll
                  for (int jj = 0; jj < 4; ++jj) { acc[2 * jj] += wv[k][2 * jj] * bflo(r[jj]); acc[2 * jj + 1] += wv[k][2 * jj + 1] * bfhi(r[jj]); } } }
              u32x4 o; o.x = pk2(acc[0], acc[1]); o.y = pk2(acc[2], acc[3]); o.z = pk2(acc[4], acc[5]); o.w = pk2(acc[6], acc[7]);
              *(LAS u32x4*)(XC + (stok + 32 * i) * XP + sp * 16) = o; } }
        bf16x8 wa[4], wx[4];
        { const bf16_t* pa = gw + ((size_t)(0 * 8 + hh) * 128 + 16 * w + fr) * 128 + 8 * fq; const bf16_t* px = gw + ((size_t)(1 * 8 + hh) * 128 + 16 * w + fr) * 128 + 8 * fq;
#pragma unroll
          for (int ks = 0; ks < 4; ++ks) { wa[ks] = *(const bf16x8*)(pa + 32 * ks); wx[ks] = *(const bf16x8*)(px + 32 * ks); } }
        const int c = cbase + 16 * w + fr;
        const float bac = ba[c], bxc = bx[c]; const float lm = lam[c]; const float sp8 = 8.0f * (fmaxf(-lm, 0.f) + __logf(1.0f + __expf(-fabsf(lm))));
        __syncthreads();
        f32x4 A[8], U[8];
#pragma unroll
        for (int mb = 0; mb < 8; ++mb) { f32x4 ra = (f32x4){0.f, 0.f, 0.f, 0.f}, rx = ra;
#pragma unroll
            for (int ks = 0; ks < 4; ++ks) { const bf16x8 xf = *(const LAS bf16x8*)(XC + (16 * mb + fr) * XP + (32 * ks + 8 * fq) * 2);
                ra = __builtin_amdgcn_mfma_f32_16x16x32_bf16(xf, wa[ks], ra, 0, 0, 0); rx = __builtin_amdgcn_mfma_f32_16x16x32_bf16(xf, wx[ks], rx, 0, 0, 0); }
#pragma unroll
            for (int e = 0; e < 4; ++e) { const float r = sigmoidf_(ra[e] + bac), ig = sigmoidf_(rx[e] + bxc); const float la = -sp8 * r; const float av = __expf(la);
                const float x2 = 2.0f * la; const float om = x2 > -0.02f ? -x2 * (1.0f + x2 * (0.5f + x2 * (1.0f / 6.0f))) : 1.0f - av * av;
                const float xc = bf2f(*(const LAS bf16_t*)(XC + (16 * mb + 4 * fq + e) * XP + (16 * w + fr) * 2));
                ra[e] = av; rx[e] = sqrtf(om) * ig * xc; }
            A[mb] = ra; U[mb] = rx; }
        float H = 0.f, Pp = 1.0f;
        if (FINAL) H = HIN[((size_t)b * NT + j) * DM + c];
#pragma unroll
        for (int mb = 0; mb < 8; ++mb) {
            float Ag = A[mb][0] * A[mb][1] * A[mb][2] * A[mb][3];
            float Ug = ((U[mb][0] * A[mb][1] + U[mb][1]) * A[mb][2] + U[mb][2]) * A[mb][3] + U[mb][3];
            { const float a1 = __shfl_up(Ag, 16), u1 = __shfl_up(Ug, 16); if (fq >= 1) { Ug = Ag * u1 + Ug; Ag = Ag * a1; } }
            { const float a2 = __shfl_up(Ag, 32), u2 = __shfl_up(Ug, 32); if (fq >= 2) { Ug = Ag * u2 + Ug; Ag = Ag * a2; } }
            if (FINAL) {
                const float ap = __shfl_up(Ag, 16), up = __shfl_up(Ug, 16);
                float h = fq == 0 ? H : ap * H + up;
#pragma unroll
                for (int e = 0; e < 4; ++e) { h = A[mb][e] * h + U[mb][e]; *(LAS bf16_t*)(HT + (16 * mb + 4 * fq + e) * XP + (16 * w + fr) * 2) = (bf16_t)(pk2(h, h) & 0xffff); }
            }
            const float Am = __shfl(Ag, 48 + fr), Um = __shfl(Ug, 48 + fr);
            H = Am * H + Um; Pp *= Am;
        }
        if (!FINAL) { if (fq == 0) { float* s = SUM + (((size_t)b * NT + j) * DM + c) * 2; s[0] = Pp; s[1] = H; } }
        else {
            __syncthreads();
#pragma unroll
            for (int i = 0; i < 4; ++i) { const int tl = stok + 32 * i; const size_t go = (rowbase + t0 + tl) * DM + cbase + sp * 8;
                const u32x4 hv = *(const LAS u32x4*)(HT + tl * XP + sp * 16); const u32x4 g = *(const u32x4*)(GY + go), s1 = *(const u32x4*)(SGA + go), s2 = *(const u32x4*)(SGB + go), yb = *(const u32x4*)(YB + go);
                u32x4 o;
#pragma unroll
                for (int jj = 0; jj < 4; ++jj) o[jj] = pk2(bflo(s1[jj]) * bflo(hv[jj]) * bflo(g[jj]) + bflo(s2[jj]) * bflo(yb[jj]), bfhi(s1[jj]) * bfhi(hv[jj]) * bfhi(g[jj]) + bfhi(s2[jj]) * bfhi(yb[jj]));
                *(u32x4*)(MIX + go) = o; }
        }
        __syncthreads();
    }
}
__device__ void carry_phase(ArgsP a, const int wv) {
    const float* SUM = (const float*)(a->ws + WS_SUM); float* HIN = (float*)(a->ws + WS_HIN);
    const int gt = blockIdx.x * NTH + opaque_tid(wv); if (gt >= NB * DM) return;
    const int b = gt / DM, c = gt % DM; float H = 0.f;
#pragma unroll 8
    for (int j = 0; j < NT; ++j) { const size_t o = ((size_t)b * NT + j) * DM + c; HIN[o] = H; const float p = SUM[o * 2], h = SUM[o * 2 + 1]; H = p * H + h; }
}
__device__ void ffn_fixup(ArgsP a, int l, const int wv) {
    bf16_t* ACT = (bf16_t*)(a->ws + WS_P); const bf16_t* HALO = (const bf16_t*)(a->ws + WS_P + ACT_BYTES);
    const float* cw = a->in[18] + (size_t)l * 3 * DFF2; const float* cb = a->in[19] + (size_t)l * DFF2;
    const int nitems = (MTOK / 128) * (DFF / 8);
    for (int it = blockIdx.x * NTH + opaque_tid(wv); it < nitems; it += gridDim.x * NTH) {
        const int cgp = it % (DFF / 8), wb = it / (DFF / 8); const int c0 = cgp * 8, t0 = wb * 128; const bool first = (t0 & (SEQ - 1)) == 0;
        const bf16_t* hc = HALO + (size_t)wb * 4 * DFF2; const bf16_t* hpv = hc - 4 * DFF2;
        u32x4 z = (u32x4){0, 0, 0, 0}; u32x4 gm2 = z, gm1 = z, vm2 = z, vm1 = z;
        if (!first) { gm2 = *(const u32x4*)(hpv + 2 * DFF2 + c0); gm1 = *(const u32x4*)(hpv + 3 * DFF2 + c0); vm2 = *(const u32x4*)(hpv + 2 * DFF2 + DFF + c0); vm1 = *(const u32x4*)(hpv + 3 * DFF2 + DFF + c0); }
        const u32x4 g0 = *(const u32x4*)(hc + c0), g1 = *(const u32x4*)(hc + DFF2 + c0), v0 = *(const u32x4*)(hc + DFF + c0), v1 = *(const u32x4*)(hc + DFF2 + DFF + c0);
        u32x4 o0, o1;
#pragma unroll
        for (int jj = 0; jj < 4; ++jj) {
            float r0[2], r1[2];
#pragma unroll
            for (int hl = 0; hl < 2; ++hl) { const int c = c0 + 2 * jj + hl;
                const float wg0 = cw[c], wg1 = cw[DFF2 + c], wg2 = cw[2 * DFF2 + c], wv0 = cw[DFF + c], wv1 = cw[DFF2 + DFF + c], wv2 = cw[2 * DFF2 + DFF + c], bg = cb[c], bv = cb[DFF + c];
                const float G2 = hl ? bfhi(gm2[jj]) : bflo(gm2[jj]), G1 = hl ? bfhi(gm1[jj]) : bflo(gm1[jj]), Ga = hl ? bfhi(g0[jj]) : bflo(g0[jj]), Gb = hl ? bfhi(g1[jj]) : bflo(g1[jj]);
                const float V2 = hl ? bfhi(vm2[jj]) : bflo(vm2[jj]), V1 = hl ? bfhi(vm1[jj]) : bflo(vm1[jj]), Va = hl ? bfhi(v0[jj]) : bflo(v0[jj]), Vb = hl ? bfhi(v1[jj]) : bflo(v1[jj]);
                r0[hl] = gelu_tanh(bg + wg0 * G2 + wg1 * G1 + wg2 * Ga) * (bv + wv0 * V2 + wv1 * V1 + wv2 * Va);
                r1[hl] = gelu_tanh(bg + wg0 * G1 + wg1 * Ga + wg2 * Gb) * (bv + wv0 * V1 + wv1 * Va + wv2 * Vb); }
            o0[jj] = pk2(r0[0], r0[1]); o1[jj] = pk2(r1[0], r1[1]); }
        *(u32x4*)(ACT + (size_t)t0 * DFF + c0) = o0; *(u32x4*)(ACT + (size_t)(t0 + 1) * DFF + c0) = o1;
    }
}
constexpr int LDS_BYTES = 136 * 1024;
__global__ void __launch_bounds__(NTH, 2) mk_fwd(Args a_unused) {
    ArgsP a = (ArgsP)__builtin_amdgcn_kernarg_segment_ptr(); asm volatile("" : "+s"(a));
    const int wv = __builtin_amdgcn_readfirstlane(threadIdx.x >> 6);
    extern __shared__ __attribute__((aligned(16))) unsigned char lds_raw[];
    LAS unsigned char* lds = (LAS unsigned char*)lds_raw;
    cg::grid_group grid = cg::this_grid();
    volatile LAS unsigned* xbst = (volatile LAS unsigned*)(lds + LDS_BYTES - 16);
    if (threadIdx.x < 4) xbst[threadIdx.x] = 0u;
    __syncthreads();
    const XcdBarrier xbar = xcd_barrier_post((unsigned*)(a->ws + WS_BAR), xbst);
    const int G = gridDim.x, bid = blockIdx.x;
    float* mod = (float*)(a->ws + WS_MOD);
    bf16_t* XN = (bf16_t*)(a->ws + WS_XN); bf16_t* P = (bf16_t*)(a->ws + WS_P);
#ifndef REPMASK
#define REPMASK 0
#endif
#ifndef XSYNC
#define XSYNC 0
#endif
#define RUN(k, ...) for (int _r = 0; _r < (((REPMASK >> (k)) & 1) ? 2 : 1); ++_r) { __VA_ARGS__ xcd_barrier(xbar, wv); }
    for (int _r = 0; _r < ((REPMASK & 1) ? 2 : 1); ++_r) { p0_mod(a, lds, wv); p0_weights(a, lds, wv); grid.sync(); }
    for (int _x = 0; _x < XSYNC; ++_x) xcd_barrier(xbar, wv);
    for (int l = 0; l < NL; ++l) {
        const float* modl = mod + (size_t)l * NB * 6144;
        const bf16_t* wl = (const bf16_t*)(a->ws + WS_W) + (size_t)l * W_LAYER_E;
        const float* xin = l == 0 ? a->in[0] : a->out;
        RUN(1, norm_phase(xin, a->in[4] + l * DM, modl, 0, 1, XN, wv);)
        RUN(2, { pg8::Gemm g{XN, wl + (size_t)4096 * DM, MTOK, 3072, DM}; pg8::StaticOrder S; S.init(MTOK, 3072, G, bid);
          EpiSplit E{P, (size_t)MTOK * DM, 0x0000, 0}; pg8::gemm_phase<EpiSplit, pg8::StaticOrder, true, true>(lds, g, S, E, wv); })
        RUN(3, attn_phase(a, l, lds, wv);)
        RUN(4, { pg8::Gemm g{XN, wl, MTOK, 4096, DM}; pg8::StaticOrder S; S.init(MTOK, 4096, G, bid);
          EpiSplit E{P, (size_t)MTOK * DM, 0x2210, 1}; pg8::gemm_phase<EpiSplit, pg8::StaticOrder, true, true>(lds, g, S, E, wv); })
        RUN(5, rnn_phase<false>(a, l, lds, wv);)
        RUN(6, carry_phase(a, wv);)
        RUN(7, rnn_phase<true>(a, l, lds, wv);)
        RUN(13, { pg8::Gemm g{XN, wl + W_IN_E, MTOK, DM, DM}; pg8::StaticOrder S; S.init(MTOK, DM, G, bid);
          EpiRes E{xin, a->out, modl + 2 * 1024, 0}; pg8::gemm_phase<EpiRes, pg8::StaticOrder, true, true>(lds, g, S, E, wv); })
        RUN(9, norm_phase(a->out, a->in[16] + l * DM, modl, 3, 4, XN, wv);)
        RUN(10, { pg8::Gemm g{XN, wl + W_IN_E + W_OUT_E, MTOK, DFF2, DM}; pg8::StaticOrder S; S.init(MTOK, DFF2, G, bid);
          EpiConvAct E{P, (bf16_t*)(a->ws + WS_P + ACT_BYTES), a->in[18] + (size_t)l * 3 * DFF2, a->in[19] + (size_t)l * DFF2};
          pg8::gemm_phase<EpiConvAct, pg8::StaticOrder, true, true, true>(lds, g, S, E, wv); })
        RUN(11, ffn_fixup(a, l, wv);)
        RUN(13, { pg8::Gemm g{P, wl + W_IN_E + W_OUT_E + W_UP_E, MTOK, DM, DFF}; pg8::StaticOrder S; S.init(MTOK, DM, G, bid);
          EpiRes E{a->out, a->out, modl + 5 * 1024, 0}; pg8::gemm_phase<EpiRes, pg8::StaticOrder, true, true>(lds, g, S, E, wv); })
    }
}
extern "C" void kernel_launch(void* const* d_in, const int* in_sizes, int n_in, void* d_out, int out_size, void* d_ws, size_t ws_size, hipStream_t stream) {
    static int grid = 0;
    if (!grid) {
        int dev = 0, cus = 0, per_cu = 0;
        (void)hipGetDevice(&dev);
        (void)hipDeviceGetAttribute(&cus, hipDeviceAttributeMultiprocessorCount, dev);
        (void)hipFuncSetAttribute((const void*)mk_fwd, hipFuncAttributeMaxDynamicSharedMemorySize, LDS_BYTES);
        (void)hipOccupancyMaxActiveBlocksPerMultiprocessor(&per_cu, (const void*)mk_fwd, NTH, LDS_BYTES);
        if (per_cu < 1) per_cu = 1;
        grid = cus * per_cu;
        if (ws_size < WS_END) { fprintf(stderr, "kernel_launch: workspace too small: %zu < %zu\n", ws_size, (size_t)WS_END); grid = -1; }
        if (n_in != 21 || out_size != MTOK * DM) { fprintf(stderr, "kernel_launch: unexpected shapes\n"); grid = -1; }
    }
    if (grid < 0) return;
    (void)hipMemsetAsync((char*)d_ws + WS_BAR, 0, XCD_BAR_WORDS * 4, stream);
    Args a{};
    for (int i = 0; i < 21; ++i) a.in[i] = (const float*)d_in[i];
    a.out = (float*)d_out; a.ws = (unsigned char*)d_ws;
    void* args[] = {&a};
    hipError_t e = hipLaunchCooperativeKernel((const void*)mk_fwd, dim3(grid), dim3(NTH), args, LDS_BYTES, stream);
    if (e != hipSuccess) fprintf(stderr, "cooperative launch failed: %s (grid %d)\n", hipGetErrorString(e), grid);
}
```

```cpp
#include <hip/hip_runtime.h>
#include <hip/hip_cooperative_groups.h>
#include <cstdio>
#include <cstdint>
namespace cg = cooperative_groups;
__device__ __forceinline__ int opaque_tid(int wv) { int t; asm volatile("v_mbcnt_lo_u32_b32 %0, -1, 0\n\tv_mbcnt_hi_u32_b32 %0, -1, %0" : "=v"(t)); return t | (wv << 6); }
__device__ __forceinline__ int opaque_bid() { int t = blockIdx.x; asm volatile("" : "+s"(t)); return t; }
namespace pg8 {
#define PG8_LAS __attribute__((address_space(3)))
typedef unsigned short bf16_t;
typedef short bf16x8 __attribute__((ext_vector_type(8)));
typedef float f32x4 __attribute__((ext_vector_type(4)));
typedef unsigned u32x4 __attribute__((ext_vector_type(4)));
constexpr int BM = 256, BK = 64, HALF = 128, HTB = HALF * BK * 2  , STAGE_BYTES = 8 * HTB, NXCD = 8, WGM = 8;

__host__ __device__ __forceinline__ int lds_byte(int r, int c) { const int st = (r >> 4) * 2 + (c >> 5), rr = r & 15, cc = c & 31, ob = rr * 64 + cc * 2; return st * 1024 + (ob ^ (((ob >> 9) & 1) << 5)); }
__host__ __device__ __forceinline__ void stage_rc(int b, int& R, int& C) { const int st = b / 1024, sb = b % 1024, swz = sb ^ (((sb >> 9) & 1) << 5); R = (st >> 1) * 16 + swz / 64; C = (st & 1) * 32 + (swz % 64) / 2; }
__host__ __device__ __forceinline__ int perm32(int rho) { const int n = rho >> 4, i = rho & 15; return 8 * (i >> 2) + 4 * n + (i & 3); }

struct Unit { int pm, pn; };
struct Gemm { const bf16_t* A; const bf16_t* Bt; int M, N, K; };

struct StaticOrder {
    int nM, nN, nwg, G, c;
    __host__ __device__ void init(int M, int N, int G_, int c_) { nM = M / BM; nN = N / BM; nwg = nM * nN; G = G_; c = c_; }
    __host__ __device__ bool next(int i, Unit& u) const {
        const long L = (long)i * G + c; if (L >= nwg) return false;
        int wgid = (int)L; { const int q = nwg / NXCD, r = nwg % NXCD, xcd = wgid % NXCD, off = wgid / NXCD; wgid = (xcd < r ? xcd * (q + 1) : r * (q + 1) + (xcd - r) * q) + off; }
        const int nig = WGM * nN, gid = wgid / nig, fm = gid * WGM, gsz = (nM - fm) < WGM ? (nM - fm) : WGM;
        u.pm = fm + ((wgid % nig) % gsz); u.pn = (wgid % nig) / gsz; return true;
    }
    __device__ __forceinline__ void a_ready(const Unit&) const {}
    __device__ __forceinline__ void done(const Unit&) const {}
};

template <class Epi, class Sched, bool ALIGN_EPI = false, bool SP2 = false, bool ROWPERM = false>
__device__ __forceinline__ void gemm_phase(PG8_LAS unsigned char* lds, const Gemm g, const Sched& S, const Epi& E, const int wv) {
    const int tid = opaque_tid(wv), wid = __builtin_amdgcn_readfirstlane(tid >> 6), lane = tid & 63, wr = wid >> 2, wc = wid & 3, fr = lane & 15, fq = lane >> 4;
    const int K = g.K, nt = K / BK;
    unsigned voffA[2], voffB[2];
#pragma unroll
    for (int i = 0; i < 2; ++i) { int R, C; stage_rc(tid * 16 + i * 8192, R, C); const int Rb = Epi::PERM ? ((R & ~31) + perm32(R & 31)) : R;
        const int Ra = ROWPERM ? (128 * (R >> 6) + 8 * (R & 15) + ((R >> 4) & 3)) : R;
        voffA[i] = (unsigned)(Ra * K + C) * 2u; voffB[i] = (unsigned)(Rb * K + C) * 2u; }
    const size_t kstep = (size_t)(BK * 2);
    const size_t hstep = (size_t)HALF * K * 2;
    const size_t tstep = 2 * hstep; const size_t hstepA = ROWPERM ? (size_t)4 * K * 2 : hstep;
    const unsigned ldsw = (unsigned)wid * 1024u;
    const int aoff = lds_byte(wr * 64 + fr, fq * 8), boff = lds_byte(wc * 32 + fr, fq * 8);
#define PG8_SA(b, h) (((b) * 2 + (h)) * HTB)
#define PG8_SB(b, h) ((4 + (b) * 2 + (h)) * HTB)
#define PG8_STAGE(bufoff, gbase, voff) do { _Pragma("unroll") for (int _i = 0; _i < 2; ++_i) \
        __builtin_amdgcn_global_load_lds((const unsigned*)((const char*)(gbase) + (voff)[_i]), (PG8_LAS unsigned*)(lds + (bufoff) + ldsw + _i * 8192), 16, 0, 0); } while (0)
#define PG8_LDA(dst, b, h) do { _Pragma("unroll") for (int m = 0; m < 4; ++m) _Pragma("unroll") for (int k = 0; k < 2; ++k) dst[m][k] = *(const PG8_LAS bf16x8*)(lds + PG8_SA(b, h) + aoff + m * 2048 + k * 1024); } while (0)
#define PG8_LDB(dst, b, h) do { _Pragma("unroll") for (int n = 0; n < 2; ++n) _Pragma("unroll") for (int k = 0; k < 2; ++k) dst[n][k] = *(const PG8_LAS bf16x8*)(lds + PG8_SB(b, h) + boff + n * 2048 + k * 1024); } while (0)
#define PG8_MMA(ai, bj, At, Bt) do { __builtin_amdgcn_s_setprio(1); _Pragma("unroll") for (int m = 0; m < 4; ++m) _Pragma("unroll") for (int n = 0; n < 2; ++n) _Pragma("unroll") for (int k = 0; k < 2; ++k) \
        acc[ai][bj][m][n] = __builtin_amdgcn_mfma_f32_16x16x32_bf16(Bt[n][k], At[m][k], acc[ai][bj][m][n], 0, 0, 0); __builtin_amdgcn_s_setprio(0); } while (0)
#define PG8_WAIT_V(n) asm volatile("s_waitcnt vmcnt(" #n ")" ::: "memory")
#define PG8_WAIT_L(n) asm volatile("s_waitcnt lgkmcnt(" #n ")" ::: "memory")
#define PG8_BAR __builtin_amdgcn_s_barrier()
#define PG8_SCHED __builtin_amdgcn_sched_barrier(0)
    Unit cur, nxt; int ui = 0;
    if (!S.next(0, cur)) return;
    f32x4 acc[2][2][4][2];
#pragma unroll
    for (int a = 0; a < 2; ++a)
#pragma unroll
        for (int b = 0; b < 2; ++b)
#pragma unroll
            for (int m = 0; m < 4; ++m)
#pragma unroll
                for (int n = 0; n < 2; ++n) acc[a][b][m][n] = (f32x4){0.f, 0.f, 0.f, 0.f};
    bf16x8 At[4][2], B0[2][2], B1[2][2];
    const char* cA = (const char*)g.A + (size_t)cur.pm * tstep; const char* cB = (const char*)g.Bt + (size_t)cur.pn * tstep;
    S.a_ready(cur);
    if constexpr (SP2) {
        PG8_STAGE(PG8_SB(0, 0), cB, voffB); PG8_STAGE(PG8_SB(0, 1), cB + hstep, voffB); PG8_STAGE(PG8_SA(0, 0), cA, voffA); PG8_STAGE(PG8_SA(0, 1), cA + hstepA, voffA);
        if (wr == 1) PG8_BAR;
        PG8_WAIT_V(2); PG8_BAR;
        PG8_STAGE(PG8_SB(1, 0), cB + kstep, voffB); PG8_STAGE(PG8_SA(1, 0), cA + kstep, voffA); PG8_STAGE(PG8_SB(1, 1), cB + hstep + kstep, voffB);
        PG8_WAIT_V(6); PG8_BAR;
    } else {
        PG8_STAGE(PG8_SB(0, 0), cB, voffB); PG8_STAGE(PG8_SA(0, 0), cA, voffA); PG8_STAGE(PG8_SB(0, 1), cB + hstep, voffB); PG8_STAGE(PG8_SA(0, 1), cA + hstepA, voffA);
        if (wr == 1) PG8_BAR;
        PG8_WAIT_V(4); PG8_BAR;
        PG8_STAGE(PG8_SB(1, 0), cB + kstep, voffB); PG8_STAGE(PG8_SA(1, 0), cA + kstep, voffA); PG8_STAGE(PG8_SB(1, 1), cB + hstep + kstep, voffB);
        PG8_WAIT_V(6); PG8_BAR;
    }
    for (;;) {
        const bool has_next = S.next(ui + 1, nxt);
        const char* nA = has_next ? (const char*)g.A + (size_t)nxt.pm * tstep : cA; const char* nB = has_next ? (const char*)g.Bt + (size_t)nxt.pn * tstep : cB;
        for (int t = 0; t < nt; t += 2) {
            const bool last = (t == nt - 2);
            const char* a1 = cA + (size_t)(t + 1) * kstep;
            const char* a2 = last ? nA : cA + (size_t)(t + 2) * kstep; const char* b2 = last ? nB : cB + (size_t)(t + 2) * kstep;
            const char* a3 = a2 + kstep; const char* b3 = b2 + kstep;
            if (last && has_next) S.a_ready(nxt);
            if constexpr (SP2) {
            PG8_LDB(B0, 0, 0); PG8_LDB(B1, 0, 1); PG8_SCHED; PG8_LDA(At, 0, 0); PG8_STAGE(PG8_SA(1, 1), a1 + hstepA, voffA);
            PG8_WAIT_V(8); PG8_WAIT_L(0); PG8_BAR; PG8_MMA(0, 0, At, B0); PG8_MMA(0, 1, At, B1); PG8_BAR; PG8_SCHED;
            PG8_LDA(At, 0, 1); PG8_STAGE(PG8_SB(0, 0), b2, voffB); PG8_STAGE(PG8_SB(0, 1), b2 + hstep, voffB); PG8_STAGE(PG8_SA(0, 0), a2, voffA);
            PG8_WAIT_V(8); PG8_WAIT_L(0); PG8_BAR; PG8_MMA(1, 0, At, B0); PG8_MMA(1, 1, At, B1); PG8_BAR; PG8_SCHED;
            PG8_LDB(B0, 1, 0); PG8_LDB(B1, 1, 1); PG8_SCHED; PG8_LDA(At, 1, 0); PG8_STAGE(PG8_SA(0, 1), a2 + hstepA, voffA);
            PG8_WAIT_V(8); PG8_WAIT_L(0); PG8_BAR; PG8_MMA(0, 0, At, B0); PG8_MMA(0, 1, At, B1); PG8_BAR; PG8_SCHED;
            PG8_LDA(At, 1, 1); PG8_STAGE(PG8_SB(1, 0), b3, voffB); PG8_STAGE(PG8_SB(1, 1), b3 + hstep, voffB); PG8_STAGE(PG8_SA(1, 0), a3, voffA);
            PG8_WAIT_V(8); PG8_WAIT_L(0); PG8_BAR; PG8_MMA(1, 0, At, B0); PG8_MMA(1, 1, At, B1); PG8_BAR; PG8_SCHED;
            } else {
            PG8_LDB(B0, 0, 0); PG8_SCHED; PG8_LDA(At, 0, 0); PG8_STAGE(PG8_SA(1, 1), a1 + hstepA, voffA);
            PG8_WAIT_L(8); PG8_BAR; PG8_WAIT_L(0); PG8_MMA(0, 0, At, B0); PG8_BAR; PG8_SCHED;
            PG8_LDB(B1, 0, 1); PG8_STAGE(PG8_SB(0, 0), b2, voffB);
            PG8_BAR; PG8_WAIT_L(0); PG8_MMA(0, 1, At, B1); PG8_BAR;
            PG8_LDA(At, 0, 1); PG8_STAGE(PG8_SA(0, 0), a2, voffA);
            PG8_BAR; PG8_WAIT_L(0); PG8_MMA(1, 0, At, B0); PG8_BAR; PG8_SCHED;
            PG8_STAGE(PG8_SB(0, 1), b2 + hstep, voffB);
            PG8_WAIT_V(6); PG8_BAR; PG8_MMA(1, 1, At, B1); PG8_BAR;
            PG8_LDB(B0, 1, 0); PG8_SCHED; PG8_LDA(At, 1, 0); PG8_STAGE(PG8_SA(0, 1), a2 + hstepA, voffA);
            PG8_WAIT_L(8); PG8_BAR; PG8_WAIT_L(0); PG8_MMA(0, 0, At, B0); PG8_BAR; PG8_SCHED;
            PG8_LDB(B1, 1, 1); PG8_STAGE(PG8_SB(1, 0), b3, voffB);
            PG8_BAR; PG8_WAIT_L(0); PG8_MMA(0, 1, At, B1); PG8_BAR;
            PG8_LDA(At, 1, 1); PG8_STAGE(PG8_SA(1, 0), a3, voffA);
            PG8_BAR; PG8_WAIT_L(0); PG8_MMA(1, 0, At, B0); PG8_BAR; PG8_SCHED;
            PG8_STAGE(PG8_SB(1, 1), b3 + hstep, voffB);
            PG8_WAIT_V(6); PG8_BAR; PG8_MMA(1, 1, At, B1); PG8_BAR;
            }
        }
        if constexpr (ALIGN_EPI) { if (wr == 0) PG8_BAR; }
        if constexpr (!Epi::AFTER_DRAIN) { E(acc, cur, wr, wc, fr, fq); S.done(cur); }
        if (!has_next) break;
#pragma unroll
        for (int a = 0; a < 2; ++a)
#pragma unroll
            for (int b = 0; b < 2; ++b)
#pragma unroll
                for (int m = 0; m < 4; ++m)
#pragma unroll
                    for (int n = 0; n < 2; ++n) acc[a][b][m][n] = (f32x4){0.f, 0.f, 0.f, 0.f};
        cur = nxt; cA = nA; cB = nB; ++ui;
        if constexpr (ALIGN_EPI) { if (wr == 1) PG8_BAR; }
    }
    PG8_WAIT_V(0);
    if constexpr (!ALIGN_EPI) { if (wr == 0) PG8_BAR; }
    PG8_BAR;
    if constexpr (Epi::AFTER_DRAIN) { E.fused(acc, cur, wr, wc, fr, fq, lds, wid, lane); S.done(cur); }
#undef PG8_SA
#undef PG8_SB
#undef PG8_STAGE
#undef PG8_LDA
#undef PG8_LDB
#undef PG8_MMA
#undef PG8_WAIT_V
#undef PG8_WAIT_L
#undef PG8_BAR
#undef PG8_SCHED
}
}
typedef pg8::bf16_t bf16_t;
typedef pg8::bf16x8 bf16x8;
typedef pg8::f32x4 f32x4;
typedef pg8::u32x4 u32x4;
typedef unsigned u32x2 __attribute__((ext_vector_type(2)));
#define LAS __attribute__((address_space(3)))

constexpr int DM = 1024, NB = 4, SEQ = 8192, MTOK = NB * SEQ, DIN = 7168, DFF = 3072, DFF2 = 6144, NL = 2;
constexpr int NTH = 512;
constexpr float EPS = 1e-6f;
constexpr int RT = 128, NT = SEQ / RT;
constexpr size_t WS_BAR = 0;
constexpr size_t WS_MOD = 16384;
constexpr size_t WS_GW = WS_MOD + (size_t)NL * NB * 6144 * 4;
constexpr size_t WS_SUM = WS_GW + (size_t)NL * 2 * 8 * 128 * 128 * 2;
constexpr size_t WS_HIN = WS_SUM + (size_t)NB * NT * 1024 * 2 * 4;
constexpr size_t WS_W = (WS_HIN + (size_t)NB * NT * 1024 * 4 + 4095) / 4096 * 4096;
constexpr size_t W_IN_E = (size_t)DIN * DM, W_OUT_E = (size_t)DM * DM, W_UP_E = (size_t)DFF2 * DM, W_DN_E = (size_t)DM * DFF, W_LAYER_E = W_IN_E + W_OUT_E + W_UP_E + W_DN_E;
constexpr size_t WS_XN = WS_W + NL * W_LAYER_E * 2;
constexpr size_t PBUF = (size_t)MTOK * DM * 2;
constexpr size_t WS_P = WS_XN + PBUF;
constexpr size_t WS_END = WS_P + 5 * PBUF;
constexpr size_t ACT_BYTES = (size_t)MTOK * DFF * 2;

__device__ __forceinline__ float bf2f(bf16_t b) { return __uint_as_float(((unsigned)b) << 16); }
__device__ __forceinline__ unsigned pk2(float lo, float hi) { unsigned r; asm volatile("v_cvt_pk_bf16_f32 %0, %1, %2" : "=v"(r) : "v"(lo), "v"(hi)); return r; }
__device__ __forceinline__ float bflo(unsigned w) { return __uint_as_float(w << 16); }
__device__ __forceinline__ float bfhi(unsigned w) { return __uint_as_float(w & 0xffff0000u); }
__device__ __forceinline__ float sigmoidf_(float x) { return __builtin_amdgcn_rcpf(1.0f + __expf(-x)); }
__device__ __forceinline__ float gelu_tanh(float x) { const float u = 1.5957691216057308f * (x + 0.044715f * x * x * x); return x * sigmoidf_(u); }

struct EpiSplit {
    static constexpr bool PERM = true, AFTER_DRAIN = false;
    bf16_t* base; size_t tstride; int modes; int skip3;
    __device__ __forceinline__ void operator()(const f32x4 (&acc)[2][2][4][2], const pg8::Unit& u, int wr, int wc, int fr, int fq) const {
        const int colt = u.pn * 256, t = colt >> 10; const int mode = (modes >> (4 * t)) & 15;
        bf16_t* o = base + (size_t)(t + ((skip3 && t == 3) ? 1 : 0)) * tstride; const int col0 = (colt & 1023) + wc * 32 + 8 * fq; const int row0 = u.pm * 256 + wr * 64 + fr;
#pragma unroll
        for (int ai = 0; ai < 2; ++ai)
#pragma unroll
            for (int m = 0; m < 4; ++m) { bf16_t* rowp = o + (size_t)(row0 + ai * 128 + m * 16) * DM + col0;
#pragma unroll
                for (int bj = 0; bj < 2; ++bj) { f32x4 v0 = acc[ai][bj][m][0], v1 = acc[ai][bj][m][1];
                    if (mode == 1) {
#pragma unroll
                        for (int j = 0; j < 4; ++j) { v0[j] = gelu_tanh(v0[j]); v1[j] = gelu_tanh(v1[j]); } }
                    else if (mode == 2) {
#pragma unroll
                        for (int j = 0; j < 4; ++j) { v0[j] = sigmoidf_(v0[j]); v1[j] = sigmoidf_(v1[j]); } }
                    u32x4 w; w.x = pk2(v0[0], v0[1]); w.y = pk2(v0[2], v0[3]); w.z = pk2(v1[0], v1[1]); w.w = pk2(v1[2], v1[3]);
                    *(u32x4*)(rowp + bj * 128) = w; } }
    }
};
struct EpiPlain {
    static constexpr bool PERM = true, AFTER_DRAIN = false;
    bf16_t* o; int ldc;
    __device__ __forceinline__ void operator()(const f32x4 (&acc)[2][2][4][2], const pg8::Unit& u, int wr, int wc, int fr, int fq) const {
        const int col0 = u.pn * 256 + wc * 32 + 8 * fq; const int row0 = u.pm * 256 + wr * 64 + fr;
#pragma unroll
        for (int ai = 0; ai < 2; ++ai)
#pragma unroll
            for (int m = 0; m < 4; ++m) { bf16_t* rowp = o + (size_t)(row0 + ai * 128 + m * 16) * ldc + col0;
#pragma unroll
                for (int bj = 0; bj < 2; ++bj) { const f32x4 v0 = acc[ai][bj][m][0], v1 = acc[ai][bj][m][1];
                    u32x4 w; w.x = pk2(v0[0], v0[1]); w.y = pk2(v0[2], v0[3]); w.z = pk2(v1[0], v1[1]); w.w = pk2(v1[2], v1[3]);
                    *(u32x4*)(rowp + bj * 128) = w; } }
    }
};
struct EpiRes {
    static constexpr bool PERM = false, AFTER_DRAIN = false;
    const float* res; float* out; const float* gate  ; int row_off;
    __device__ __forceinline__ void operator()(const f32x4 (&acc)[2][2][4][2], const pg8::Unit& u, int wr, int wc, int fr, int fq) const {
        const int grow0 = row_off + u.pm * 256; const int b = grow0 / SEQ; const int row0 = grow0 + wr * 64 + fr, col0 = u.pn * 256 + wc * 32 + 4 * fq;
        f32x4 gv[2][2];
#pragma unroll
        for (int bj = 0; bj < 2; ++bj)
#pragma unroll
            for (int n = 0; n < 2; ++n) gv[bj][n] = *(const f32x4*)(gate + (size_t)b * 6144 + col0 + bj * 128 + n * 16);
#pragma unroll
        for (int ai = 0; ai < 2; ++ai)
#pragma unroll
            for (int m = 0; m < 4; ++m) { const size_t off = (size_t)(row0 + ai * 128 + m * 16) * DM + col0;
#pragma unroll
                for (int bj = 0; bj < 2; ++bj)
#pragma unroll
                    for (int n = 0; n < 2; ++n) { const f32x4 r = *(const f32x4*)(res + off + bj * 128 + n * 16); *(f32x4*)(out + off + bj * 128 + n * 16) = r + gv[bj][n] * acc[ai][bj][m][n]; }
                asm volatile("" ::: "memory"); }
    }
};


#define XB_TMO      128
#define XB_XCNT(j)  (256  + 64 * (j))
#define XB_XSUB(j)  (1280 + 64 * (j))
#define XB_XGEN(j)  (2304 + 64 * (j))
#define XB_TOP      3328
#define XB_TOPGEN   3392
#define XCD_BAR_WORDS 3456
#define XB_SPIN_CAP (1u << 22)
__device__ __forceinline__ unsigned xb_ld(unsigned* p)              { return __hip_atomic_load(p, __ATOMIC_RELAXED, __HIP_MEMORY_SCOPE_AGENT); }
__device__ __forceinline__ unsigned xb_add(unsigned* p, unsigned v) { return __hip_atomic_fetch_add(p, v, __ATOMIC_RELAXED, __HIP_MEMORY_SCOPE_AGENT); }
__device__ __forceinline__ unsigned xb_xcc_id() { return (unsigned)__builtin_amdgcn_s_getreg((3 << 11) | 20) & 0xFu; }
#define XB_SPIN(cond, bar) do { unsigned _sp = 0; while (cond) { __builtin_amdgcn_s_sleep(1); \
    if ((++_sp & 255u) == 0u) { if (xb_ld(&(bar)[XB_TMO])) break; if (_sp > XB_SPIN_CAP) { atomicAdd(&(bar)[XB_TMO], 1u); break; } } } } while (0)
struct XcdBarrier { unsigned* bar; unsigned x; volatile LAS unsigned* st; };
__device__ __forceinline__ XcdBarrier xcd_barrier_post(unsigned* bar, volatile LAS unsigned* st) {
    XcdBarrier b; b.bar = bar; b.x = xb_xcc_id(); b.st = st;
    if (threadIdx.x == 0) (void)xb_add(&bar[XB_XCNT(b.x)], 1u);
    return b;
}
__device__ __forceinline__ void xcd_barrier_complete(unsigned* bar, unsigned x, unsigned& nloc, unsigned& nx) {
    const unsigned G = gridDim.x * gridDim.y * gridDim.z;
    unsigned sum, cnt, mine, sp = 0u;
    for (;;) {
        sum = 0u; cnt = 0u; mine = 0u;
#pragma unroll
        for (unsigned j = 0; j < 16; ++j) { const unsigned c = xb_ld(&bar[XB_XCNT(j)]); sum += c; cnt += (c > 0u) ? 1u : 0u; mine = (j == x) ? c : mine; }
        if (sum == G) break;
        __builtin_amdgcn_s_sleep(1);
        if ((++sp & 255u) == 0u) { if (xb_ld(&bar[XB_TMO])) break; if (sp > XB_SPIN_CAP) { atomicAdd(&bar[XB_TMO], 1u); break; } }
    }
    nloc = mine > 0u ? mine : 1u; nx = cnt > 0u ? cnt : 1u;
}
__device__ __forceinline__ void xcd_barrier(const XcdBarrier& b, const int wv) {
    asm volatile("s_waitcnt vmcnt(0)" ::: "memory");
    __syncthreads();
    if (opaque_tid(wv) == 0) {
        unsigned* bar = b.bar;
        __builtin_amdgcn_s_waitcnt(0);
        unsigned nloc = b.st[0], nx = b.st[1];
        if (nloc == 0u) { xcd_barrier_complete(bar, b.x, nloc, nx); b.st[0] = nloc; b.st[1] = nx; }
        const unsigned old = xb_add(&bar[XB_XSUB(b.x)], 1u);
        const unsigned gen = old / nloc;
        if (old + 1u == (gen + 1u) * nloc) {
            __builtin_amdgcn_fence(__ATOMIC_RELEASE, "agent");
            asm volatile("s_waitcnt vmcnt(0)" ::: "memory");
            const unsigned og = xb_add(&bar[XB_TOP], 1u);
            const unsigned tg = og / nx;
            if (og + 1u == (tg + 1u) * nx) xb_add(&bar[XB_TOPGEN], 1u);
            else XB_SPIN(xb_ld(&bar[XB_TOPGEN]) == tg, bar);
            __builtin_amdgcn_fence(__ATOMIC_ACQUIRE, "agent");
            xb_add(&bar[XB_XGEN(b.x)], 1u);
            asm volatile("s_waitcnt vmcnt(0)" ::: "memory");
        } else {
            XB_SPIN(xb_ld(&bar[XB_XGEN(b.x)]) == gen, bar);
            __builtin_amdgcn_fence(__ATOMIC_ACQUIRE, "agent");
            asm volatile("s_waitcnt vmcnt(0)" ::: "memory");
        }
    }
    __syncthreads();
}

__device__ __forceinline__ float dpp_shr1(float x) { return __builtin_bit_cast(float, __builtin_amdgcn_update_dpp(0, __builtin_bit_cast(int, x), 0x111, 0xf, 0xf, false)); }
struct EpiConvAct {
    static constexpr bool PERM = true, AFTER_DRAIN = false;
    bf16_t* act; bf16_t* halo; const float* cw; const float* cb;
    __device__ __forceinline__ void operator()(const f32x4 (&acc)[2][2][4][2], const pg8::Unit& u, int wr, int wc, int fr, int fq) const {
        const int tb = u.pm * 256 + 128 * wr, c0 = u.pn * 128 + wc * 32 + 8 * fq;
        bf16_t* hp = halo + (size_t)(tb >> 7) * 4 * DFF2;
#pragma unroll
        for (int n = 0; n < 2; ++n) {
            const int c = c0 + 4 * n;
            const f32x4 bg = *(const f32x4*)(cb + c), bv = *(const f32x4*)(cb + DFF + c);
            const f32x4 wg0 = *(const f32x4*)(cw + c), wg1 = *(const f32x4*)(cw + DFF2 + c), wg2 = *(const f32x4*)(cw + 2 * DFF2 + c);
            const f32x4 wv0 = *(const f32x4*)(cw + DFF + c), wv1 = *(const f32x4*)(cw + DFF2 + DFF + c), wv2 = *(const f32x4*)(cw + 2 * DFF2 + DFF + c);
            f32x4 pg6, pg7, pv6, pv7;
#pragma unroll
            for (int j = 0; j < 4; ++j) { pg6[j] = dpp_shr1(acc[1][0][2][n][j]); pg7[j] = dpp_shr1(acc[1][0][3][n][j]); pv6[j] = dpp_shr1(acc[1][1][2][n][j]); pv7[j] = dpp_shr1(acc[1][1][3][n][j]); }
#pragma unroll
            for (int q = 0; q < 8; ++q) {
                const f32x4 g = acc[q >> 2][0][q & 3][n], v = acc[q >> 2][1][q & 3][n];
                const f32x4 g1 = q >= 1 ? acc[(q - 1 + 8) % 8 >> 2][0][(q - 1 + 8) % 8 & 3][n] : pg7, g2 = q >= 2 ? acc[(q - 2 + 8) % 8 >> 2][0][(q - 2 + 8) % 8 & 3][n] : (q == 1 ? pg7 : pg6);
                const f32x4 v1 = q >= 1 ? acc[(q - 1 + 8) % 8 >> 2][1][(q - 1 + 8) % 8 & 3][n] : pv7, v2 = q >= 2 ? acc[(q - 2 + 8) % 8 >> 2][1][(q - 2 + 8) % 8 & 3][n] : (q == 1 ? pv7 : pv6);
                const f32x4 g1e = q == 0 ? pg7 : g1, g2e = q == 0 ? pg6 : g2, v1e = q == 0 ? pv7 : v1, v2e = q == 0 ? pv6 : v2;
                float o[4];
#pragma unroll
                for (int j = 0; j < 4; ++j) { const float cg = bg[j] + wg0[j] * g2e[j] + wg1[j] * g1e[j] + wg2[j] * g[j]; const float cv = bv[j] + wv0[j] * v2e[j] + wv1[j] * v1e[j] + wv2[j] * v[j]; o[j] = gelu_tanh(cg) * cv; }
                if (fr > 0 || q >= 2) { u32x2 w; w.x = pk2(o[0], o[1]); w.y = pk2(o[2], o[3]); *(u32x2*)(act + (size_t)(tb + 8 * fr + q) * DFF + c) = w; }
                if ((fr == 0 && q < 2) || (fr == 15 && q >= 6)) { const int r = q < 2 ? q : q - 4; u32x2 wgp, wvp; wgp.x = pk2(g[0], g[1]); wgp.y = pk2(g[2], g[3]); wvp.x = pk2(v[0], v[1]); wvp.y = pk2(v[2], v[3]);
                    *(u32x2*)(hp + (size_t)r * DFF2 + c) = wgp; *(u32x2*)(hp + (size_t)r * DFF2 + DFF + c) = wvp; }
            }
        }
    }
};

struct Args { const float* in[21]; float* out; unsigned char* ws; };
typedef const __attribute__((address_space(4))) Args* ArgsP;

__device__ void p0_mod(ArgsP a, LAS unsigned char* lds, const int wv) {
    const int tid = opaque_tid(wv), w = tid >> 6, lane = tid & 63;
    const float* c = a->in[1]; const float* aw = a->in[2]; const float* ab = a->in[3]; float* mod = (float*)(a->ws + WS_MOD);
    LAS float* red = (LAS float*)lds;
    for (int grp = blockIdx.x; grp < NL * 6144 / 48; grp += gridDim.x) {
        const int gl = grp * 48 + (lane < 48 ? lane : 47), l = gl / 6144, j = gl % 6144;
        const float* wp = aw + (size_t)l * DM * 6144 + j;
        float s0 = 0.f, s1 = 0.f, s2 = 0.f, s3 = 0.f;
#pragma unroll 16
        for (int k = w * 128; k < w * 128 + 128; ++k) { const float wv = wp[(size_t)k * 6144]; s0 += c[k] * wv; s1 += c[DM + k] * wv; s2 += c[2 * DM + k] * wv; s3 += c[3 * DM + k] * wv; }
        red[(w * 4 + 0) * 64 + lane] = s0; red[(w * 4 + 1) * 64 + lane] = s1; red[(w * 4 + 2) * 64 + lane] = s2; red[(w * 4 + 3) * 64 + lane] = s3;
        __syncthreads();
        if (tid < 256 && lane < 48) { const int b = tid >> 6; float s = ab[(size_t)l * 6144 + j];
#pragma unroll
            for (int ww = 0; ww < 8; ++ww) s += red[(ww * 4 + b) * 64 + lane];
            mod[((size_t)l * NB + b) * 6144 + j] = s; }
        __syncthreads();
    }
    bf16_t* gw = (bf16_t*)(a->ws + WS_GW);
    for (size_t idx = (size_t)blockIdx.x * NTH + tid; idx < (size_t)NL * 2 * 8 * 128 * 128; idx += (size_t)gridDim.x * NTH) {
        const int i = idx & 127, j = (idx >> 7) & 127, h = (idx >> 14) & 7, mat = (idx >> 17) & 1, l = (int)(idx >> 18);
        const float* src = a->in[mat ? 10 : 8];
        const float v = src[(((size_t)l * 8 + h) * 128 + i) * 128 + j];
        gw[idx] = (bf16_t)(pk2(v, v) & 0xffff);
    }
}
struct TMat { const float* W; bf16_t* Wt; int K, N, rmode, ntn; };
__device__ __forceinline__ TMat tmat_of(ArgsP a, int mi) {
    const int l = mi >> 2, k = mi & 3; bf16_t* wl = (bf16_t*)(a->ws + WS_W) + (size_t)l * W_LAYER_E; TMat m;
    if (k == 0) { m.W = a->in[5] + (size_t)l * DM * DIN; m.Wt = wl; m.K = DM; m.N = DIN; m.rmode = 1; }
    else if (k == 1) { m.W = a->in[15] + (size_t)l * DM * DM; m.Wt = wl + W_IN_E; m.K = DM; m.N = DM; m.rmode = 0; }
    else if (k == 2) { m.W = a->in[17] + (size_t)l * DM * DFF2; m.Wt = wl + W_IN_E + W_OUT_E; m.K = DM; m.N = DFF2; m.rmode = 2; }
    else { m.W = a->in[20] + (size_t)l * DFF * DM; m.Wt = wl + W_IN_E + W_OUT_E + W_UP_E; m.K = DFF; m.N = DM; m.rmode = 0; }
    m.ntn = m.N / 64; return m;
}
constexpr int TILES_IN = (DM / 64) * (DIN / 64), TILES_OUT = (DM / 64) * (DM / 64), TILES_UP = (DM / 64) * (DFF2 / 64), TILES_DN = (DFF / 64) * (DM / 64), TILES_L = TILES_IN + TILES_OUT + TILES_UP + TILES_DN;
__device__ __forceinline__ void tile_of(int g, int& mi, int& tile) {
    const int l = g / TILES_L; int r = g - l * TILES_L; int k = 0;
    if (r >= TILES_IN) { r -= TILES_IN; k = 1; if (r >= TILES_OUT) { r -= TILES_OUT; k = 2; if (r >= TILES_UP) { r -= TILES_UP; k = 3; } } }
    mi = l * 4 + k; tile = r;
}
__device__ void p0_weights(ArgsP a, LAS unsigned char* lds, const int wv) {
    LAS float* t = (LAS float*)lds;
    const int tid = opaque_tid(wv); const int G = gridDim.x;
    int g = blockIdx.x; if (g >= NL * TILES_L) return;
    int mi, tile; tile_of(g, mi, tile); TMat m = tmat_of(a, mi);
    f32x4 v0, v1;
    { const int k0 = (tile / m.ntn) * 64, n0 = (tile % m.ntn) * 64; const float* p = m.W + (size_t)(k0 + (tid >> 4)) * m.N + n0 + (tid & 15) * 4; v0 = *(const f32x4*)p; v1 = *(const f32x4*)(p + (size_t)32 * m.N); }
    for (;;) {
        const int k0 = (tile / m.ntn) * 64, n0 = (tile % m.ntn) * 64; const TMat cm = m;
        { const int k = tid >> 4, n = (tid & 15) * 4;
          t[k * 65 + n] = v0[0]; t[k * 65 + n + 1] = v0[1]; t[k * 65 + n + 2] = v0[2]; t[k * 65 + n + 3] = v0[3];
          t[(k + 32) * 65 + n] = v1[0]; t[(k + 32) * 65 + n + 1] = v1[1]; t[(k + 32) * 65 + n + 2] = v1[2]; t[(k + 32) * 65 + n + 3] = v1[3]; }
        g += G; const bool more = g < NL * TILES_L;
        if (more) { tile_of(g, mi, tile); m = tmat_of(a, mi); const int k1 = (tile / m.ntn) * 64, n1 = (tile % m.ntn) * 64;
            const float* p = m.W + (size_t)(k1 + (tid >> 4)) * m.N + n1 + (tid & 15) * 4; v0 = *(const f32x4*)p; v1 = *(const f32x4*)(p + (size_t)32 * m.N); }
        __syncthreads();
        { const int n = tid >> 3, p = tid & 7; float v[8];
#pragma unroll
          for (int e = 0; e < 8; ++e) v[e] = t[(p * 8 + e) * 65 + n];
          u32x4 w; w.x = pk2(v[0], v[1]); w.y = pk2(v[2], v[3]); w.z = pk2(v[4], v[5]); w.w = pk2(v[6], v[7]);
          int nr = n0 + n; if (cm.rmode == 1) nr = nr < 2048 ? nr : (nr < 5120 ? nr + 2048 : nr - 3072);
          else if (cm.rmode == 2) nr = nr < DFF ? ((nr >> 7) * 256 + (nr & 127)) : (((nr - DFF) >> 7) * 256 + 128 + ((nr - DFF) & 127));
          *(u32x4*)(cm.Wt + (size_t)nr * cm.K + k0 + p * 8) = w; }
        __syncthreads();
        if (!more) break;
    }
}
__device__ void norm_phase(const float* __restrict__ x, const float* __restrict__ g, const float* __restrict__ modl  , int shk, int sck, bf16_t* __restrict__ xn, const int wv) {
    const int tid = opaque_tid(wv); const int w = tid >> 6, lane = tid & 63;
    for (int row = blockIdx.x * 8 + w; row < MTOK; row += gridDim.x * 8) {
        const int b = row / SEQ; const float* xr = x + (size_t)row * DM; f32x4 v[4]; float ss = 0.f;
#pragma unroll
        for (int i = 0; i < 4; ++i) { v[i] = *(const f32x4*)(xr + lane * 4 + 256 * i); ss += v[i][0] * v[i][0] + v[i][1] * v[i][1] + v[i][2] * v[i][2] + v[i][3] * v[i][3]; }
#pragma unroll
        for (int o = 32; o >= 1; o >>= 1) ss += __shfl_xor(ss, o);
        const float rstd = rsqrtf(ss * (1.0f / DM) + EPS);
        const float* sh = modl + (size_t)b * 6144 + shk * 1024; const float* sc = modl + (size_t)b * 6144 + sck * 1024;
#pragma unroll
        for (int i = 0; i < 4; ++i) { const int c = lane * 4 + 256 * i; const f32x4 gg = *(const f32x4*)(g + c), s1 = *(const f32x4*)(sc + c), s0 = *(const f32x4*)(sh + c);
            f32x4 y;
#pragma unroll
            for (int j = 0; j < 4; ++j) y[j] = v[i][j] * rstd * gg[j] * (1.0f + s1[j]) + s0[j];
            u32x2 o; o.x = pk2(y[0], y[1]); o.y = pk2(y[2], y[3]); *(u32x2*)(xn + (size_t)row * DM + c) = o; }
    }
}
constexpr int KP = 272, VP = 136;
constexpr float DEAD = 1e-30f;
__device__ void attn_phase(ArgsP a, int l, LAS unsigned char* lds, const int wv) {
    const int tid = opaque_tid(wv), w = __builtin_amdgcn_readfirstlane(tid >> 6), lane = tid & 63, fr = lane & 15, fq = lane >> 4;
    LAS unsigned char* Ks = lds; LAS unsigned char* Vt = lds + 64 * KP; LAS int* flags = (LAS int*)(lds + 64 * KP + 128 * VP);
    const bf16_t* Qb = (const bf16_t*)(a->ws + WS_P); bf16_t* Yb = (bf16_t*)(a->ws + WS_P + 3 * PBUF); const bf16_t* Kb = (const bf16_t*)(a->ws + WS_P + PBUF); const bf16_t* Vb = (const bf16_t*)(a->ws + WS_P + 2 * PBUF);
    const float* gq = a->in[13] + l * 128; const float* gk = a->in[14] + l * 128;
    const int sp = tid & 15, skp = tid >> 4;
    float gks[8];
#pragma unroll
    for (int e = 0; e < 8; ++e) gks[e] = gk[sp * 8 + e];
    const int nunits = NB * 8 * (SEQ / 256);
    for (int unit = blockIdx.x; unit < nunits; unit += gridDim.x) {
        const int qt = (SEQ / 256 - 1) - unit / (NB * 8), bh = unit % (NB * 8), b = bh >> 3, hh = bh & 7;
        const size_t rowbase = (size_t)b * SEQ; const int t0 = qt * 256, r0 = t0 + 32 * w;
        int kb = qt * 4 + 3;
        u32x4 kr[2], vr[2];
#pragma unroll
        for (int i = 0; i < 2; ++i) { const size_t grow = rowbase + kb * 64 + 2 * skp + i; kr[i] = *(const u32x4*)(Kb + grow * DM + hh * 128 + sp * 8); vr[i] = *(const u32x4*)(Vb + grow * DM + hh * 128 + sp * 8); }
        bf16x8 qf[2][4];
#pragma unroll
        for (int rb = 0; rb < 2; ++rb) {
            const bf16_t* qp = Qb + (rowbase + r0 + 16 * rb + fr) * DM + hh * 128 + 8 * fq; u32x4 raw[4]; float ss = 0.f;
#pragma unroll
            for (int ks = 0; ks < 4; ++ks) { raw[ks] = *(const u32x4*)(qp + 32 * ks);
#pragma unroll
                for (int j = 0; j < 4; ++j) { const float x0 = bflo(raw[ks][j]), x1 = bfhi(raw[ks][j]); ss += x0 * x0 + x1 * x1; } }
            ss += __shfl_xor(ss, 16); ss += __shfl_xor(ss, 32);
            const float rs = rsqrtf(ss * (1.0f / 128.0f) + EPS) * (0.08838834764831845f * 1.4426950408889634f);
#pragma unroll
            for (int ks = 0; ks < 4; ++ks) { u32x4 o;
#pragma unroll
                for (int j = 0; j < 4; ++j) { const int d = 32 * ks + 8 * fq + 2 * j; o[j] = pk2(bflo(raw[ks][j]) * rs * gq[d], bfhi(raw[ks][j]) * rs * gq[d + 1]); }
                qf[rb][ks] = __builtin_bit_cast(bf16x8, o); }
        }
        f32x4 O[2][8];
#pragma unroll
        for (int rb = 0; rb < 2; ++rb)
#pragma unroll
            for (int db = 0; db < 8; ++db) O[rb][db] = (f32x4){0.f, 0.f, 0.f, 0.f};
        float carry[2] = {1.f, 1.f};
        bool alive = true;
        for (;;) {
#pragma unroll
            for (int i = 0; i < 2; ++i) { float x[8]; float ss = 0.f;
#pragma unroll
                for (int j = 0; j < 4; ++j) { x[2 * j] = bflo(kr[i][j]); x[2 * j + 1] = bfhi(kr[i][j]); ss += x[2 * j] * x[2 * j] + x[2 * j + 1] * x[2 * j + 1]; }
                ss += __shfl_xor(ss, 1); ss += __shfl_xor(ss, 2); ss += __shfl_xor(ss, 4); ss += __shfl_xor(ss, 8);
                const float rs = rsqrtf(ss * (1.0f / 128.0f) + EPS);
                u32x4 o;
#pragma unroll
                for (int j = 0; j < 4; ++j) o[j] = pk2(x[2 * j] * rs * gks[2 * j], x[2 * j + 1] * rs * gks[2 * j + 1]);
                *(LAS u32x4*)(Ks + (2 * skp + i) * KP + sp * 16) = o; }
            { const int wsz = skp ^ (sp & 14);
#pragma unroll
              for (int j = 0; j < 4; ++j) { *(LAS unsigned*)(Vt + (sp * 8 + 2 * j) * VP + wsz * 4) = (vr[0][j] & 0xffffu) | (vr[1][j] << 16); *(LAS unsigned*)(Vt + (sp * 8 + 2 * j + 1) * VP + wsz * 4) = (vr[0][j] >> 16) | (vr[1][j] & 0xffff0000u); } }
            __syncthreads();
            if (kb > 0) {
#pragma unroll
                for (int i = 0; i < 2; ++i) { const size_t grow = rowbase + (kb - 1) * 64 + 2 * skp + i; kr[i] = *(const u32x4*)(Kb + grow * DM + hh * 128 + sp * 8); vr[i] = *(const u32x4*)(Vb + grow * DM + hh * 128 + sp * 8); } }
            const bool active = alive && (kb * 64 < r0 + 31);
            if (active) {
                f32x4 S[2][4];
#pragma unroll
                for (int nb = 0; nb < 4; ++nb) {
                    bf16x8 kf[4];
#pragma unroll
                    for (int ks = 0; ks < 4; ++ks) kf[ks] = *(const LAS bf16x8*)(Ks + (16 * nb + fr) * KP + (32 * ks + 8 * fq) * 2);
#pragma unroll
                    for (int rb = 0; rb < 2; ++rb) { f32x4 sacc = (f32x4){0.f, 0.f, 0.f, 0.f};
#pragma unroll
                        for (int ks = 0; ks < 4; ++ks) sacc = __builtin_amdgcn_mfma_f32_16x16x32_bf16(kf[ks], qf[rb][ks], sacc, 0, 0, 0);
                        S[rb][nb] = sacc; }
                }
                const bool diag = (kb * 64 + 63 >= r0);
                unsigned pw[2][4][2];
#pragma unroll
                for (int rb = 0; rb < 2; ++rb) {
                    const int q = r0 + 16 * rb + fr; float bt[4][4], suf[4][4], T[4], ab[4];
#pragma unroll
                    for (int nb = 0; nb < 4; ++nb) { float run = 1.f;
#pragma unroll
                        for (int e = 3; e >= 0; --e) { const float z2 = __builtin_amdgcn_fmed3f(S[rb][nb][e], -115.f, 115.f);
                            const float E = __builtin_amdgcn_exp2f(-z2); float be = __builtin_amdgcn_rcpf(1.0f + E); float om = E * be;
                            if (diag) { const bool mk = (kb * 64 + 16 * nb + 4 * fq + e) < q; be = mk ? be : 0.f; om = mk ? om : 1.f; }
                            bt[nb][e] = be; suf[nb][e] = run; run *= om; }
                        const float g1 = __shfl_xor(run, 16), g2 = __shfl_xor(run, 32), g3 = __shfl_xor(g1, 32);
                        T[nb] = (run * g1) * (g2 * g3); ab[nb] = fq == 0 ? (g1 * g2 * g3) : fq == 1 ? (g2 * g3) : fq == 2 ? g1 : 1.f; }
                    float hi = carry[rb];
#pragma unroll
                    for (int nb = 3; nb >= 0; --nb) { const float base = hi * ab[nb];
                        pw[rb][nb][0] = pk2(bt[nb][0] * base * suf[nb][0], bt[nb][1] * base * suf[nb][1]); pw[rb][nb][1] = pk2(bt[nb][2] * base * suf[nb][2], bt[nb][3] * base * suf[nb][3]); hi *= T[nb]; }
                    carry[rb] = hi;
                }
#pragma unroll
                for (int ks2 = 0; ks2 < 2; ++ks2) {
                    bf16x8 pf[2];
#pragma unroll
                    for (int rb = 0; rb < 2; ++rb) { u32x4 t; t.x = pw[rb][2 * ks2][0]; t.y = pw[rb][2 * ks2][1]; t.z = pw[rb][2 * ks2 + 1][0]; t.w = pw[rb][2 * ks2 + 1][1]; pf[rb] = __builtin_bit_cast(bf16x8, t); }
#pragma unroll
                    for (int db = 0; db < 8; ++db) { const LAS unsigned char* vrow = Vt + (16 * db + fr) * VP;
                        const u32x2 va = *(const LAS u32x2*)(vrow + 4 * ((16 * ks2 + 2 * fq) ^ (2 * db))), vb = *(const LAS u32x2*)(vrow + 4 * ((16 * ks2 + 8 + 2 * fq) ^ (2 * db)));
                        u32x4 t; t.x = va.x; t.y = va.y; t.z = vb.x; t.w = vb.y; const bf16x8 vf = __builtin_bit_cast(bf16x8, t);
#pragma unroll
                        for (int rb = 0; rb < 2; ++rb) O[rb][db] = __builtin_amdgcn_mfma_f32_16x16x32_bf16(vf, pf[rb], O[rb][db], 0, 0, 0); }
                }
                alive = !__all((carry[0] < DEAD) && (carry[1] < DEAD));
            }
            if (lane == 0) flags[w] = alive ? 1 : 0;
            __syncthreads();
            int any = 0;
#pragma unroll
            for (int ww = 0; ww < 8; ++ww) any |= flags[ww];
            --kb;
            if (!any || kb < 0) break;
        }
#pragma unroll
        for (int rb = 0; rb < 2; ++rb) { bf16_t* op = Yb + (rowbase + r0 + 16 * rb + fr) * DM + hh * 128 + 4 * fq;
#pragma unroll
            for (int db = 0; db < 8; ++db) { u32x2 o; o.x = pk2(O[rb][db][0], O[rb][db][1]); o.y = pk2(O[rb][db][2], O[rb][db][3]); *(u32x2*)(op + 16 * db) = o; } }
    }
}
constexpr int XP = 272;
__device__ void rnn_phase(ArgsP a, int l, LAS unsigned char* lds, const int wv) {
    const int tid = opaque_tid(wv), w = __builtin_amdgcn_readfirstlane(tid >> 6), lane = tid & 63, fr = lane & 15, fq = lane >> 4;
    LAS unsigned char* XC = lds; LAS unsigned char* HT = lds + RT * XP; LAS unsigned char* PT = lds + 2 * RT * XP;
    const bf16_t* XR = (const bf16_t*)(a->ws + WS_P); const bf16_t* GY = (const bf16_t*)(a->ws + WS_P + PBUF); bf16_t* SGA = (bf16_t*)(a->ws + WS_P + 2 * PBUF);
    bf16_t* SGB = (bf16_t*)(a->ws + WS_P + 4 * PBUF); const bf16_t* YB = (const bf16_t*)(a->ws + WS_P + 3 * PBUF);
    float* SUM = (float*)(a->ws + WS_SUM);
    const bf16_t* gw = (const bf16_t*)(a->ws + WS_GW) + (size_t)l * 2 * 8 * 16384;
    const float* cw = a->in[6] + (size_t)l * 4 * DM; const float* cb = a->in[7] + (size_t)l * DM;
    const float* ba = a->in[9] + (size_t)l * DM; const float* bx = a->in[11] + (size_t)l * DM; const float* lam = a->in[12] + (size_t)l * DM;
    const int sp = tid & 15, tg = tid >> 4;
    const int nunits = NB * 8 * NT;
    for (int unit = blockIdx.x; unit < nunits; unit += gridDim.x) {
        const int hh = unit & 7, b = (unit >> 3) & 3, j = unit >> 5; const int t0 = j * RT; const size_t rowbase = (size_t)b * SEQ;
        const int cbase = hh * 128;
        { u32x4 r[7];
#pragma unroll
          for (int i = 0; i < 7; ++i) { const int ts = t0 + 4 * tg - 3 + i; r[i] = (u32x4){0, 0, 0, 0}; if (ts >= 0) r[i] = *(const u32x4*)(XR + (rowbase + ts) * DM + cbase + sp * 8); }
          float wvv[4][8], bv[8];
#pragma unroll
          for (int e = 0; e < 8; ++e) { bv[e] = cb[cbase + sp * 8 + e];
#pragma unroll
              for (int k = 0; k < 4; ++k) wvv[k][e] = cw[k * DM + cbase + sp * 8 + e]; }
#pragma unroll
          for (int i = 0; i < 4; ++i) { float acc[8];
#pragma unroll
              for (int e = 0; e < 8; ++e) acc[e] = bv[e];
#pragma unroll
              for (int k = 0; k < 4; ++k) {
#pragma unroll
                  for (int jj = 0; jj < 4; ++jj) { acc[2 * jj] += wvv[k][2 * jj] * bflo(r[i + k][jj]); acc[2 * jj + 1] += wvv[k][2 * jj + 1] * bfhi(r[i + k][jj]); } }
              u32x4 o; o.x = pk2(acc[0], acc[1]); o.y = pk2(acc[2], acc[3]); o.z = pk2(acc[4], acc[5]); o.w = pk2(acc[6], acc[7]);
              *(LAS u32x4*)(XC + (4 * tg + i) * XP + sp * 16) = o; } }
        bf16x8 wa[4], wx[4];
        { const bf16_t* pa = gw + ((size_t)(0 * 8 + hh) * 128 + 16 * w + fr) * 128 + 8 * fq; const bf16_t* px = gw + ((size_t)(1 * 8 + hh) * 128 + 16 * w + fr) * 128 + 8 * fq;
#pragma unroll
          for (int ks = 0; ks < 4; ++ks) { wa[ks] = *(const bf16x8*)(pa + 32 * ks); wx[ks] = *(const bf16x8*)(px + 32 * ks); } }
        const int c = cbase + 16 * w + fr;
        const float bac = ba[c], bxc = bx[c]; const float lm = lam[c];
        const float sp8l = 8.0f * 1.4426950408889634f * (fmaxf(-lm, 0.f) + __logf(1.0f + __expf(-fabsf(lm))));
        __syncthreads();
        f32x4 A[8], U[8];
#pragma unroll
        for (int mb = 0; mb < 8; ++mb) { f32x4 ra = (f32x4){0.f, 0.f, 0.f, 0.f}, rx = ra;
#pragma unroll
            for (int ks = 0; ks < 4; ++ks) { const bf16x8 xf = *(const LAS bf16x8*)(XC + (16 * mb + fr) * XP + (32 * ks + 8 * fq) * 2);
                ra = __builtin_amdgcn_mfma_f32_16x16x32_bf16(xf, wa[ks], ra, 0, 0, 0); rx = __builtin_amdgcn_mfma_f32_16x16x32_bf16(xf, wx[ks], rx, 0, 0, 0); }
#pragma unroll
            for (int e = 0; e < 4; ++e) { const float r = __builtin_amdgcn_rcpf(1.0f + __builtin_amdgcn_exp2f(-1.4426950408889634f * (ra[e] + bac)));
                const float ig = __builtin_amdgcn_rcpf(1.0f + __builtin_amdgcn_exp2f(-1.4426950408889634f * (rx[e] + bxc)));
                const float la2 = -sp8l * r; const float av = __builtin_amdgcn_exp2f(la2);
                const float x2 = 1.3862943611198906f * la2;
                const float om = x2 > -0.02f ? -x2 * (1.0f + x2 * (0.5f + x2 * (1.0f / 6.0f))) : 1.0f - av * av;
                const float xc = bf2f(*(const LAS bf16_t*)(XC + (16 * mb + 4 * fq + e) * XP + (16 * w + fr) * 2));
                ra[e] = av; rx[e] = __builtin_amdgcn_sqrtf(om) * ig * xc; }
            A[mb] = ra; U[mb] = rx; }
        u32x4 mg[4], ms1[4], ms2[4], myb[4];
#pragma unroll
        for (int i = 0; i < 4; ++i) { const size_t go = (rowbase + t0 + 4 * tg + i) * DM + cbase + sp * 8; mg[i] = *(const u32x4*)(GY + go); ms1[i] = *(const u32x4*)(SGA + go); ms2[i] = *(const u32x4*)(SGB + go); myb[i] = *(const u32x4*)(YB + go); }
        float H = 0.f, Pp = 1.0f;
#pragma unroll
        for (int mb = 0; mb < 8; ++mb) {
            float Ag = A[mb][0] * A[mb][1] * A[mb][2] * A[mb][3];
            float Ug = ((U[mb][0] * A[mb][1] + U[mb][1]) * A[mb][2] + U[mb][2]) * A[mb][3] + U[mb][3];
            { const float a1 = __shfl_up(Ag, 16), u1 = __shfl_up(Ug, 16); if (fq >= 1) { Ug = Ag * u1 + Ug; Ag = Ag * a1; } }
            { const float a2 = __shfl_up(Ag, 32), u2 = __shfl_up(Ug, 32); if (fq >= 2) { Ug = Ag * u2 + Ug; Ag = Ag * a2; } }
            const float ap = __shfl_up(Ag, 16), up = __shfl_up(Ug, 16);
            float h = fq == 0 ? H : ap * H + up, p = fq == 0 ? Pp : ap * Pp;
#pragma unroll
            for (int e = 0; e < 4; ++e) { h = A[mb][e] * h + U[mb][e]; p *= A[mb][e]; const unsigned hp2 = pk2(h, p); const int off = (16 * mb + 4 * fq + e) * XP + (16 * w + fr) * 2;
                *(LAS bf16_t*)(HT + off) = (bf16_t)(hp2 & 0xffff); *(LAS bf16_t*)(PT + off) = (bf16_t)(hp2 >> 16); }
            const float Am = __shfl(Ag, 48 + fr), Um = __shfl(Ug, 48 + fr);
            H = Am * H + Um; Pp *= Am;
        }
        if (fq == 0) { float* sm = SUM + (((size_t)b * NT + j) * DM + c) * 2; sm[0] = Pp; sm[1] = H; }
        __syncthreads();
#pragma unroll
        for (int i = 0; i < 4; ++i) { const int tl = 4 * tg + i; const size_t go = (rowbase + t0 + tl) * DM + cbase + sp * 8;
            const u32x4 hv = *(const LAS u32x4*)(HT + tl * XP + sp * 16), pv = *(const LAS u32x4*)(PT + tl * XP + sp * 16);
            u32x4 o0, o1;
#pragma unroll
            for (int jj = 0; jj < 4; ++jj) { const float ga = bflo(ms1[i][jj]) * bflo(mg[i][jj]), gb = bfhi(ms1[i][jj]) * bfhi(mg[i][jj]);
                o0[jj] = pk2(ga * bflo(hv[jj]) + bflo(ms2[i][jj]) * bflo(myb[i][jj]), gb * bfhi(hv[jj]) + bfhi(ms2[i][jj]) * bfhi(myb[i][jj]));
                o1[jj] = pk2(ga * bflo(pv[jj]), gb * bfhi(pv[jj])); }
            *(u32x4*)(SGB + go) = o0; *(u32x4*)(SGA + go) = o1; }
    }
}
__device__ void carry_phase(ArgsP a, const int wv) {
    const float* SUM = (const float*)(a->ws + WS_SUM); float* HIN = (float*)(a->ws + WS_HIN);
    const int gt = blockIdx.x * NTH + opaque_tid(wv); if (gt >= NB * DM) return;
    const int b = gt / DM, c = gt % DM; float H = 0.f;
#pragma unroll 8
    for (int j = 0; j < NT; ++j) { const size_t o = ((size_t)b * NT + j) * DM + c; HIN[o] = H; const float p = SUM[o * 2], h = SUM[o * 2 + 1]; H = p * H + h; }
}
__device__ void mix_phase(ArgsP a, const int wv) {
    const bf16_t* M0 = (const bf16_t*)(a->ws + WS_P + 4 * PBUF); const bf16_t* M1 = (const bf16_t*)(a->ws + WS_P + 2 * PBUF); bf16_t* MIX = (bf16_t*)(a->ws + WS_XN); const float* HIN = (const float*)(a->ws + WS_HIN);
    for (int it = blockIdx.x * NTH + opaque_tid(wv); it < (MTOK / 32) * (DM / 8); it += gridDim.x * NTH) {
        const int pc = it & 127, rg = it >> 7; const int row0 = rg * 32, b = row0 / SEQ, j = (row0 % SEQ) / RT;
        const float* hp = HIN + ((size_t)b * NT + j) * DM + pc * 8; const f32x4 h0 = *(const f32x4*)hp, h1 = *(const f32x4*)(hp + 4);
#pragma unroll 8
        for (int r = 0; r < 32; ++r) { const size_t go = (size_t)(row0 + r) * DM + pc * 8; const u32x4 m0 = *(const u32x4*)(M0 + go), m1 = *(const u32x4*)(M1 + go); u32x4 o;
            o.x = pk2(bflo(m0.x) + bflo(m1.x) * h0[0], bfhi(m0.x) + bfhi(m1.x) * h0[1]); o.y = pk2(bflo(m0.y) + bflo(m1.y) * h0[2], bfhi(m0.y) + bfhi(m1.y) * h0[3]);
            o.z = pk2(bflo(m0.z) + bflo(m1.z) * h1[0], bfhi(m0.z) + bfhi(m1.z) * h1[1]); o.w = pk2(bflo(m0.w) + bflo(m1.w) * h1[2], bfhi(m0.w) + bfhi(m1.w) * h1[3]);
            *(u32x4*)(MIX + go) = o; }
    }
}
__device__ void ffn_fixup(ArgsP a, int l, const int wv) {
    bf16_t* ACT = (bf16_t*)(a->ws + WS_P); const bf16_t* HALO = (const bf16_t*)(a->ws + WS_P + ACT_BYTES);
    const float* cw = a->in[18] + (size_t)l * 3 * DFF2; const float* cb = a->in[19] + (size_t)l * DFF2;
    const int nitems = (MTOK / 128) * (DFF / 8);
    for (int it = blockIdx.x * NTH + opaque_tid(wv); it < nitems; it += gridDim.x * NTH) {
        const int cgp = it % (DFF / 8), wb = it / (DFF / 8); const int c0 = cgp * 8, t0 = wb * 128; const bool first = (t0 & (SEQ - 1)) == 0;
        const bf16_t* hc = HALO + (size_t)wb * 4 * DFF2; const bf16_t* hpv = hc - 4 * DFF2;
        u32x4 z = (u32x4){0, 0, 0, 0}; u32x4 gm2 = z, gm1 = z, vm2 = z, vm1 = z;
        if (!first) { gm2 = *(const u32x4*)(hpv + 2 * DFF2 + c0); gm1 = *(const u32x4*)(hpv + 3 * DFF2 + c0); vm2 = *(const u32x4*)(hpv + 2 * DFF2 + DFF + c0); vm1 = *(const u32x4*)(hpv + 3 * DFF2 + DFF + c0); }
        const u32x4 g0 = *(const u32x4*)(hc + c0), g1 = *(const u32x4*)(hc + DFF2 + c0), v0 = *(const u32x4*)(hc + DFF + c0), v1 = *(const u32x4*)(hc + DFF2 + DFF + c0);
        u32x4 o0, o1;
#pragma unroll
        for (int jj = 0; jj < 4; ++jj) {
            float r0[2], r1[2];
#pragma unroll
            for (int hl = 0; hl < 2; ++hl) { const int c = c0 + 2 * jj + hl;
                const float wg0 = cw[c], wg1 = cw[DFF2 + c], wg2 = cw[2 * DFF2 + c], wv0 = cw[DFF + c], wv1 = cw[DFF2 + DFF + c], wv2 = cw[2 * DFF2 + DFF + c], bg = cb[c], bv = cb[DFF + c];
                const float G2 = hl ? bfhi(gm2[jj]) : bflo(gm2[jj]), G1 = hl ? bfhi(gm1[jj]) : bflo(gm1[jj]), Ga = hl ? bfhi(g0[jj]) : bflo(g0[jj]), Gb = hl ? bfhi(g1[jj]) : bflo(g1[jj]);
                const float V2 = hl ? bfhi(vm2[jj]) : bflo(vm2[jj]), V1 = hl ? bfhi(vm1[jj]) : bflo(vm1[jj]), Va = hl ? bfhi(v0[jj]) : bflo(v0[jj]), Vb = hl ? bfhi(v1[jj]) : bflo(v1[jj]);
                r0[hl] = gelu_tanh(bg + wg0 * G2 + wg1 * G1 + wg2 * Ga) * (bv + wv0 * V2 + wv1 * V1 + wv2 * Va);
                r1[hl] = gelu_tanh(bg + wg0 * G1 + wg1 * Ga + wg2 * Gb) * (bv + wv0 * V1 + wv1 * Va + wv2 * Vb); }
            o0[jj] = pk2(r0[0], r0[1]); o1[jj] = pk2(r1[0], r1[1]); }
        *(u32x4*)(ACT + (size_t)t0 * DFF + c0) = o0; *(u32x4*)(ACT + (size_t)(t0 + 1) * DFF + c0) = o1;
    }
}
constexpr int LDS_BYTES = 136 * 1024;
__global__ void __launch_bounds__(NTH, 2) mk_fwd(Args a_unused) {
    ArgsP a = (ArgsP)__builtin_amdgcn_kernarg_segment_ptr(); asm volatile("" : "+s"(a));
    const int wv = __builtin_amdgcn_readfirstlane(threadIdx.x >> 6);
    extern __shared__ __attribute__((aligned(16))) unsigned char lds_raw[];
    LAS unsigned char* lds = (LAS unsigned char*)lds_raw;
    cg::grid_group grid = cg::this_grid();
    volatile LAS unsigned* xbst = (volatile LAS unsigned*)(lds + LDS_BYTES - 16);
    if (threadIdx.x < 4) xbst[threadIdx.x] = 0u;
    __syncthreads();
    const XcdBarrier xbar = xcd_barrier_post((unsigned*)(a->ws + WS_BAR), xbst);
    const int G = gridDim.x, bid = blockIdx.x;
    float* mod = (float*)(a->ws + WS_MOD);
    bf16_t* XN = (bf16_t*)(a->ws + WS_XN); bf16_t* P = (bf16_t*)(a->ws + WS_P);
#ifndef REPMASK
#define REPMASK 0
#endif
#ifndef XSYNC
#define XSYNC 0
#endif
#define RUN(k, ...) for (int _r = 0; _r < (((REPMASK >> (k)) & 1) ? 2 : 1); ++_r) { __VA_ARGS__ xcd_barrier(xbar, wv); }
    for (int _r = 0; _r < ((REPMASK & 1) ? 2 : 1); ++_r) { p0_mod(a, lds, wv); p0_weights(a, lds, wv); grid.sync(); }
    for (int _x = 0; _x < XSYNC; ++_x) xcd_barrier(xbar, wv);
    for (int l = 0; l < NL; ++l) {
        const float* modl = mod + (size_t)l * NB * 6144;
        const bf16_t* wl = (const bf16_t*)(a->ws + WS_W) + (size_t)l * W_LAYER_E;
        const float* xin = l == 0 ? a->in[0] : a->out;
        RUN(1, norm_phase(xin, a->in[4] + l * DM, modl, 0, 1, XN, wv);)
        RUN(2, { pg8::Gemm g{XN, wl + (size_t)4096 * DM, MTOK, 3072, DM}; pg8::StaticOrder S; S.init(MTOK, 3072, G, bid);
          EpiSplit E{P, (size_t)MTOK * DM, 0x0000, 0}; pg8::gemm_phase<EpiSplit, pg8::StaticOrder, true, true>(lds, g, S, E, wv); })
        RUN(3, attn_phase(a, l, lds, wv);)
        RUN(4, { pg8::Gemm g{XN, wl, MTOK, 4096, DM}; pg8::StaticOrder S; S.init(MTOK, 4096, G, bid);
          EpiSplit E{P, (size_t)MTOK * DM, 0x2210, 1}; pg8::gemm_phase<EpiSplit, pg8::StaticOrder, true, true>(lds, g, S, E, wv); })
        RUN(5, rnn_phase(a, l, lds, wv);)
        RUN(6, carry_phase(a, wv);)
        RUN(7, mix_phase(a, wv);)
        RUN(13, { pg8::Gemm g{XN, wl + W_IN_E, MTOK, DM, DM}; pg8::StaticOrder S; S.init(MTOK, DM, G, bid);
          EpiRes E{xin, a->out, modl + 2 * 1024, 0}; pg8::gemm_phase<EpiRes, pg8::StaticOrder, true, true>(lds, g, S, E, wv); })
        RUN(9, norm_phase(a->out, a->in[16] + l * DM, modl, 3, 4, XN, wv);)
        RUN(10, { pg8::Gemm g{XN, wl + W_IN_E + W_OUT_E, MTOK, DFF2, DM}; pg8::StaticOrder S; S.init(MTOK, DFF2, G, bid);
          EpiConvAct E{P, (bf16_t*)(a->ws + WS_P + ACT_BYTES), a->in[18] + (size_t)l * 3 * DFF2, a->in[19] + (size_t)l * DFF2};
          pg8::gemm_phase<EpiConvAct, pg8::StaticOrder, true, true, true>(lds, g, S, E, wv); })
        RUN(11, ffn_fixup(a, l, wv);)
        RUN(13, { pg8::Gemm g{P, wl + W_IN_E + W_OUT_E + W_UP_E, MTOK, DM, DFF}; pg8::StaticOrder S; S.init(MTOK, DM, G, bid);
          EpiRes E{a->out, a->out, modl + 5 * 1024, 0}; pg8::gemm_phase<EpiRes, pg8::StaticOrder, true, true>(lds, g, S, E, wv); })
    }
}
extern "C" void kernel_launch(void* const* d_in, const int* in_sizes, int n_in, void* d_out, int out_size, void* d_ws, size_t ws_size, hipStream_t stream) {
    static int grid = 0;
    if (!grid) {
        int dev = 0, cus = 0, per_cu = 0;
        (void)hipGetDevice(&dev);
        (void)hipDeviceGetAttribute(&cus, hipDeviceAttributeMultiprocessorCount, dev);
        (void)hipFuncSetAttribute((const void*)mk_fwd, hipFuncAttributeMaxDynamicSharedMemorySize, LDS_BYTES);
        (void)hipOccupancyMaxActiveBlocksPerMultiprocessor(&per_cu, (const void*)mk_fwd, NTH, LDS_BYTES);
        if (per_cu < 1) per_cu = 1;
        grid = cus * per_cu;
        if (ws_size < WS_END) { fprintf(stderr, "kernel_launch: workspace too small: %zu < %zu\n", ws_size, (size_t)WS_END); grid = -1; }
        if (n_in != 21 || out_size != MTOK * DM) { fprintf(stderr, "kernel_launch: unexpected shapes\n"); grid = -1; }
    }
    if (grid < 0) return;
    (void)hipMemsetAsync((char*)d_ws + WS_BAR, 0, XCD_BAR_WORDS * 4, stream);
    Args a{};
    for (int i = 0; i < 21; ++i) a.in[i] = (const float*)d_in[i];
    a.out = (float*)d_out; a.ws = (unsigned char*)d_ws;
    void* args[] = {&a};
    hipError_t e = hipLaunchCooperativeKernel((const void*)mk_fwd, dim3(grid), dim3(NTH), args, LDS_BYTES, stream);
    if (e != hipSuccess) fprintf(stderr, "cooperative launch failed: %s (grid %d)\n", hipGetErrorString(e), grid);
}
```

```cpp
#include <hip/hip_runtime.h>
#include <hip/hip_cooperative_groups.h>
#include <cstdio>
#include <cstdint>
namespace cg = cooperative_groups;
__device__ __forceinline__ int opaque_tid(int wv) { int t; asm volatile("v_mbcnt_lo_u32_b32 %0, -1, 0\n\tv_mbcnt_hi_u32_b32 %0, -1, %0" : "=v"(t)); return t | (wv << 6); }
__device__ __forceinline__ int opaque_bid() { int t = blockIdx.x; asm volatile("" : "+s"(t)); return t; }
namespace pg8 {
#define PG8_LAS __attribute__((address_space(3)))
typedef unsigned short bf16_t;
typedef short bf16x8 __attribute__((ext_vector_type(8)));
typedef float f32x4 __attribute__((ext_vector_type(4)));
typedef unsigned u32x4 __attribute__((ext_vector_type(4)));
constexpr int BM = 256, BK = 64, HALF = 128, HTB = HALF * BK * 2  , STAGE_BYTES = 8 * HTB, NXCD = 8, WGM = 8;

__host__ __device__ __forceinline__ int lds_byte(int r, int c) { const int st = (r >> 4) * 2 + (c >> 5), rr = r & 15, cc = c & 31, ob = rr * 64 + cc * 2; return st * 1024 + (ob ^ (((ob >> 9) & 1) << 5)); }
__host__ __device__ __forceinline__ void stage_rc(int b, int& R, int& C) { const int st = b / 1024, sb = b % 1024, swz = sb ^ (((sb >> 9) & 1) << 5); R = (st >> 1) * 16 + swz / 64; C = (st & 1) * 32 + (swz % 64) / 2; }
__host__ __device__ __forceinline__ int perm32(int rho) { const int n = rho >> 4, i = rho & 15; return 8 * (i >> 2) + 4 * n + (i & 3); }

struct Unit { int pm, pn; };
struct Gemm { const bf16_t* A; const bf16_t* Bt; int M, N, K; };

struct StaticOrder {
    int nM, nN, nwg, G, c;
    __host__ __device__ void init(int M, int N, int G_, int c_) { nM = M / BM; nN = N / BM; nwg = nM * nN; G = G_; c = c_; }
    __host__ __device__ bool next(int i, Unit& u) const {
        const long L = (long)i * G + c; if (L >= nwg) return false;
        int wgid = (int)L; { const int q = nwg / NXCD, r = nwg % NXCD, xcd = wgid % NXCD, off = wgid / NXCD; wgid = (xcd < r ? xcd * (q + 1) : r * (q + 1) + (xcd - r) * q) + off; }
        const int nig = WGM * nN, gid = wgid / nig, fm = gid * WGM, gsz = (nM - fm) < WGM ? (nM - fm) : WGM;
        u.pm = fm + ((wgid % nig) % gsz); u.pn = (wgid % nig) / gsz; return true;
    }
    __device__ __forceinline__ void a_ready(const Unit&) const {}
    __device__ __forceinline__ void done(const Unit&) const {}
};

template <class Epi, class Sched, bool ALIGN_EPI = false, bool SP2 = false, bool ROWPERM = false>
__device__ __forceinline__ void gemm_phase(PG8_LAS unsigned char* lds, const Gemm g, const Sched& S, const Epi& E, const int wv) {
    const int tid = opaque_tid(wv), wid = __builtin_amdgcn_readfirstlane(tid >> 6), lane = tid & 63, wr = wid >> 2, wc = wid & 3, fr = lane & 15, fq = lane >> 4;
    const int K = g.K, nt = K / BK;
    unsigned voffA[2], voffB[2];
#pragma unroll
    for (int i = 0; i < 2; ++i) { int R, C; stage_rc(tid * 16 + i * 8192, R, C); const int Rb = Epi::PERM ? ((R & ~31) + perm32(R & 31)) : R;
        const int Ra = ROWPERM ? (128 * (R >> 6) + 8 * (R & 15) + ((R >> 4) & 3)) : R;
        voffA[i] = (unsigned)(Ra * K + C) * 2u; voffB[i] = (unsigned)(Rb * K + C) * 2u; }
    const size_t kstep = (size_t)(BK * 2);
    const size_t hstep = (size_t)HALF * K * 2;
    const size_t tstep = 2 * hstep; const size_t hstepA = ROWPERM ? (size_t)4 * K * 2 : hstep;
    const unsigned ldsw = (unsigned)wid * 1024u;
    const int aoff = lds_byte(wr * 64 + fr, fq * 8), boff = lds_byte(wc * 32 + fr, fq * 8);
#define PG8_SA(b, h) (((b) * 2 + (h)) * HTB)
#define PG8_SB(b, h) ((4 + (b) * 2 + (h)) * HTB)
#define PG8_STAGE(bufoff, gbase, voff) do { _Pragma("unroll") for (int _i = 0; _i < 2; ++_i) \
        __builtin_amdgcn_global_load_lds((const unsigned*)((const char*)(gbase) + (voff)[_i]), (PG8_LAS unsigned*)(lds + (bufoff) + ldsw + _i * 8192), 16, 0, 0); } while (0)
#define PG8_LDA(dst, b, h) do { _Pragma("unroll") for (int m = 0; m < 4; ++m) _Pragma("unroll") for (int k = 0; k < 2; ++k) dst[m][k] = *(const PG8_LAS bf16x8*)(lds + PG8_SA(b, h) + aoff + m * 2048 + k * 1024); } while (0)
#define PG8_LDB(dst, b, h) do { _Pragma("unroll") for (int n = 0; n < 2; ++n) _Pragma("unroll") for (int k = 0; k < 2; ++k) dst[n][k] = *(const PG8_LAS bf16x8*)(lds + PG8_SB(b, h) + boff + n * 2048 + k * 1024); } while (0)
#define PG8_MMA(ai, bj, At, Bt) do { __builtin_amdgcn_s_setprio(1); _Pragma("unroll") for (int m = 0; m < 4; ++m) _Pragma("unroll") for (int n = 0; n < 2; ++n) _Pragma("unroll") for (int k = 0; k < 2; ++k) \
        acc[ai][bj][m][n] = __builtin_amdgcn_mfma_f32_16x16x32_bf16(Bt[n][k], At[m][k], acc[ai][bj][m][n], 0, 0, 0); __builtin_amdgcn_s_setprio(0); } while (0)
#define PG8_WAIT_V(n) asm volatile("s_waitcnt vmcnt(" #n ")" ::: "memory")
#define PG8_WAIT_L(n) asm volatile("s_waitcnt lgkmcnt(" #n ")" ::: "memory")
#define PG8_BAR __builtin_amdgcn_s_barrier()
#define PG8_SCHED __builtin_amdgcn_sched_barrier(0)
    Unit cur, nxt; int ui = 0;
    if (!S.next(0, cur)) return;
    f32x4 acc[2][2][4][2];
#pragma unroll
    for (int a = 0; a < 2; ++a)
#pragma unroll
        for (int b = 0; b < 2; ++b)
#pragma unroll
            for (int m = 0; m < 4; ++m)
#pragma unroll
                for (int n = 0; n < 2; ++n) acc[a][b][m][n] = (f32x4){0.f, 0.f, 0.f, 0.f};
    bf16x8 At[4][2], B0[2][2], B1[2][2];
    const char* cA = (const char*)g.A + (size_t)cur.pm * tstep; const char* cB = (const char*)g.Bt + (size_t)cur.pn * tstep;
    S.a_ready(cur);
    if constexpr (SP2) {
        PG8_STAGE(PG8_SB(0, 0), cB, voffB); PG8_STAGE(PG8_SB(0, 1), cB + hstep, voffB); PG8_STAGE(PG8_SA(0, 0), cA, voffA); PG8_STAGE(PG8_SA(0, 1), cA + hstepA, voffA);
        if (wr == 1) PG8_BAR;
        PG8_WAIT_V(2); PG8_BAR;
        PG8_STAGE(PG8_SB(1, 0), cB + kstep, voffB); PG8_STAGE(PG8_SA(1, 0), cA + kstep, voffA); PG8_STAGE(PG8_SB(1, 1), cB + hstep + kstep, voffB);
        PG8_WAIT_V(6); PG8_BAR;
    } else {
        PG8_STAGE(PG8_SB(0, 0), cB, voffB); PG8_STAGE(PG8_SA(0, 0), cA, voffA); PG8_STAGE(PG8_SB(0, 1), cB + hstep, voffB); PG8_STAGE(PG8_SA(0, 1), cA + hstepA, voffA);
        if (wr == 1) PG8_BAR;
        PG8_WAIT_V(4); PG8_BAR;
        PG8_STAGE(PG8_SB(1, 0), cB + kstep, voffB); PG8_STAGE(PG8_SA(1, 0), cA + kstep, voffA); PG8_STAGE(PG8_SB(1, 1), cB + hstep + kstep, voffB);
        PG8_WAIT_V(6); PG8_BAR;
    }
    for (;;) {
        const bool has_next = S.next(ui + 1, nxt);
        const char* nA = has_next ? (const char*)g.A + (size_t)nxt.pm * tstep : cA; const char* nB = has_next ? (const char*)g.Bt + (size_t)nxt.pn * tstep : cB;
        for (int t = 0; t < nt; t += 2) {
            const bool last = (t == nt - 2);
            const char* a1 = cA + (size_t)(t + 1) * kstep;
            const char* a2 = last ? nA : cA + (size_t)(t + 2) * kstep; const char* b2 = last ? nB : cB + (size_t)(t + 2) * kstep;
            const char* a3 = a2 + kstep; const char* b3 = b2 + kstep;
            if (last && has_next) S.a_ready(nxt);
            if constexpr (SP2) {
            PG8_LDB(B0, 0, 0); PG8_LDB(B1, 0, 1); PG8_SCHED; PG8_LDA(At, 0, 0); PG8_STAGE(PG8_SA(1, 1), a1 + hstepA, voffA);
            PG8_WAIT_V(8); PG8_WAIT_L(0); PG8_BAR; PG8_MMA(0, 0, At, B0); PG8_MMA(0, 1, At, B1); PG8_BAR; PG8_SCHED;
            PG8_LDA(At, 0, 1); PG8_STAGE(PG8_SB(0, 0), b2, voffB); PG8_STAGE(PG8_SB(0, 1), b2 + hstep, voffB); PG8_STAGE(PG8_SA(0, 0), a2, voffA);
            PG8_WAIT_V(8); PG8_WAIT_L(0); PG8_BAR; PG8_MMA(1, 0, At, B0); PG8_MMA(1, 1, At, B1); PG8_BAR; PG8_SCHED;
            PG8_LDB(B0, 1, 0); PG8_LDB(B1, 1, 1); PG8_SCHED; PG8_LDA(At, 1, 0); PG8_STAGE(PG8_SA(0, 1), a2 + hstepA, voffA);
            PG8_WAIT_V(8); PG8_WAIT_L(0); PG8_BAR; PG8_MMA(0, 0, At, B0); PG8_MMA(0, 1, At, B1); PG8_BAR; PG8_SCHED;
            PG8_LDA(At, 1, 1); PG8_STAGE(PG8_SB(1, 0), b3, voffB); PG8_STAGE(PG8_SB(1, 1), b3 + hstep, voffB); PG8_STAGE(PG8_SA(1, 0), a3, voffA);
            PG8_WAIT_V(8); PG8_WAIT_L(0); PG8_BAR; PG8_MMA(1, 0, At, B0); PG8_MMA(1, 1, At, B1); PG8_BAR; PG8_SCHED;
            } else {
            PG8_LDB(B0, 0, 0); PG8_SCHED; PG8_LDA(At, 0, 0); PG8_STAGE(PG8_SA(1, 1), a1 + hstepA, voffA);
            PG8_WAIT_L(8); PG8_BAR; PG8_WAIT_L(0); PG8_MMA(0, 0, At, B0); PG8_BAR; PG8_SCHED;
            PG8_LDB(B1, 0, 1); PG8_STAGE(PG8_SB(0, 0), b2, voffB);
            PG8_BAR; PG8_WAIT_L(0); PG8_MMA(0, 1, At, B1); PG8_BAR;
            PG8_LDA(At, 0, 1); PG8_STAGE(PG8_SA(0, 0), a2, voffA);
            PG8_BAR; PG8_WAIT_L(0); PG8_MMA(1, 0, At, B0); PG8_BAR; PG8_SCHED;
            PG8_STAGE(PG8_SB(0, 1), b2 + hstep, voffB);
            PG8_WAIT_V(6); PG8_BAR; PG8_MMA(1, 1, At, B1); PG8_BAR;
            PG8_LDB(B0, 1, 0); PG8_SCHED; PG8_LDA(At, 1, 0); PG8_STAGE(PG8_SA(0, 1), a2 + hstepA, voffA);
            PG8_WAIT_L(8); PG8_BAR; PG8_WAIT_L(0); PG8_MMA(0, 0, At, B0); PG8_BAR; PG8_SCHED;
            PG8_LDB(B1, 1, 1); PG8_STAGE(PG8_SB(1, 0), b3, voffB);
            PG8_BAR; PG8_WAIT_L(0); PG8_MMA(0, 1, At, B1); PG8_BAR;
            PG8_LDA(At, 1, 1); PG8_STAGE(PG8_SA(1, 0), a3, voffA);
            PG8_BAR; PG8_WAIT_L(0); PG8_MMA(1, 0, At, B0); PG8_BAR; PG8_SCHED;
            PG8_STAGE(PG8_SB(1, 1), b3 + hstep, voffB);
            PG8_WAIT_V(6); PG8_BAR; PG8_MMA(1, 1, At, B1); PG8_BAR;
            }
        }
        if constexpr (ALIGN_EPI) { if (wr == 0) PG8_BAR; }
        if constexpr (!Epi::AFTER_DRAIN) { E(acc, cur, wr, wc, fr, fq); S.done(cur); }
        if (!has_next) break;
#pragma unroll
        for (int a = 0; a < 2; ++a)
#pragma unroll
            for (int b = 0; b < 2; ++b)
#pragma unroll
                for (int m = 0; m < 4; ++m)
#pragma unroll
                    for (int n = 0; n < 2; ++n) acc[a][b][m][n] = (f32x4){0.f, 0.f, 0.f, 0.f};
        cur = nxt; cA = nA; cB = nB; ++ui;
        if constexpr (ALIGN_EPI) { if (wr == 1) PG8_BAR; }
    }
    PG8_WAIT_V(0);
    if constexpr (!ALIGN_EPI) { if (wr == 0) PG8_BAR; }
    PG8_BAR;
    if constexpr (Epi::AFTER_DRAIN) { E.fused(acc, cur, wr, wc, fr, fq, lds, wid, lane); S.done(cur); }
#undef PG8_SA
#undef PG8_SB
#undef PG8_STAGE
#undef PG8_LDA
#undef PG8_LDB
#undef PG8_MMA
#undef PG8_WAIT_V
#undef PG8_WAIT_L
#undef PG8_BAR
#undef PG8_SCHED
}
}
typedef pg8::bf16_t bf16_t;
typedef pg8::bf16x8 bf16x8;
typedef pg8::f32x4 f32x4;
typedef pg8::u32x4 u32x4;
typedef unsigned u32x2 __attribute__((ext_vector_type(2)));
#define LAS __attribute__((address_space(3)))

constexpr int DM = 1024, NB = 4, SEQ = 8192, MTOK = NB * SEQ, DIN = 7168, DFF = 3072, DFF2 = 6144, NL = 2;
constexpr int NTH = 512;
constexpr float EPS = 1e-6f;
constexpr int RT = 128, NT = SEQ / RT;
constexpr size_t WS_BAR = 0;
constexpr size_t WS_MOD = 16384;
constexpr size_t WS_GW = WS_MOD + (size_t)NL * NB * 6144 * 4;
constexpr size_t WS_SUM = WS_GW + (size_t)NL * 2 * 8 * 128 * 128 * 2;
constexpr size_t WS_HIN = WS_SUM + (size_t)NB * NT * 1024 * 2 * 4;
constexpr size_t WS_W = (WS_HIN + (size_t)NB * NT * 1024 * 4 + 4095) / 4096 * 4096;
constexpr size_t W_IN_E = (size_t)DIN * DM, W_OUT_E = (size_t)DM * DM, W_UP_E = (size_t)DFF2 * DM, W_DN_E = (size_t)DM * DFF, W_LAYER_E = W_IN_E + W_OUT_E + W_UP_E + W_DN_E;
constexpr size_t WS_XN = WS_W + NL * W_LAYER_E * 2;
constexpr size_t PBUF = (size_t)MTOK * DM * 2;
constexpr size_t WS_P = WS_XN + PBUF;
constexpr size_t WS_END = WS_P + 5 * PBUF;
constexpr size_t ACT_BYTES = (size_t)MTOK * DFF * 2;

__device__ __forceinline__ float bf2f(bf16_t b) { return __uint_as_float(((unsigned)b) << 16); }
__device__ __forceinline__ unsigned pk2(float lo, float hi) { unsigned r; asm volatile("v_cvt_pk_bf16_f32 %0, %1, %2" : "=v"(r) : "v"(lo), "v"(hi)); return r; }
__device__ __forceinline__ float bflo(unsigned w) { return __uint_as_float(w << 16); }
__device__ __forceinline__ float bfhi(unsigned w) { return __uint_as_float(w & 0xffff0000u); }
__device__ __forceinline__ float lane_get(float x, int srclane) { return __builtin_bit_cast(float, __builtin_amdgcn_ds_bpermute(srclane << 2, __builtin_bit_cast(int, x))); }
__device__ __forceinline__ float sigmoidf_(float x) { return __builtin_amdgcn_rcpf(1.0f + __expf(-x)); }
__device__ __forceinline__ float gelu_tanh(float x) { const float u = 1.5957691216057308f * (x + 0.044715f * x * x * x); return x * sigmoidf_(u); }

struct EpiSplit {
    static constexpr bool PERM = true, AFTER_DRAIN = false;
    bf16_t* base; size_t tstride; int modes; int skip3;
    __device__ __forceinline__ void operator()(const f32x4 (&acc)[2][2][4][2], const pg8::Unit& u, int wr, int wc, int fr, int fq) const {
        const int colt = u.pn * 256, t = colt >> 10; const int mode = (modes >> (4 * t)) & 15;
        bf16_t* o = base + (size_t)(t + ((skip3 && t == 3) ? 1 : 0)) * tstride; const int col0 = (colt & 1023) + wc * 32 + 8 * fq; const int row0 = u.pm * 256 + wr * 64 + fr;
#pragma unroll
        for (int ai = 0; ai < 2; ++ai)
#pragma unroll
            for (int m = 0; m < 4; ++m) { bf16_t* rowp = o + (size_t)(row0 + ai * 128 + m * 16) * DM + col0;
#pragma unroll
                for (int bj = 0; bj < 2; ++bj) { f32x4 v0 = acc[ai][bj][m][0], v1 = acc[ai][bj][m][1];
                    if (mode == 1) {
#pragma unroll
                        for (int j = 0; j < 4; ++j) { v0[j] = gelu_tanh(v0[j]); v1[j] = gelu_tanh(v1[j]); } }
                    else if (mode == 2) {
#pragma unroll
                        for (int j = 0; j < 4; ++j) { v0[j] = sigmoidf_(v0[j]); v1[j] = sigmoidf_(v1[j]); } }
                    u32x4 w; w.x = pk2(v0[0], v0[1]); w.y = pk2(v0[2], v0[3]); w.z = pk2(v1[0], v1[1]); w.w = pk2(v1[2], v1[3]);
                    *(u32x4*)(rowp + bj * 128) = w; } }
    }
};
struct EpiPlain {
    static constexpr bool PERM = true, AFTER_DRAIN = false;
    bf16_t* o; int ldc;
    __device__ __forceinline__ void operator()(const f32x4 (&acc)[2][2][4][2], const pg8::Unit& u, int wr, int wc, int fr, int fq) const {
        const int col0 = u.pn * 256 + wc * 32 + 8 * fq; const int row0 = u.pm * 256 + wr * 64 + fr;
#pragma unroll
        for (int ai = 0; ai < 2; ++ai)
#pragma unroll
            for (int m = 0; m < 4; ++m) { bf16_t* rowp = o + (size_t)(row0 + ai * 128 + m * 16) * ldc + col0;
#pragma unroll
                for (int bj = 0; bj < 2; ++bj) { const f32x4 v0 = acc[ai][bj][m][0], v1 = acc[ai][bj][m][1];
                    u32x4 w; w.x = pk2(v0[0], v0[1]); w.y = pk2(v0[2], v0[3]); w.z = pk2(v1[0], v1[1]); w.w = pk2(v1[2], v1[3]);
                    *(u32x4*)(rowp + bj * 128) = w; } }
    }
};
struct EpiRes {
    static constexpr bool PERM = false, AFTER_DRAIN = false;
    const float* res; float* out; const float* gate  ; int row_off;
    __device__ __forceinline__ void operator()(const f32x4 (&acc)[2][2][4][2], const pg8::Unit& u, int wr, int wc, int fr, int fq) const {
        const int grow0 = row_off + u.pm * 256; const int b = grow0 / SEQ; const int row0 = grow0 + wr * 64 + fr, col0 = u.pn * 256 + wc * 32 + 4 * fq;
        f32x4 gv[2][2];
#pragma unroll
        for (int bj = 0; bj < 2; ++bj)
#pragma unroll
            for (int n = 0; n < 2; ++n) gv[bj][n] = *(const f32x4*)(gate + (size_t)b * 6144 + col0 + bj * 128 + n * 16);
#pragma unroll
        for (int ai = 0; ai < 2; ++ai)
#pragma unroll
            for (int m = 0; m < 4; ++m) { const size_t off = (size_t)(row0 + ai * 128 + m * 16) * DM + col0;
#pragma unroll
                for (int bj = 0; bj < 2; ++bj)
#pragma unroll
                    for (int n = 0; n < 2; ++n) { const f32x4 r = *(const f32x4*)(res + off + bj * 128 + n * 16); *(f32x4*)(out + off + bj * 128 + n * 16) = r + gv[bj][n] * acc[ai][bj][m][n]; }
                asm volatile("" ::: "memory"); }
    }
};


#define XB_TMO      128
#define XB_XCNT(j)  (256  + 64 * (j))
#define XB_XSUB(j)  (1280 + 64 * (j))
#define XB_XGEN(j)  (2304 + 64 * (j))
#define XB_TOP      3328
#define XB_TOPGEN   3392
#define XCD_BAR_WORDS 3456
#define XB_SPIN_CAP (1u << 22)
__device__ __forceinline__ unsigned xb_ld(unsigned* p)              { return __hip_atomic_load(p, __ATOMIC_RELAXED, __HIP_MEMORY_SCOPE_AGENT); }
__device__ __forceinline__ unsigned xb_add(unsigned* p, unsigned v) { return __hip_atomic_fetch_add(p, v, __ATOMIC_RELAXED, __HIP_MEMORY_SCOPE_AGENT); }
__device__ __forceinline__ unsigned xb_xcc_id() { return (unsigned)__builtin_amdgcn_s_getreg((3 << 11) | 20) & 0xFu; }
#define XB_SPIN(cond, bar) do { unsigned _sp = 0; while (cond) { __builtin_amdgcn_s_sleep(1); \
    if ((++_sp & 255u) == 0u) { if (xb_ld(&(bar)[XB_TMO])) break; if (_sp > XB_SPIN_CAP) { atomicAdd(&(bar)[XB_TMO], 1u); break; } } } } while (0)
struct XcdBarrier { unsigned* bar; unsigned x; volatile LAS unsigned* st; };
__device__ __forceinline__ XcdBarrier xcd_barrier_post(unsigned* bar, volatile LAS unsigned* st) {
    XcdBarrier b; b.bar = bar; b.x = xb_xcc_id(); b.st = st;
    if (threadIdx.x == 0) (void)xb_add(&bar[XB_XCNT(b.x)], 1u);
    return b;
}
__device__ __forceinline__ void xcd_barrier_complete(unsigned* bar, unsigned x, unsigned& nloc, unsigned& nx) {
    const unsigned G = gridDim.x * gridDim.y * gridDim.z;
    unsigned sum, cnt, mine, sp = 0u;
    for (;;) {
        sum = 0u; cnt = 0u; mine = 0u;
#pragma unroll
        for (unsigned j = 0; j < 16; ++j) { const unsigned c = xb_ld(&bar[XB_XCNT(j)]); sum += c; cnt += (c > 0u) ? 1u : 0u; mine = (j == x) ? c : mine; }
        if (sum == G) break;
        __builtin_amdgcn_s_sleep(1);
        if ((++sp & 255u) == 0u) { if (xb_ld(&bar[XB_TMO])) break; if (sp > XB_SPIN_CAP) { atomicAdd(&bar[XB_TMO], 1u); break; } }
    }
    nloc = mine > 0u ? mine : 1u; nx = cnt > 0u ? cnt : 1u;
}
__device__ __forceinline__ void xcd_barrier(const XcdBarrier& b, const int wv) {
    asm volatile("s_waitcnt vmcnt(0)" ::: "memory");
    __syncthreads();
    if (opaque_tid(wv) == 0) {
        unsigned* bar = b.bar;
        __builtin_amdgcn_s_waitcnt(0);
        unsigned nloc = b.st[0], nx = b.st[1];
        if (nloc == 0u) { xcd_barrier_complete(bar, b.x, nloc, nx); b.st[0] = nloc; b.st[1] = nx; }
        const unsigned old = xb_add(&bar[XB_XSUB(b.x)], 1u);
        const unsigned gen = old / nloc;
        if (old + 1u == (gen + 1u) * nloc) {
            __builtin_amdgcn_fence(__ATOMIC_RELEASE, "agent");
            asm volatile("s_waitcnt vmcnt(0)" ::: "memory");
            const unsigned og = xb_add(&bar[XB_TOP], 1u);
            const unsigned tg = og / nx;
            if (og + 1u == (tg + 1u) * nx) xb_add(&bar[XB_TOPGEN], 1u);
            else XB_SPIN(xb_ld(&bar[XB_TOPGEN]) == tg, bar);
            __builtin_amdgcn_fence(__ATOMIC_ACQUIRE, "agent");
            xb_add(&bar[XB_XGEN(b.x)], 1u);
            asm volatile("s_waitcnt vmcnt(0)" ::: "memory");
        } else {
            XB_SPIN(xb_ld(&bar[XB_XGEN(b.x)]) == gen, bar);
            __builtin_amdgcn_fence(__ATOMIC_ACQUIRE, "agent");
            asm volatile("s_waitcnt vmcnt(0)" ::: "memory");
        }
    }
    __syncthreads();
}

__device__ __forceinline__ float dpp_shr1(float x) { return __builtin_bit_cast(float, __builtin_amdgcn_update_dpp(0, __builtin_bit_cast(int, x), 0x111, 0xf, 0xf, false)); }
struct EpiConvAct {
    static constexpr bool PERM = true, AFTER_DRAIN = false;
    bf16_t* act; bf16_t* halo; const float* cw; const float* cb;
    __device__ __forceinline__ void operator()(const f32x4 (&acc)[2][2][4][2], const pg8::Unit& u, int wr, int wc, int fr, int fq) const {
        const int tb = u.pm * 256 + 128 * wr, c0 = u.pn * 128 + wc * 32 + 8 * fq;
        bf16_t* hp = halo + (size_t)(tb >> 7) * 4 * DFF2;
#pragma unroll
        for (int n = 0; n < 2; ++n) {
            const int c = c0 + 4 * n;
            const f32x4 bg = *(const f32x4*)(cb + c), bv = *(const f32x4*)(cb + DFF + c);
            const f32x4 wg0 = *(const f32x4*)(cw + c), wg1 = *(const f32x4*)(cw + DFF2 + c), wg2 = *(const f32x4*)(cw + 2 * DFF2 + c);
            const f32x4 wv0 = *(const f32x4*)(cw + DFF + c), wv1 = *(const f32x4*)(cw + DFF2 + DFF + c), wv2 = *(const f32x4*)(cw + 2 * DFF2 + DFF + c);
            f32x4 pg6, pg7, pv6, pv7;
#pragma unroll
            for (int j = 0; j < 4; ++j) { pg6[j] = dpp_shr1(acc[1][0][2][n][j]); pg7[j] = dpp_shr1(acc[1][0][3][n][j]); pv6[j] = dpp_shr1(acc[1][1][2][n][j]); pv7[j] = dpp_shr1(acc[1][1][3][n][j]); }
#pragma unroll
            for (int q = 0; q < 8; ++q) {
                const f32x4 g = acc[q >> 2][0][q & 3][n], v = acc[q >> 2][1][q & 3][n];
                const f32x4 g1 = q >= 1 ? acc[(q - 1 + 8) % 8 >> 2][0][(q - 1 + 8) % 8 & 3][n] : pg7, g2 = q >= 2 ? acc[(q - 2 + 8) % 8 >> 2][0][(q - 2 + 8) % 8 & 3][n] : (q == 1 ? pg7 : pg6);
                const f32x4 v1 = q >= 1 ? acc[(q - 1 + 8) % 8 >> 2][1][(q - 1 + 8) % 8 & 3][n] : pv7, v2 = q >= 2 ? acc[(q - 2 + 8) % 8 >> 2][1][(q - 2 + 8) % 8 & 3][n] : (q == 1 ? pv7 : pv6);
                const f32x4 g1e = q == 0 ? pg7 : g1, g2e = q == 0 ? pg6 : g2, v1e = q == 0 ? pv7 : v1, v2e = q == 0 ? pv6 : v2;
                float o[4];
#pragma unroll
                for (int j = 0; j < 4; ++j) { const float cg = bg[j] + wg0[j] * g2e[j] + wg1[j] * g1e[j] + wg2[j] * g[j]; const float cv = bv[j] + wv0[j] * v2e[j] + wv1[j] * v1e[j] + wv2[j] * v[j]; o[j] = gelu_tanh(cg) * cv; }
                if (fr > 0 || q >= 2) { u32x2 w; w.x = pk2(o[0], o[1]); w.y = pk2(o[2], o[3]); *(u32x2*)(act + (size_t)(tb + 8 * fr + q) * DFF + c) = w; }
                if ((fr == 0 && q < 2) || (fr == 15 && q >= 6)) { const int r = q < 2 ? q : q - 4; u32x2 wgp, wvp; wgp.x = pk2(g[0], g[1]); wgp.y = pk2(g[2], g[3]); wvp.x = pk2(v[0], v[1]); wvp.y = pk2(v[2], v[3]);
                    *(u32x2*)(hp + (size_t)r * DFF2 + c) = wgp; *(u32x2*)(hp + (size_t)r * DFF2 + DFF + c) = wvp; }
            }
        }
    }
};

struct Args { const float* in[21]; float* out; unsigned char* ws; };
typedef const __attribute__((address_space(4))) Args* ArgsP;

__device__ void p0_mod(ArgsP a, LAS unsigned char* lds, const int wv) {
    const int tid = opaque_tid(wv), w = tid >> 6, lane = tid & 63;
    const float* c = a->in[1]; const float* aw = a->in[2]; const float* ab = a->in[3]; float* mod = (float*)(a->ws + WS_MOD);
    LAS float* red = (LAS float*)lds;
    for (int grp = blockIdx.x; grp < NL * 6144 / 48; grp += gridDim.x) {
        const int gl = grp * 48 + (lane < 48 ? lane : 47), l = gl / 6144, j = gl % 6144;
        const float* wp = aw + (size_t)l * DM * 6144 + j;
        float s0 = 0.f, s1 = 0.f, s2 = 0.f, s3 = 0.f;
#pragma unroll 16
        for (int k = w * 128; k < w * 128 + 128; ++k) { const float wv = wp[(size_t)k * 6144]; s0 += c[k] * wv; s1 += c[DM + k] * wv; s2 += c[2 * DM + k] * wv; s3 += c[3 * DM + k] * wv; }
        red[(w * 4 + 0) * 64 + lane] = s0; red[(w * 4 + 1) * 64 + lane] = s1; red[(w * 4 + 2) * 64 + lane] = s2; red[(w * 4 + 3) * 64 + lane] = s3;
        __syncthreads();
        if (tid < 256 && lane < 48) { const int b = tid >> 6; float s = ab[(size_t)l * 6144 + j];
#pragma unroll
            for (int ww = 0; ww < 8; ++ww) s += red[(ww * 4 + b) * 64 + lane];
            mod[((size_t)l * NB + b) * 6144 + j] = s; }
        __syncthreads();
    }
    bf16_t* gw = (bf16_t*)(a->ws + WS_GW);
    for (size_t idx = (size_t)blockIdx.x * NTH + tid; idx < (size_t)NL * 2 * 8 * 128 * 128; idx += (size_t)gridDim.x * NTH) {
        const int i = idx & 127, j = (idx >> 7) & 127, h = (idx >> 14) & 7, mat = (idx >> 17) & 1, l = (int)(idx >> 18);
        const float* src = a->in[mat ? 10 : 8];
        const float v = src[(((size_t)l * 8 + h) * 128 + i) * 128 + j];
        gw[idx] = (bf16_t)(pk2(v, v) & 0xffff);
    }
}
struct TMat { const float* W; bf16_t* Wt; int K, N, rmode, ntn; };
__device__ __forceinline__ TMat tmat_of(ArgsP a, int mi) {
    const int l = mi >> 2, k = mi & 3; bf16_t* wl = (bf16_t*)(a->ws + WS_W) + (size_t)l * W_LAYER_E; TMat m;
    if (k == 0) { m.W = a->in[5] + (size_t)l * DM * DIN; m.Wt = wl; m.K = DM; m.N = DIN; m.rmode = 1; }
    else if (k == 1) { m.W = a->in[15] + (size_t)l * DM * DM; m.Wt = wl + W_IN_E; m.K = DM; m.N = DM; m.rmode = 0; }
    else if (k == 2) { m.W = a->in[17] + (size_t)l * DM * DFF2; m.Wt = wl + W_IN_E + W_OUT_E; m.K = DM; m.N = DFF2; m.rmode = 2; }
    else { m.W = a->in[20] + (size_t)l * DFF * DM; m.Wt = wl + W_IN_E + W_OUT_E + W_UP_E; m.K = DFF; m.N = DM; m.rmode = 0; }
    m.ntn = m.N / 64; return m;
}
constexpr int TILES_IN = (DM / 64) * (DIN / 64), TILES_OUT = (DM / 64) * (DM / 64), TILES_UP = (DM / 64) * (DFF2 / 64), TILES_DN = (DFF / 64) * (DM / 64), TILES_L = TILES_IN + TILES_OUT + TILES_UP + TILES_DN;
__device__ __forceinline__ void tile_of(int g, int& mi, int& tile) {
    const int l = g / TILES_L; int r = g - l * TILES_L; int k = 0;
    if (r >= TILES_IN) { r -= TILES_IN; k = 1; if (r >= TILES_OUT) { r -= TILES_OUT; k = 2; if (r >= TILES_UP) { r -= TILES_UP; k = 3; } } }
    mi = l * 4 + k; tile = r;
}
__device__ void p0_weights(ArgsP a, LAS unsigned char* lds, const int wv) {
    LAS float* t = (LAS float*)lds;
    const int tid = opaque_tid(wv); const int G = gridDim.x;
    int g = blockIdx.x; if (g >= NL * TILES_L) return;
    int mi, tile; tile_of(g, mi, tile); TMat m = tmat_of(a, mi);
    f32x4 v0, v1;
    { const int k0 = (tile / m.ntn) * 64, n0 = (tile % m.ntn) * 64; const float* p = m.W + (size_t)(k0 + (tid >> 4)) * m.N + n0 + (tid & 15) * 4; v0 = *(const f32x4*)p; v1 = *(const f32x4*)(p + (size_t)32 * m.N); }
    for (;;) {
        const int k0 = (tile / m.ntn) * 64, n0 = (tile % m.ntn) * 64; const TMat cm = m;
        { const int k = tid >> 4, n = (tid & 15) * 4;
          t[k * 65 + n] = v0[0]; t[k * 65 + n + 1] = v0[1]; t[k * 65 + n + 2] = v0[2]; t[k * 65 + n + 3] = v0[3];
          t[(k + 32) * 65 + n] = v1[0]; t[(k + 32) * 65 + n + 1] = v1[1]; t[(k + 32) * 65 + n + 2] = v1[2]; t[(k + 32) * 65 + n + 3] = v1[3]; }
        g += G; const bool more = g < NL * TILES_L;
        if (more) { tile_of(g, mi, tile); m = tmat_of(a, mi); const int k1 = (tile / m.ntn) * 64, n1 = (tile % m.ntn) * 64;
            const float* p = m.W + (size_t)(k1 + (tid >> 4)) * m.N + n1 + (tid & 15) * 4; v0 = *(const f32x4*)p; v1 = *(const f32x4*)(p + (size_t)32 * m.N); }
        __syncthreads();
        { const int n = tid >> 3, p = tid & 7; float v[8];
#pragma unroll
          for (int e = 0; e < 8; ++e) v[e] = t[(p * 8 + e) * 65 + n];
          u32x4 w; w.x = pk2(v[0], v[1]); w.y = pk2(v[2], v[3]); w.z = pk2(v[4], v[5]); w.w = pk2(v[6], v[7]);
          int nr = n0 + n; if (cm.rmode == 1) nr = nr < 2048 ? nr : (nr < 5120 ? nr + 2048 : nr - 3072);
          else if (cm.rmode == 2) nr = nr < DFF ? ((nr >> 7) * 256 + (nr & 127)) : (((nr - DFF) >> 7) * 256 + 128 + ((nr - DFF) & 127));
          *(u32x4*)(cm.Wt + (size_t)nr * cm.K + k0 + p * 8) = w; }
        __syncthreads();
        if (!more) break;
    }
}
__device__ void norm_phase(const float* __restrict__ x, const float* __restrict__ g, const float* __restrict__ modl  , int shk, int sck, bf16_t* __restrict__ xn, const int wv) {
    const int tid = opaque_tid(wv); const int w = tid >> 6, lane = tid & 63;
    for (int row = blockIdx.x * 8 + w; row < MTOK; row += gridDim.x * 8) {
        const int b = row / SEQ; const float* xr = x + (size_t)row * DM; f32x4 v[4]; float ss = 0.f;
#pragma unroll
        for (int i = 0; i < 4; ++i) { v[i] = *(const f32x4*)(xr + lane * 4 + 256 * i); ss += v[i][0] * v[i][0] + v[i][1] * v[i][1] + v[i][2] * v[i][2] + v[i][3] * v[i][3]; }
#pragma unroll
        for (int o = 32; o >= 1; o >>= 1) ss += lane_get(ss, lane ^ o);
        const float rstd = rsqrtf(ss * (1.0f / DM) + EPS);
        const float* sh = modl + (size_t)b * 6144 + shk * 1024; const float* sc = modl + (size_t)b * 6144 + sck * 1024;
#pragma unroll
        for (int i = 0; i < 4; ++i) { const int c = lane * 4 + 256 * i; const f32x4 gg = *(const f32x4*)(g + c), s1 = *(const f32x4*)(sc + c), s0 = *(const f32x4*)(sh + c);
            f32x4 y;
#pragma unroll
            for (int j = 0; j < 4; ++j) y[j] = v[i][j] * rstd * gg[j] * (1.0f + s1[j]) + s0[j];
            u32x2 o; o.x = pk2(y[0], y[1]); o.y = pk2(y[2], y[3]); *(u32x2*)(xn + (size_t)row * DM + c) = o; }
    }
}
constexpr int KP = 272, VP = 136;
constexpr int ASLOT = 64 * KP + 128 * VP;
constexpr float DEAD = 1e-30f;
typedef float f32x2 __attribute__((ext_vector_type(2)));
template <bool DIAG>
__device__ __forceinline__ void sb_weights(const f32x4 (&S)[4], float& carry, unsigned (&pw)[4][2], int q, int key0, int fq, int lane) {
    {
        f32x2 w01[4], w23[4]; float T[4], ab[4];
#pragma unroll
        for (int nb = 0; nb < 4; ++nb) {
            float E[4], be[4];
#pragma unroll
            for (int e = 0; e < 4; ++e) E[e] = __builtin_amdgcn_exp2f(-__builtin_amdgcn_fmed3f(S[nb][e], -115.f, 115.f));
            const f32x2 d01 = (f32x2){E[0], E[1]} + 1.0f, d23 = (f32x2){E[2], E[3]} + 1.0f;
            be[0] = __builtin_amdgcn_rcpf(d01.x); be[1] = __builtin_amdgcn_rcpf(d01.y); be[2] = __builtin_amdgcn_rcpf(d23.x); be[3] = __builtin_amdgcn_rcpf(d23.y);
            f32x2 b01 = (f32x2){be[0], be[1]}, b23 = (f32x2){be[2], be[3]};
            f32x2 o01 = (f32x2){E[0], E[1]} * b01, o23 = (f32x2){E[2], E[3]} * b23;
            if (DIAG) { const int k = key0 + 16 * nb;
                const bool m0 = k + 0 < q, m1 = k + 1 < q, m2 = k + 2 < q, m3 = k + 3 < q;
                b01.x = m0 ? b01.x : 0.f; o01.x = m0 ? o01.x : 1.f; b01.y = m1 ? b01.y : 0.f; o01.y = m1 ? o01.y : 1.f; b23.x = m2 ? b23.x : 0.f; o23.x = m2 ? o23.x : 1.f; b23.y = m3 ? b23.y : 0.f; o23.y = m3 ? o23.y : 1.f; }
            const float s1 = o23.y * o23.x, s0 = s1 * o01.y, run = s0 * o01.x;
            w01[nb] = b01 * (f32x2){s0, s1}; w23[nb] = b23 * (f32x2){o23.y, 1.0f};
            const float g1 = lane_get(run, lane ^ 16), g2 = lane_get(run, lane ^ 32), g3 = lane_get(g1, lane ^ 32);
            const float g23 = g2 * g3; T[nb] = (run * g1) * g23; ab[nb] = fq == 0 ? (g1 * g23) : fq == 1 ? g23 : fq == 2 ? g1 : 1.f; }
        float hi = carry;
#pragma unroll
        for (int nb = 3; nb >= 0; --nb) { const float base = hi * ab[nb]; const f32x2 p01 = w01[nb] * base, p23 = w23[nb] * base;
            pw[nb][0] = pk2(p01.x, p01.y); pw[nb][1] = pk2(p23.x, p23.y); hi *= T[nb]; }
        carry = hi;
    }
}
__device__ __forceinline__ void attn_stage(LAS unsigned char* Ks, LAS unsigned char* Vt, const u32x4 (&kr)[2], const u32x4 (&vr)[2], const float (&gks)[8], int sp, int skp, int lane) {
#pragma unroll
    for (int i = 0; i < 2; ++i) { float x[8]; float ss = 0.f;
#pragma unroll
        for (int j = 0; j < 4; ++j) { x[2 * j] = bflo(kr[i][j]); x[2 * j + 1] = bfhi(kr[i][j]); ss += x[2 * j] * x[2 * j] + x[2 * j + 1] * x[2 * j + 1]; }
        ss += lane_get(ss, lane ^ 1); ss += lane_get(ss, lane ^ 2); ss += lane_get(ss, lane ^ 4); ss += lane_get(ss, lane ^ 8);
        const float rs = rsqrtf(ss * (1.0f / 128.0f) + EPS);
        u32x4 o;
#pragma unroll
        for (int j = 0; j < 4; ++j) o[j] = pk2(x[2 * j] * rs * gks[2 * j], x[2 * j + 1] * rs * gks[2 * j + 1]);
        *(LAS u32x4*)(Ks + (2 * skp + i) * KP + sp * 16) = o; }
    const int wsz = skp ^ (sp & 14);
#pragma unroll
    for (int j = 0; j < 4; ++j) { *(LAS unsigned*)(Vt + (sp * 8 + 2 * j) * VP + wsz * 4) = (vr[0][j] & 0xffffu) | (vr[1][j] << 16); *(LAS unsigned*)(Vt + (sp * 8 + 2 * j + 1) * VP + wsz * 4) = (vr[0][j] >> 16) | (vr[1][j] & 0xffff0000u); }
}
__device__ void attn_phase(ArgsP a, int l, LAS unsigned char* lds, const int wv) {
    const int tid = opaque_tid(wv), w = __builtin_amdgcn_readfirstlane(tid >> 6), lane = tid & 63, fr = lane & 15, fq = lane >> 4;
    LAS int* flags = (LAS int*)(lds + 4 * ASLOT);
    const bf16_t* Qb = (const bf16_t*)(a->ws + WS_P); bf16_t* Yb = (bf16_t*)(a->ws + WS_P + 3 * PBUF); const bf16_t* Kb = (const bf16_t*)(a->ws + WS_P + PBUF); const bf16_t* Vb = (const bf16_t*)(a->ws + WS_P + 2 * PBUF);
    const float* gq = a->in[13] + l * 128; const float* gk = a->in[14] + l * 128;
    const int sp = tid & 15, skp = tid >> 4;
    float gks[8];
#pragma unroll
    for (int e = 0; e < 8; ++e) gks[e] = gk[sp * 8 + e] * gq[sp * 8 + e];
    const int nunits = NB * 8 * (SEQ / 256);
    for (int unit = blockIdx.x; unit < nunits; unit += gridDim.x) {
        const int qt = (SEQ / 256 - 1) - unit / (NB * 8), bh = unit % (NB * 8), b = bh >> 3, hh = bh & 7;
        const size_t rowbase = (size_t)b * SEQ; const int t0 = qt * 256, r0 = t0 + 32 * w;
        const int kbw = qt * 4 + (w >> 1);
        const bf16_t* kbase = Kb + rowbase * DM + hh * 128 + sp * 8; const bf16_t* vbase = Vb + rowbase * DM + hh * 128 + sp * 8;
        u32x4 kr[2], vr[2];
#pragma unroll
        for (int h2 = 0; h2 < 2; ++h2) { u32x4 k4[2][2], v4[2][2];
#pragma unroll
          for (int i4 = 0; i4 < 2; ++i4)
#pragma unroll
              for (int i = 0; i < 2; ++i) { const size_t ro = (size_t)((qt * 4 + 2 * h2 + i4) * 64 + 2 * skp + i) * DM; k4[i4][i] = *(const u32x4*)(kbase + ro); v4[i4][i] = *(const u32x4*)(vbase + ro); }
#pragma unroll
          for (int i4 = 0; i4 < 2; ++i4) attn_stage(lds + (2 * h2 + i4) * ASLOT, lds + (2 * h2 + i4) * ASLOT + 64 * KP, k4[i4], v4[i4], gks, sp, skp, lane); }
        bf16x8 qf[2][4];
#pragma unroll
        for (int rb = 0; rb < 2; ++rb) {
            const bf16_t* qp = Qb + (rowbase + r0 + 16 * rb + fr) * DM + hh * 128 + 8 * fq; u32x4 raw[4]; float ss = 0.f;
#pragma unroll
            for (int ks = 0; ks < 4; ++ks) { raw[ks] = *(const u32x4*)(qp + 32 * ks);
#pragma unroll
                for (int j = 0; j < 4; ++j) { const float x0 = bflo(raw[ks][j]), x1 = bfhi(raw[ks][j]); ss += x0 * x0 + x1 * x1; } }
            ss += lane_get(ss, lane ^ 16); ss += lane_get(ss, lane ^ 32);
            const float rs = rsqrtf(ss * (1.0f / 128.0f) + EPS) * (0.08838834764831845f * 1.4426950408889634f);
#pragma unroll
            for (int ks = 0; ks < 4; ++ks) { u32x4 o;
#pragma unroll
                for (int j = 0; j < 4; ++j) o[j] = pk2(bflo(raw[ks][j]) * rs, bfhi(raw[ks][j]) * rs);
                qf[rb][ks] = __builtin_bit_cast(bf16x8, o); }
        }
        f32x4 O[2][8];
#pragma unroll
        for (int rb = 0; rb < 2; ++rb)
#pragma unroll
            for (int db = 0; db < 8; ++db) O[rb][db] = (f32x4){0.f, 0.f, 0.f, 0.f};
        float carry[2] = {1.f, 1.f};
        bool alive = true;
        __syncthreads();
        for (int s_ = 0;; ++s_) {
            const int kb = kbw - s_, nbn = qt * 4 - s_ - 1;
            if (nbn >= 0) {
#pragma unroll
                for (int i = 0; i < 2; ++i) { const size_t ro = (size_t)(nbn * 64 + 2 * skp + i) * DM; kr[i] = *(const u32x4*)(kbase + ro); vr[i] = *(const u32x4*)(vbase + ro); } }
            if (alive && kb >= 0) {
                const LAS unsigned char* Ks = lds + (kb & 3) * ASLOT; const LAS unsigned char* Vt = Ks + 64 * KP;
                unsigned pw[2][4][2];
#pragma unroll
                for (int rb = 0; rb < 2; ++rb) {
                    f32x4 S[4];
#pragma unroll
                    for (int nb = 0; nb < 4; ++nb) { f32x4 sacc = (f32x4){0.f, 0.f, 0.f, 0.f};
#pragma unroll
                        for (int ks = 0; ks < 4; ++ks) { const bf16x8 kf = *(const LAS bf16x8*)(Ks + (16 * nb + fr) * KP + (32 * ks + 8 * fq) * 2); sacc = __builtin_amdgcn_mfma_f32_16x16x32_bf16(kf, qf[rb][ks], sacc, 0, 0, 0); }
                        S[nb] = sacc; }
                    if (s_ == 0) sb_weights<true>(S, carry[rb], pw[rb], r0 + 16 * rb + fr, kb * 64 + 4 * fq, fq, lane);
                    else sb_weights<false>(S, carry[rb], pw[rb], r0 + 16 * rb + fr, kb * 64 + 4 * fq, fq, lane);
                }
#pragma unroll
                for (int ks2 = 0; ks2 < 2; ++ks2) {
                    bf16x8 pf[2];
#pragma unroll
                    for (int rb = 0; rb < 2; ++rb) { u32x4 t; t.x = pw[rb][2 * ks2][0]; t.y = pw[rb][2 * ks2][1]; t.z = pw[rb][2 * ks2 + 1][0]; t.w = pw[rb][2 * ks2 + 1][1]; pf[rb] = __builtin_bit_cast(bf16x8, t); }
#pragma unroll
                    for (int db = 0; db < 8; ++db) { const LAS unsigned char* vrow = Vt + (16 * db + fr) * VP;
                        const u32x2 va = *(const LAS u32x2*)(vrow + 4 * ((16 * ks2 + 2 * fq) ^ (2 * db))), vb = *(const LAS u32x2*)(vrow + 4 * ((16 * ks2 + 8 + 2 * fq) ^ (2 * db)));
                        u32x4 t; t.x = va.x; t.y = va.y; t.z = vb.x; t.w = vb.y; const bf16x8 vf = __builtin_bit_cast(bf16x8, t);
#pragma unroll
                        for (int rb = 0; rb < 2; ++rb) O[rb][db] = __builtin_amdgcn_mfma_f32_16x16x32_bf16(vf, pf[rb], O[rb][db], 0, 0, 0); }
                }
                alive = !__all((carry[0] < DEAD) && (carry[1] < DEAD));
            }
            if (lane == 0) flags[w] = (alive && kb >= 1) ? 1 : 0;
            __syncthreads();
            int any = 0;
#pragma unroll
            for (int ww = 0; ww < 8; ++ww) any |= flags[ww];
            if (!any) break;
            if (nbn >= 0) attn_stage(lds + (nbn & 3) * ASLOT, lds + (nbn & 3) * ASLOT + 64 * KP, kr, vr, gks, sp, skp, lane);
            __syncthreads();
        }
#pragma unroll
        for (int rb = 0; rb < 2; ++rb) { bf16_t* op = Yb + (rowbase + r0 + 16 * rb + fr) * DM + hh * 128 + 4 * fq;
#pragma unroll
            for (int db = 0; db < 8; ++db) { u32x2 o; o.x = pk2(O[rb][db][0], O[rb][db][1]); o.y = pk2(O[rb][db][2], O[rb][db][3]); *(u32x2*)(op + 16 * db) = o; } }
        __syncthreads();
    }
}
constexpr int XP = 272;
__device__ void rnn_phase(ArgsP a, int l, LAS unsigned char* lds, const int wv) {
    const int tid = opaque_tid(wv), w = __builtin_amdgcn_readfirstlane(tid >> 6), lane = tid & 63, fr = lane & 15, fq = lane >> 4;
    LAS unsigned char* XC = lds; LAS unsigned char* HT = lds + RT * XP; LAS unsigned char* PT = lds + 2 * RT * XP;
    const bf16_t* XR = (const bf16_t*)(a->ws + WS_P); const bf16_t* GY = (const bf16_t*)(a->ws + WS_P + PBUF); bf16_t* SGA = (bf16_t*)(a->ws + WS_P + 2 * PBUF);
    bf16_t* SGB = (bf16_t*)(a->ws + WS_P + 4 * PBUF); const bf16_t* YB = (const bf16_t*)(a->ws + WS_P + 3 * PBUF);
    float* SUM = (float*)(a->ws + WS_SUM);
    const bf16_t* gw = (const bf16_t*)(a->ws + WS_GW) + (size_t)l * 2 * 8 * 16384;
    const float* cw = a->in[6] + (size_t)l * 4 * DM; const float* cb = a->in[7] + (size_t)l * DM;
    const float* ba = a->in[9] + (size_t)l * DM; const float* bx = a->in[11] + (size_t)l * DM; const float* lam = a->in[12] + (size_t)l * DM;
    const int sp = tid & 15, tg = tid >> 4;
    const int nunits = NB * 8 * NT;
    for (int unit = blockIdx.x; unit < nunits; unit += gridDim.x) {
        const int hh = unit & 7, b = (unit >> 3) & 3, j = unit >> 5; const int t0 = j * RT; const size_t rowbase = (size_t)b * SEQ;
        const int cbase = hh * 128;
        { u32x4 r[7];
#pragma unroll
          for (int i = 0; i < 7; ++i) { const int ts = t0 + 4 * tg - 3 + i; r[i] = (u32x4){0, 0, 0, 0}; if (ts >= 0) r[i] = *(const u32x4*)(XR + (rowbase + ts) * DM + cbase + sp * 8); }
          float wvv[4][8], bv[8];
#pragma unroll
          for (int e = 0; e < 8; ++e) { bv[e] = cb[cbase + sp * 8 + e];
#pragma unroll
              for (int k = 0; k < 4; ++k) wvv[k][e] = cw[k * DM + cbase + sp * 8 + e]; }
#pragma unroll
          for (int i = 0; i < 4; ++i) { float acc[8];
#pragma unroll
              for (int e = 0; e < 8; ++e) acc[e] = bv[e];
#pragma unroll
              for (int k = 0; k < 4; ++k) {
#pragma unroll
                  for (int jj = 0; jj < 4; ++jj) { acc[2 * jj] += wvv[k][2 * jj] * bflo(r[i + k][jj]); acc[2 * jj + 1] += wvv[k][2 * jj + 1] * bfhi(r[i + k][jj]); } }
              u32x4 o; o.x = pk2(acc[0], acc[1]); o.y = pk2(acc[2], acc[3]); o.z = pk2(acc[4], acc[5]); o.w = pk2(acc[6], acc[7]);
              *(LAS u32x4*)(XC + (4 * tg + i) * XP + sp * 16) = o; } }
        bf16x8 wa[4], wx[4];
        { const bf16_t* pa = gw + ((size_t)(0 * 8 + hh) * 128 + 16 * w + fr) * 128 + 8 * fq; const bf16_t* px = gw + ((size_t)(1 * 8 + hh) * 128 + 16 * w + fr) * 128 + 8 * fq;
#pragma unroll
          for (int ks = 0; ks < 4; ++ks) { wa[ks] = *(const bf16x8*)(pa + 32 * ks); wx[ks] = *(const bf16x8*)(px + 32 * ks); } }
        const int c = cbase + 16 * w + fr;
        const float bac = ba[c], bxc = bx[c]; const float lm = lam[c];
        const float sp8l = 8.0f * 1.4426950408889634f * (fmaxf(-lm, 0.f) + __logf(1.0f + __expf(-fabsf(lm))));
        __syncthreads();
        f32x4 A[8], U[8];
#pragma unroll
        for (int mb = 0; mb < 8; ++mb) { f32x4 ra = (f32x4){0.f, 0.f, 0.f, 0.f}, rx = ra;
#pragma unroll
            for (int ks = 0; ks < 4; ++ks) { const bf16x8 xf = *(const LAS bf16x8*)(XC + (16 * mb + fr) * XP + (32 * ks + 8 * fq) * 2);
                ra = __builtin_amdgcn_mfma_f32_16x16x32_bf16(xf, wa[ks], ra, 0, 0, 0); rx = __builtin_amdgcn_mfma_f32_16x16x32_bf16(xf, wx[ks], rx, 0, 0, 0); }
#pragma unroll
            for (int e = 0; e < 4; ++e) { const float r = __builtin_amdgcn_rcpf(1.0f + __builtin_amdgcn_exp2f(-1.4426950408889634f * (ra[e] + bac)));
                const float ig = __builtin_amdgcn_rcpf(1.0f + __builtin_amdgcn_exp2f(-1.4426950408889634f * (rx[e] + bxc)));
                const float la2 = -sp8l * r; const float av = __builtin_amdgcn_exp2f(la2);
                const float x2 = 1.3862943611198906f * la2;
                const float om = x2 > -0.02f ? -x2 * (1.0f + x2 * (0.5f + x2 * (1.0f / 6.0f))) : 1.0f - av * av;
                const float xc = bf2f(*(const LAS bf16_t*)(XC + (16 * mb + 4 * fq + e) * XP + (16 * w + fr) * 2));
                ra[e] = av; rx[e] = __builtin_amdgcn_sqrtf(om) * ig * xc; }
            A[mb] = ra; U[mb] = rx; }
        u32x4 mg[4], ms1[4], ms2[4], myb[4];
#pragma unroll
        for (int i = 0; i < 4; ++i) { const size_t go = (rowbase + t0 + 4 * tg + i) * DM + cbase + sp * 8; mg[i] = *(const u32x4*)(GY + go); ms1[i] = *(const u32x4*)(SGA + go); ms2[i] = *(const u32x4*)(SGB + go); myb[i] = *(const u32x4*)(YB + go); }
        float H = 0.f, Pp = 1.0f;
#pragma unroll
        for (int mb = 0; mb < 8; ++mb) {
            float Ag = A[mb][0] * A[mb][1] * A[mb][2] * A[mb][3];
            float Ug = ((U[mb][0] * A[mb][1] + U[mb][1]) * A[mb][2] + U[mb][2]) * A[mb][3] + U[mb][3];
            { const float a1 = lane_get(Ag, lane - 16), u1 = lane_get(Ug, lane - 16); if (fq >= 1) { Ug = Ag * u1 + Ug; Ag = Ag * a1; } }
            { const float a2 = lane_get(Ag, lane - 32), u2 = lane_get(Ug, lane - 32); if (fq >= 2) { Ug = Ag * u2 + Ug; Ag = Ag * a2; } }
            const float ap = lane_get(Ag, lane - 16), up = lane_get(Ug, lane - 16);
            float h = fq == 0 ? H : ap * H + up, p = fq == 0 ? Pp : ap * Pp;
#pragma unroll
            for (int e = 0; e < 4; ++e) { h = A[mb][e] * h + U[mb][e]; p *= A[mb][e]; const unsigned hp2 = pk2(h, p); const int off = (16 * mb + 4 * fq + e) * XP + (16 * w + fr) * 2;
                *(LAS bf16_t*)(HT + off) = (bf16_t)(hp2 & 0xffff); *(LAS bf16_t*)(PT + off) = (bf16_t)(hp2 >> 16); }
            const float Am = lane_get(Ag, 48 + fr), Um = lane_get(Ug, 48 + fr);
            H = Am * H + Um; Pp *= Am;
        }
        if (fq == 0) { float* sm = SUM + (((size_t)b * NT + j) * DM + c) * 2; sm[0] = Pp; sm[1] = H; }
        __syncthreads();
#pragma unroll
        for (int i = 0; i < 4; ++i) { const int tl = 4 * tg + i; const size_t go = (rowbase + t0 + tl) * DM + cbase + sp * 8;
            const u32x4 hv = *(const LAS u32x4*)(HT + tl * XP + sp * 16), pv = *(const LAS u32x4*)(PT + tl * XP + sp * 16);
            u32x4 o0, o1;
#pragma unroll
            for (int jj = 0; jj < 4; ++jj) { const float ga = bflo(ms1[i][jj]) * bflo(mg[i][jj]), gb = bfhi(ms1[i][jj]) * bfhi(mg[i][jj]);
                o0[jj] = pk2(ga * bflo(hv[jj]) + bflo(ms2[i][jj]) * bflo(myb[i][jj]), gb * bfhi(hv[jj]) + bfhi(ms2[i][jj]) * bfhi(myb[i][jj]));
                o1[jj] = pk2(ga * bflo(pv[jj]), gb * bfhi(pv[jj])); }
            *(u32x4*)(SGB + go) = o0; *(u32x4*)(SGA + go) = o1; }
    }
}
__device__ void carry_phase(ArgsP a, const int wv) {
    const float* SUM = (const float*)(a->ws + WS_SUM); float* HIN = (float*)(a->ws + WS_HIN);
    const int gt = blockIdx.x * NTH + opaque_tid(wv); if (gt >= NB * DM) return;
    const int b = gt / DM, c = gt % DM; float H = 0.f;
#pragma unroll 8
    for (int j = 0; j < NT; ++j) { const size_t o = ((size_t)b * NT + j) * DM + c; HIN[o] = H; const float p = SUM[o * 2], h = SUM[o * 2 + 1]; H = p * H + h; }
}
__device__ void mix_phase(ArgsP a, const int wv) {
    const bf16_t* M0 = (const bf16_t*)(a->ws + WS_P + 4 * PBUF); const bf16_t* M1 = (const bf16_t*)(a->ws + WS_P + 2 * PBUF); bf16_t* MIX = (bf16_t*)(a->ws + WS_XN); const float* HIN = (const float*)(a->ws + WS_HIN);
    for (int it = blockIdx.x * NTH + opaque_tid(wv); it < (MTOK / 32) * (DM / 8); it += gridDim.x * NTH) {
        const int pc = it & 127, rg = it >> 7; const int row0 = rg * 32, b = row0 / SEQ, j = (row0 % SEQ) / RT;
        const float* hp = HIN + ((size_t)b * NT + j) * DM + pc * 8; const f32x4 h0 = *(const f32x4*)hp, h1 = *(const f32x4*)(hp + 4);
#pragma unroll 8
        for (int r = 0; r < 32; ++r) { const size_t go = (size_t)(row0 + r) * DM + pc * 8; const u32x4 m0 = *(const u32x4*)(M0 + go), m1 = *(const u32x4*)(M1 + go); u32x4 o;
            o.x = pk2(bflo(m0.x) + bflo(m1.x) * h0[0], bfhi(m0.x) + bfhi(m1.x) * h0[1]); o.y = pk2(bflo(m0.y) + bflo(m1.y) * h0[2], bfhi(m0.y) + bfhi(m1.y) * h0[3]);
            o.z = pk2(bflo(m0.z) + bflo(m1.z) * h1[0], bfhi(m0.z) + bfhi(m1.z) * h1[1]); o.w = pk2(bflo(m0.w) + bflo(m1.w) * h1[2], bfhi(m0.w) + bfhi(m1.w) * h1[3]);
            *(u32x4*)(MIX + go) = o; }
    }
}
__device__ void ffn_fixup(ArgsP a, int l, const int wv) {
    bf16_t* ACT = (bf16_t*)(a->ws + WS_P); const bf16_t* HALO = (const bf16_t*)(a->ws + WS_P + ACT_BYTES);
    const float* cw = a->in[18] + (size_t)l * 3 * DFF2; const float* cb = a->in[19] + (size_t)l * DFF2;
    const int nitems = (MTOK / 128) * (DFF / 8);
    for (int it = blockIdx.x * NTH + opaque_tid(wv); it < nitems; it += gridDim.x * NTH) {
        const int cgp = it % (DFF / 8), wb = it / (DFF / 8); const int c0 = cgp * 8, t0 = wb * 128; const bool first = (t0 & (SEQ - 1)) == 0;
        const bf16_t* hc = HALO + (size_t)wb * 4 * DFF2; const bf16_t* hpv = hc - 4 * DFF2;
        u32x4 z = (u32x4){0, 0, 0, 0}; u32x4 gm2 = z, gm1 = z, vm2 = z, vm1 = z;
        if (!first) { gm2 = *(const u32x4*)(hpv + 2 * DFF2 + c0); gm1 = *(const u32x4*)(hpv + 3 * DFF2 + c0); vm2 = *(const u32x4*)(hpv + 2 * DFF2 + DFF + c0); vm1 = *(const u32x4*)(hpv + 3 * DFF2 + DFF + c0); }
        const u32x4 g0 = *(const u32x4*)(hc + c0), g1 = *(const u32x4*)(hc + DFF2 + c0), v0 = *(const u32x4*)(hc + DFF + c0), v1 = *(const u32x4*)(hc + DFF2 + DFF + c0);
        u32x4 o0, o1;
#pragma unroll
        for (int jj = 0; jj < 4; ++jj) {
            float r0[2], r1[2];
#pragma unroll
            for (int hl = 0; hl < 2; ++hl) { const int c = c0 + 2 * jj + hl;
                const float wg0 = cw[c], wg1 = cw[DFF2 + c], wg2 = cw[2 * DFF2 + c], wv0 = cw[DFF + c], wv1 = cw[DFF2 + DFF + c], wv2 = cw[2 * DFF2 + DFF + c], bg = cb[c], bv = cb[DFF + c];
                const float G2 = hl ? bfhi(gm2[jj]) : bflo(gm2[jj]), G1 = hl ? bfhi(gm1[jj]) : bflo(gm1[jj]), Ga = hl ? bfhi(g0[jj]) : bflo(g0[jj]), Gb = hl ? bfhi(g1[jj]) : bflo(g1[jj]);
                const float V2 = hl ? bfhi(vm2[jj]) : bflo(vm2[jj]), V1 = hl ? bfhi(vm1[jj]) : bflo(vm1[jj]), Va = hl ? bfhi(v0[jj]) : bflo(v0[jj]), Vb = hl ? bfhi(v1[jj]) : bflo(v1[jj]);
                r0[hl] = gelu_tanh(bg + wg0 * G2 + wg1 * G1 + wg2 * Ga) * (bv + wv0 * V2 + wv1 * V1 + wv2 * Va);
                r1[hl] = gelu_tanh(bg + wg0 * G1 + wg1 * Ga + wg2 * Gb) * (bv + wv0 * V1 + wv1 * Va + wv2 * Vb); }
            o0[jj] = pk2(r0[0], r0[1]); o1[jj] = pk2(r1[0], r1[1]); }
        *(u32x4*)(ACT + (size_t)t0 * DFF + c0) = o0; *(u32x4*)(ACT + (size_t)(t0 + 1) * DFF + c0) = o1;
    }
}
constexpr int LDS_BYTES = 137 * 1024;
__global__ void __launch_bounds__(NTH, 2) mk_fwd(Args a_unused) {
    ArgsP a = (ArgsP)__builtin_amdgcn_kernarg_segment_ptr(); asm volatile("" : "+s"(a));
    const int wv = __builtin_amdgcn_readfirstlane(threadIdx.x >> 6);
    extern __shared__ __attribute__((aligned(16))) unsigned char lds_raw[];
    LAS unsigned char* lds = (LAS unsigned char*)lds_raw;
    cg::grid_group grid = cg::this_grid();
    volatile LAS unsigned* xbst = (volatile LAS unsigned*)(lds + LDS_BYTES - 16);
    if (threadIdx.x < 4) xbst[threadIdx.x] = 0u;
    __syncthreads();
    const XcdBarrier xbar = xcd_barrier_post((unsigned*)(a->ws + WS_BAR), xbst);
    const int G = gridDim.x, bid = blockIdx.x;
    float* mod = (float*)(a->ws + WS_MOD);
    bf16_t* XN = (bf16_t*)(a->ws + WS_XN); bf16_t* P = (bf16_t*)(a->ws + WS_P);
#ifndef REPMASK
#define REPMASK 0
#endif
#ifndef XSYNC
#define XSYNC 0
#endif
#define RUN(k, ...) for (int _r = 0; _r < (((REPMASK >> (k)) & 1) ? 2 : 1); ++_r) { __VA_ARGS__ xcd_barrier(xbar, wv); }
    for (int _r = 0; _r < ((REPMASK & 1) ? 2 : 1); ++_r) { p0_mod(a, lds, wv); p0_weights(a, lds, wv); grid.sync(); }
    for (int _x = 0; _x < XSYNC; ++_x) xcd_barrier(xbar, wv);
    for (int l = 0; l < NL; ++l) {
        const float* modl = mod + (size_t)l * NB * 6144;
        const bf16_t* wl = (const bf16_t*)(a->ws + WS_W) + (size_t)l * W_LAYER_E;
        const float* xin = l == 0 ? a->in[0] : a->out;
        RUN(1, norm_phase(xin, a->in[4] + l * DM, modl, 0, 1, XN, wv);)
        RUN(2, { pg8::Gemm g{XN, wl + (size_t)4096 * DM, MTOK, 3072, DM}; pg8::StaticOrder S; S.init(MTOK, 3072, G, bid);
          EpiSplit E{P, (size_t)MTOK * DM, 0x0000, 0}; pg8::gemm_phase<EpiSplit, pg8::StaticOrder, true, true>(lds, g, S, E, wv); })
        RUN(3, attn_phase(a, l, lds, wv);)
        RUN(4, { pg8::Gemm g{XN, wl, MTOK, 4096, DM}; pg8::StaticOrder S; S.init(MTOK, 4096, G, bid);
          EpiSplit E{P, (size_t)MTOK * DM, 0x2210, 1}; pg8::gemm_phase<EpiSplit, pg8::StaticOrder, true, true>(lds, g, S, E, wv); })
        RUN(5, rnn_phase(a, l, lds, wv);)
        RUN(6, carry_phase(a, wv);)
        RUN(7, mix_phase(a, wv);)
        RUN(13, { pg8::Gemm g{XN, wl + W_IN_E, MTOK, DM, DM}; pg8::StaticOrder S; S.init(MTOK, DM, G, bid);
          EpiRes E{xin, a->out, modl + 2 * 1024, 0}; pg8::gemm_phase<EpiRes, pg8::StaticOrder, true, true>(lds, g, S, E, wv); })
        RUN(9, norm_phase(a->out, a->in[16] + l * DM, modl, 3, 4, XN, wv);)
        RUN(10, { pg8::Gemm g{XN, wl + W_IN_E + W_OUT_E, MTOK, DFF2, DM}; pg8::StaticOrder S; S.init(MTOK, DFF2, G, bid);
          EpiConvAct E{P, (bf16_t*)(a->ws + WS_P + ACT_BYTES), a->in[18] + (size_t)l * 3 * DFF2, a->in[19] + (size_t)l * DFF2};
          pg8::gemm_phase<EpiConvAct, pg8::StaticOrder, true, true, true>(lds, g, S, E, wv); })
        RUN(11, ffn_fixup(a, l, wv);)
        RUN(13, { pg8::Gemm g{P, wl + W_IN_E + W_OUT_E + W_UP_E, MTOK, DM, DFF}; pg8::StaticOrder S; S.init(MTOK, DM, G, bid);
          EpiRes E{a->out, a->out, modl + 5 * 1024, 0}; pg8::gemm_phase<EpiRes, pg8::StaticOrder, true, true>(lds, g, S, E, wv); })
    }
}
extern "C" void kernel_launch(void* const* d_in, const int* in_sizes, int n_in, void* d_out, int out_size, void* d_ws, size_t ws_size, hipStream_t stream) {
    static int grid = 0;
    if (!grid) {
        int dev = 0, cus = 0, per_cu = 0;
        (void)hipGetDevice(&dev);
        (void)hipDeviceGetAttribute(&cus, hipDeviceAttributeMultiprocessorCount, dev);
        (void)hipFuncSetAttribute((const void*)mk_fwd, hipFuncAttributeMaxDynamicSharedMemorySize, LDS_BYTES);
        (void)hipOccupancyMaxActiveBlocksPerMultiprocessor(&per_cu, (const void*)mk_fwd, NTH, LDS_BYTES);
        if (per_cu < 1) per_cu = 1;
        grid = cus * per_cu;
        if (ws_size < WS_END) { fprintf(stderr, "kernel_launch: workspace too small: %zu < %zu\n", ws_size, (size_t)WS_END); grid = -1; }
        if (n_in != 21 || out_size != MTOK * DM) { fprintf(stderr, "kernel_launch: unexpected shapes\n"); grid = -1; }
    }
    if (grid < 0) return;
    (void)hipMemsetAsync((char*)d_ws + WS_BAR, 0, XCD_BAR_WORDS * 4, stream);
    Args a{};
    for (int i = 0; i < 21; ++i) a.in[i] = (const float*)d_in[i];
    a.out = (float*)d_out; a.ws = (unsigned char*)d_ws;
    void* args[] = {&a};
    hipError_t e = hipLaunchCooperativeKernel((const void*)mk_fwd, dim3(grid), dim3(NTH), args, LDS_BYTES, stream);
    if (e != hipSuccess) fprintf(stderr, "cooperative launch failed: %s (grid %d)\n", hipGetErrorString(e), grid);
}
```

```cpp
#include <hip/hip_runtime.h>
#include <hip/hip_cooperative_groups.h>
#include <cstdio>
#include <cstdint>
namespace cg = cooperative_groups;
__device__ __forceinline__ int opaque_tid(int wv) { int t; asm volatile("v_mbcnt_lo_u32_b32 %0, -1, 0\n\tv_mbcnt_hi_u32_b32 %0, -1, %0" : "=v"(t)); return t | (wv << 6); }
__device__ __forceinline__ int opaque_bid() { int t = blockIdx.x; asm volatile("" : "+s"(t)); return t; }
namespace pg8 {
#define PG8_LAS __attribute__((address_space(3)))
typedef unsigned short bf16_t;
typedef short bf16x8 __attribute__((ext_vector_type(8)));
typedef float f32x4 __attribute__((ext_vector_type(4)));
typedef unsigned u32x4 __attribute__((ext_vector_type(4)));
constexpr int BM = 256, BK = 64, HALF = 128, HTB = HALF * BK * 2  , STAGE_BYTES = 8 * HTB, NXCD = 8, WGM = 8;

__host__ __device__ __forceinline__ int lds_byte(int r, int c) { const int st = (r >> 4) * 2 + (c >> 5), rr = r & 15, cc = c & 31, ob = rr * 64 + cc * 2; return st * 1024 + (ob ^ (((ob >> 9) & 1) << 5)); }
__host__ __device__ __forceinline__ void stage_rc(int b, int& R, int& C) { const int st = b / 1024, sb = b % 1024, swz = sb ^ (((sb >> 9) & 1) << 5); R = (st >> 1) * 16 + swz / 64; C = (st & 1) * 32 + (swz % 64) / 2; }
__host__ __device__ __forceinline__ int perm32(int rho) { const int n = rho >> 4, i = rho & 15; return 8 * (i >> 2) + 4 * n + (i & 3); }

struct Unit { int pm, pn; };
struct Gemm { const bf16_t* A; const bf16_t* Bt; int M, N, K; };

struct StaticOrder {
    int nM, nN, nwg, G, c;
    __host__ __device__ void init(int M, int N, int G_, int c_) { nM = M / BM; nN = N / BM; nwg = nM * nN; G = G_; c = c_; }
    __host__ __device__ bool next(int i, Unit& u) const {
        const long L = (long)i * G + c; if (L >= nwg) return false;
        int wgid = (int)L; { const int q = nwg / NXCD, r = nwg % NXCD, xcd = wgid % NXCD, off = wgid / NXCD; wgid = (xcd < r ? xcd * (q + 1) : r * (q + 1) + (xcd - r) * q) + off; }
        const int nig = WGM * nN, gid = wgid / nig, fm = gid * WGM, gsz = (nM - fm) < WGM ? (nM - fm) : WGM;
        u.pm = fm + ((wgid % nig) % gsz); u.pn = (wgid % nig) / gsz; return true;
    }
    __device__ __forceinline__ void a_ready(const Unit&) const {}
    __device__ __forceinline__ void done(const Unit&) const {}
};

template <class Epi, class Sched, bool ALIGN_EPI = false, bool SP2 = false, bool ROWPERM = false>
__device__ __forceinline__ void gemm_phase(PG8_LAS unsigned char* lds, const Gemm g, const Sched& S, const Epi& E, const int wv) {
    const int tid = opaque_tid(wv), wid = __builtin_amdgcn_readfirstlane(tid >> 6), lane = tid & 63, wr = wid >> 2, wc = wid & 3, fr = lane & 15, fq = lane >> 4;
    const int K = g.K, nt = K / BK;
    unsigned voffA[2], voffB[2];
#pragma unroll
    for (int i = 0; i < 2; ++i) { int R, C; stage_rc(tid * 16 + i * 8192, R, C); const int Rb = Epi::PERM ? ((R & ~31) + perm32(R & 31)) : R;
        const int Ra = ROWPERM ? (128 * (R >> 6) + 8 * (R & 15) + ((R >> 4) & 3)) : R;
        voffA[i] = (unsigned)(Ra * K + C) * 2u; voffB[i] = (unsigned)(Rb * K + C) * 2u; }
    const size_t kstep = (size_t)(BK * 2);
    const size_t hstep = (size_t)HALF * K * 2;
    const size_t tstep = 2 * hstep; const size_t hstepA = ROWPERM ? (size_t)4 * K * 2 : hstep;
    const unsigned ldsw = (unsigned)wid * 1024u;
    const int aoff = lds_byte(wr * 64 + fr, fq * 8), boff = lds_byte(wc * 32 + fr, fq * 8);
#define PG8_SA(b, h) (((b) * 2 + (h)) * HTB)
#define PG8_SB(b, h) ((4 + (b) * 2 + (h)) * HTB)
#define PG8_STAGE(bufoff, gbase, voff) do { _Pragma("unroll") for (int _i = 0; _i < 2; ++_i) \
        __builtin_amdgcn_global_load_lds((const unsigned*)((const char*)(gbase) + (voff)[_i]), (PG8_LAS unsigned*)(lds + (bufoff) + ldsw + _i * 8192), 16, 0, 0); } while (0)
#define PG8_LDA(dst, b, h) do { _Pragma("unroll") for (int m = 0; m < 4; ++m) _Pragma("unroll") for (int k = 0; k < 2; ++k) dst[m][k] = *(const PG8_LAS bf16x8*)(lds + PG8_SA(b, h) + aoff + m * 2048 + k * 1024); } while (0)
#define PG8_LDB(dst, b, h) do { _Pragma("unroll") for (int n = 0; n < 2; ++n) _Pragma("unroll") for (int k = 0; k < 2; ++k) dst[n][k] = *(const PG8_LAS bf16x8*)(lds + PG8_SB(b, h) + boff + n * 2048 + k * 1024); } while (0)
#define PG8_MMA(ai, bj, At, Bt) do { __builtin_amdgcn_s_setprio(1); _Pragma("unroll") for (int m = 0; m < 4; ++m) _Pragma("unroll") for (int n = 0; n < 2; ++n) _Pragma("unroll") for (int k = 0; k < 2; ++k) \
        acc[ai][bj][m][n] = __builtin_amdgcn_mfma_f32_16x16x32_bf16(Bt[n][k], At[m][k], acc[ai][bj][m][n], 0, 0, 0); __builtin_amdgcn_s_setprio(0); } while (0)
#define PG8_WAIT_V(n) asm volatile("s_waitcnt vmcnt(" #n ")" ::: "memory")
#define PG8_WAIT_L(n) asm volatile("s_waitcnt lgkmcnt(" #n ")" ::: "memory")
#define PG8_BAR __builtin_amdgcn_s_barrier()
#define PG8_SCHED __builtin_amdgcn_sched_barrier(0)
    Unit cur, nxt; int ui = 0;
    if (!S.next(0, cur)) return;
    f32x4 acc[2][2][4][2];
#pragma unroll
    for (int a = 0; a < 2; ++a)
#pragma unroll
        for (int b = 0; b < 2; ++b)
#pragma unroll
            for (int m = 0; m < 4; ++m)
#pragma unroll
                for (int n = 0; n < 2; ++n) acc[a][b][m][n] = (f32x4){0.f, 0.f, 0.f, 0.f};
    bf16x8 At[4][2], B0[2][2], B1[2][2];
    const char* cA = (const char*)g.A + (size_t)cur.pm * tstep; const char* cB = (const char*)g.Bt + (size_t)cur.pn * tstep;
    S.a_ready(cur);
    if constexpr (SP2) {
        PG8_STAGE(PG8_SB(0, 0), cB, voffB); PG8_STAGE(PG8_SB(0, 1), cB + hstep, voffB); PG8_STAGE(PG8_SA(0, 0), cA, voffA); PG8_STAGE(PG8_SA(0, 1), cA + hstepA, voffA);
        if (wr == 1) PG8_BAR;
        PG8_WAIT_V(2); PG8_BAR;
        PG8_STAGE(PG8_SB(1, 0), cB + kstep, voffB); PG8_STAGE(PG8_SA(1, 0), cA + kstep, voffA); PG8_STAGE(PG8_SB(1, 1), cB + hstep + kstep, voffB);
        PG8_WAIT_V(6); PG8_BAR;
    } else {
        PG8_STAGE(PG8_SB(0, 0), cB, voffB); PG8_STAGE(PG8_SA(0, 0), cA, voffA); PG8_STAGE(PG8_SB(0, 1), cB + hstep, voffB); PG8_STAGE(PG8_SA(0, 1), cA + hstepA, voffA);
        if (wr == 1) PG8_BAR;
        PG8_WAIT_V(4); PG8_BAR;
        PG8_STAGE(PG8_SB(1, 0), cB + kstep, voffB); PG8_STAGE(PG8_SA(1, 0), cA + kstep, voffA); PG8_STAGE(PG8_SB(1, 1), cB + hstep + kstep, voffB);
        PG8_WAIT_V(6); PG8_BAR;
    }
    for (;;) {
        const bool has_next = S.next(ui + 1, nxt);
        const char* nA = has_next ? (const char*)g.A + (size_t)nxt.pm * tstep : cA; const char* nB = has_next ? (const char*)g.Bt + (size_t)nxt.pn * tstep : cB;
        for (int t = 0; t < nt; t += 2) {
            const bool last = (t == nt - 2);
            const char* a1 = cA + (size_t)(t + 1) * kstep;
            const char* a2 = last ? nA : cA + (size_t)(t + 2) * kstep; const char* b2 = last ? nB : cB + (size_t)(t + 2) * kstep;
            const char* a3 = a2 + kstep; const char* b3 = b2 + kstep;
            if (last && has_next) S.a_ready(nxt);
            if constexpr (SP2) {
            PG8_LDB(B0, 0, 0); PG8_LDB(B1, 0, 1); PG8_SCHED; PG8_LDA(At, 0, 0); PG8_STAGE(PG8_SA(1, 1), a1 + hstepA, voffA);
            PG8_WAIT_V(8); PG8_WAIT_L(0); PG8_BAR; PG8_MMA(0, 0, At, B0); PG8_MMA(0, 1, At, B1); PG8_BAR; PG8_SCHED;
            PG8_LDA(At, 0, 1); PG8_STAGE(PG8_SB(0, 0), b2, voffB); PG8_STAGE(PG8_SB(0, 1), b2 + hstep, voffB); PG8_STAGE(PG8_SA(0, 0), a2, voffA);
            PG8_WAIT_V(8); PG8_WAIT_L(0); PG8_BAR; PG8_MMA(1, 0, At, B0); PG8_MMA(1, 1, At, B1); PG8_BAR; PG8_SCHED;
            PG8_LDB(B0, 1, 0); PG8_LDB(B1, 1, 1); PG8_SCHED; PG8_LDA(At, 1, 0); PG8_STAGE(PG8_SA(0, 1), a2 + hstepA, voffA);
            PG8_WAIT_V(8); PG8_WAIT_L(0); PG8_BAR; PG8_MMA(0, 0, At, B0); PG8_MMA(0, 1, At, B1); PG8_BAR; PG8_SCHED;
            PG8_LDA(At, 1, 1); PG8_STAGE(PG8_SB(1, 0), b3, voffB); PG8_STAGE(PG8_SB(1, 1), b3 + hstep, voffB); PG8_STAGE(PG8_SA(1, 0), a3, voffA);
            PG8_WAIT_V(8); PG8_WAIT_L(0); PG8_BAR; PG8_MMA(1, 0, At, B0); PG8_MMA(1, 1, At, B1); PG8_BAR; PG8_SCHED;
            } else {
            PG8_LDB(B0, 0, 0); PG8_SCHED; PG8_LDA(At, 0, 0); PG8_STAGE(PG8_SA(1, 1), a1 + hstepA, voffA);
            PG8_WAIT_L(8); PG8_BAR; PG8_WAIT_L(0); PG8_MMA(0, 0, At, B0); PG8_BAR; PG8_SCHED;
            PG8_LDB(B1, 0, 1); PG8_STAGE(PG8_SB(0, 0), b2, voffB);
            PG8_BAR; PG8_WAIT_L(0); PG8_MMA(0, 1, At, B1); PG8_BAR;
            PG8_LDA(At, 0, 1); PG8_STAGE(PG8_SA(0, 0), a2, voffA);
            PG8_BAR; PG8_WAIT_L(0); PG8_MMA(1, 0, At, B0); PG8_BAR; PG8_SCHED;
            PG8_STAGE(PG8_SB(0, 1), b2 + hstep, voffB);
            PG8_WAIT_V(6); PG8_BAR; PG8_MMA(1, 1, At, B1); PG8_BAR;
            PG8_LDB(B0, 1, 0); PG8_SCHED; PG8_LDA(At, 1, 0); PG8_STAGE(PG8_SA(0, 1), a2 + hstepA, voffA);
            PG8_WAIT_L(8); PG8_BAR; PG8_WAIT_L(0); PG8_MMA(0, 0, At, B0); PG8_BAR; PG8_SCHED;
            PG8_LDB(B1, 1, 1); PG8_STAGE(PG8_SB(1, 0), b3, voffB);
            PG8_BAR; PG8_WAIT_L(0); PG8_MMA(0, 1, At, B1); PG8_BAR;
            PG8_LDA(At, 1, 1); PG8_STAGE(PG8_SA(1, 0), a3, voffA);
            PG8_BAR; PG8_WAIT_L(0); PG8_MMA(1, 0, At, B0); PG8_BAR; PG8_SCHED;
            PG8_STAGE(PG8_SB(1, 1), b3 + hstep, voffB);
            PG8_WAIT_V(6); PG8_BAR; PG8_MMA(1, 1, At, B1); PG8_BAR;
            }
        }
        if constexpr (ALIGN_EPI) { if (wr == 0) PG8_BAR; }
        if constexpr (!Epi::AFTER_DRAIN) { E(acc, cur, wr, wc, fr, fq); S.done(cur); }
        if (!has_next) break;
#pragma unroll
        for (int a = 0; a < 2; ++a)
#pragma unroll
            for (int b = 0; b < 2; ++b)
#pragma unroll
                for (int m = 0; m < 4; ++m)
#pragma unroll
                    for (int n = 0; n < 2; ++n) acc[a][b][m][n] = (f32x4){0.f, 0.f, 0.f, 0.f};
        cur = nxt; cA = nA; cB = nB; ++ui;
        if constexpr (ALIGN_EPI) { if (wr == 1) PG8_BAR; }
    }
    PG8_WAIT_V(0);
    if constexpr (!ALIGN_EPI) { if (wr == 0) PG8_BAR; }
    PG8_BAR;
    if constexpr (Epi::AFTER_DRAIN) { E.fused(acc, cur, wr, wc, fr, fq, lds, wid, lane); S.done(cur); }
#undef PG8_SA
#undef PG8_SB
#undef PG8_STAGE
#undef PG8_LDA
#undef PG8_LDB
#undef PG8_MMA
#undef PG8_WAIT_V
#undef PG8_WAIT_L
#undef PG8_BAR
#undef PG8_SCHED
}
}
typedef pg8::bf16_t bf16_t;
typedef pg8::bf16x8 bf16x8;
typedef pg8::f32x4 f32x4;
typedef pg8::u32x4 u32x4;
typedef unsigned u32x2 __attribute__((ext_vector_type(2)));
#define LAS __attribute__((address_space(3)))

constexpr int DM = 1024, NB = 4, SEQ = 8192, MTOK = NB * SEQ, DIN = 7168, DFF = 3072, DFF2 = 6144, NL = 2;
constexpr int NTH = 512;
constexpr float EPS = 1e-6f;
constexpr int RT = 128, NT = SEQ / RT;
constexpr size_t WS_BAR = 0;
constexpr size_t WS_MOD = 16384;
constexpr size_t WS_GW = WS_MOD + (size_t)NL * NB * 6144 * 4;
constexpr size_t WS_SUM = WS_GW + (size_t)NL * 2 * 8 * 128 * 128 * 2;
constexpr size_t WS_HIN = WS_SUM + (size_t)NB * NT * 1024 * 2 * 4;
constexpr size_t WS_W = (WS_HIN + (size_t)NB * NT * 1024 * 4 + 4095) / 4096 * 4096;
constexpr size_t W_IN_E = (size_t)DIN * DM, W_OUT_E = (size_t)DM * DM, W_UP_E = (size_t)DFF2 * DM, W_DN_E = (size_t)DM * DFF, W_LAYER_E = W_IN_E + W_OUT_E + W_UP_E + W_DN_E;
constexpr size_t WS_XN = WS_W + NL * W_LAYER_E * 2;
constexpr size_t PBUF = (size_t)MTOK * DM * 2;
constexpr size_t WS_P = WS_XN + PBUF;
constexpr size_t WS_END = WS_P + 5 * PBUF;
constexpr size_t ACT_BYTES = (size_t)MTOK * DFF * 2;

__device__ __forceinline__ float bf2f(bf16_t b) { return __uint_as_float(((unsigned)b) << 16); }
__device__ __forceinline__ unsigned pk2(float lo, float hi) { unsigned r; asm volatile("v_cvt_pk_bf16_f32 %0, %1, %2" : "=v"(r) : "v"(lo), "v"(hi)); return r; }
__device__ __forceinline__ float bflo(unsigned w) { return __uint_as_float(w << 16); }
__device__ __forceinline__ float bfhi(unsigned w) { return __uint_as_float(w & 0xffff0000u); }
__device__ __forceinline__ float lane_get(float x, int srclane) { return __builtin_bit_cast(float, __builtin_amdgcn_ds_bpermute(srclane << 2, __builtin_bit_cast(int, x))); }
__device__ __forceinline__ float sigmoidf_(float x) { return __builtin_amdgcn_rcpf(1.0f + __expf(-x)); }
__device__ __forceinline__ float gelu_tanh(float x) { const float u = 1.5957691216057308f * (x + 0.044715f * x * x * x); return x * sigmoidf_(u); }

struct EpiSplit {
    static constexpr bool PERM = true, AFTER_DRAIN = false;
    bf16_t* base; size_t tstride; int modes; int skip3;
    __device__ __forceinline__ void operator()(const f32x4 (&acc)[2][2][4][2], const pg8::Unit& u, int wr, int wc, int fr, int fq) const {
        const int colt = u.pn * 256, t = colt >> 10; const int mode = (modes >> (4 * t)) & 15;
        bf16_t* o = base + (size_t)(t + ((skip3 && t == 3) ? 1 : 0)) * tstride; const int col0 = (colt & 1023) + wc * 32 + 8 * fq; const int row0 = u.pm * 256 + wr * 64 + fr;
#pragma unroll
        for (int ai = 0; ai < 2; ++ai)
#pragma unroll
            for (int m = 0; m < 4; ++m) { bf16_t* rowp = o + (size_t)(row0 + ai * 128 + m * 16) * DM + col0;
#pragma unroll
                for (int bj = 0; bj < 2; ++bj) { f32x4 v0 = acc[ai][bj][m][0], v1 = acc[ai][bj][m][1];
                    if (mode == 1) {
#pragma unroll
                        for (int j = 0; j < 4; ++j) { v0[j] = gelu_tanh(v0[j]); v1[j] = gelu_tanh(v1[j]); } }
                    else if (mode == 2) {
#pragma unroll
                        for (int j = 0; j < 4; ++j) { v0[j] = sigmoidf_(v0[j]); v1[j] = sigmoidf_(v1[j]); } }
                    u32x4 w; w.x = pk2(v0[0], v0[1]); w.y = pk2(v0[2], v0[3]); w.z = pk2(v1[0], v1[1]); w.w = pk2(v1[2], v1[3]);
                    *(u32x4*)(rowp + bj * 128) = w; } }
    }
};
struct EpiPlain {
    static constexpr bool PERM = true, AFTER_DRAIN = false;
    bf16_t* o; int ldc;
    __device__ __forceinline__ void operator()(const f32x4 (&acc)[2][2][4][2], const pg8::Unit& u, int wr, int wc, int fr, int fq) const {
        const int col0 = u.pn * 256 + wc * 32 + 8 * fq; const int row0 = u.pm * 256 + wr * 64 + fr;
#pragma unroll
        for (int ai = 0; ai < 2; ++ai)
#pragma unroll
            for (int m = 0; m < 4; ++m) { bf16_t* rowp = o + (size_t)(row0 + ai * 128 + m * 16) * ldc + col0;
#pragma unroll
                for (int bj = 0; bj < 2; ++bj) { const f32x4 v0 = acc[ai][bj][m][0], v1 = acc[ai][bj][m][1];
                    u32x4 w; w.x = pk2(v0[0], v0[1]); w.y = pk2(v0[2], v0[3]); w.z = pk2(v1[0], v1[1]); w.w = pk2(v1[2], v1[3]);
                    *(u32x4*)(rowp + bj * 128) = w; } }
    }
};
struct EpiRes {
    static constexpr bool PERM = false, AFTER_DRAIN = false;
    const float* res; float* out; const float* gate  ; int row_off;
    __device__ __forceinline__ void operator()(const f32x4 (&acc)[2][2][4][2], const pg8::Unit& u, int wr, int wc, int fr, int fq) const {
        const int grow0 = row_off + u.pm * 256; const int b = grow0 / SEQ; const int row0 = grow0 + wr * 64 + fr, col0 = u.pn * 256 + wc * 32 + 4 * fq;
        f32x4 gv[2][2];
#pragma unroll
        for (int bj = 0; bj < 2; ++bj)
#pragma unroll
            for (int n = 0; n < 2; ++n) gv[bj][n] = *(const f32x4*)(gate + (size_t)b * 6144 + col0 + bj * 128 + n * 16);
#pragma unroll
        for (int ai = 0; ai < 2; ++ai)
#pragma unroll
            for (int m = 0; m < 4; ++m) { const size_t off = (size_t)(row0 + ai * 128 + m * 16) * DM + col0;
#pragma unroll
                for (int bj = 0; bj < 2; ++bj)
#pragma unroll
                    for (int n = 0; n < 2; ++n) { const f32x4 r = *(const f32x4*)(res + off + bj * 128 + n * 16); *(f32x4*)(out + off + bj * 128 + n * 16) = r + gv[bj][n] * acc[ai][bj][m][n]; }
                asm volatile("" ::: "memory"); }
    }
};


#define XB_TMO      128
#define XB_XCNT(j)  (256  + 64 * (j))
#define XB_XSUB(j)  (1280 + 64 * (j))
#define XB_XGEN(j)  (2304 + 64 * (j))
#define XB_TOP      3328
#define XB_TOPGEN   3392
#define XCD_BAR_WORDS 3456
#define XB_SPIN_CAP (1u << 22)
__device__ __forceinline__ unsigned xb_ld(unsigned* p)              { return __hip_atomic_load(p, __ATOMIC_RELAXED, __HIP_MEMORY_SCOPE_AGENT); }
__device__ __forceinline__ unsigned xb_add(unsigned* p, unsigned v) { return __hip_atomic_fetch_add(p, v, __ATOMIC_RELAXED, __HIP_MEMORY_SCOPE_AGENT); }
__device__ __forceinline__ unsigned xb_xcc_id() { return (unsigned)__builtin_amdgcn_s_getreg((3 << 11) | 20) & 0xFu; }
#define XB_SPIN(cond, bar) do { unsigned _sp = 0; while (cond) { __builtin_amdgcn_s_sleep(1); \
    if ((++_sp & 255u) == 0u) { if (xb_ld(&(bar)[XB_TMO])) break; if (_sp > XB_SPIN_CAP) { atomicAdd(&(bar)[XB_TMO], 1u); break; } } } } while (0)
struct XcdBarrier { unsigned* bar; unsigned x; volatile LAS unsigned* st; };
__device__ __forceinline__ XcdBarrier xcd_barrier_post(unsigned* bar, volatile LAS unsigned* st) {
    XcdBarrier b; b.bar = bar; b.x = xb_xcc_id(); b.st = st;
    if (threadIdx.x == 0) (void)xb_add(&bar[XB_XCNT(b.x)], 1u);
    return b;
}
__device__ __forceinline__ void xcd_barrier_complete(unsigned* bar, unsigned x, unsigned& nloc, unsigned& nx) {
    const unsigned G = gridDim.x * gridDim.y * gridDim.z;
    unsigned sum, cnt, mine, sp = 0u;
    for (;;) {
        sum = 0u; cnt = 0u; mine = 0u;
#pragma unroll
        for (unsigned j = 0; j < 16; ++j) { const unsigned c = xb_ld(&bar[XB_XCNT(j)]); sum += c; cnt += (c > 0u) ? 1u : 0u; mine = (j == x) ? c : mine; }
        if (sum == G) break;
        __builtin_amdgcn_s_sleep(1);
        if ((++sp & 255u) == 0u) { if (xb_ld(&bar[XB_TMO])) break; if (sp > XB_SPIN_CAP) { atomicAdd(&bar[XB_TMO], 1u); break; } }
    }
    nloc = mine > 0u ? mine : 1u; nx = cnt > 0u ? cnt : 1u;
}
__device__ __forceinline__ void xcd_barrier(const XcdBarrier& b, const int wv) {
    asm volatile("s_waitcnt vmcnt(0)" ::: "memory");
    __syncthreads();
    if (opaque_tid(wv) == 0) {
        unsigned* bar = b.bar;
        __builtin_amdgcn_s_waitcnt(0);
        unsigned nloc = b.st[0], nx = b.st[1];
        if (nloc == 0u) { xcd_barrier_complete(bar, b.x, nloc, nx); b.st[0] = nloc; b.st[1] = nx; }
        const unsigned old = xb_add(&bar[XB_XSUB(b.x)], 1u);
        const unsigned gen = old / nloc;
        if (old + 1u == (gen + 1u) * nloc) {
            __builtin_amdgcn_fence(__ATOMIC_RELEASE, "agent");
            asm volatile("s_waitcnt vmcnt(0)" ::: "memory");
            const unsigned og = xb_add(&bar[XB_TOP], 1u);
            const unsigned tg = og / nx;
            if (og + 1u == (tg + 1u) * nx) xb_add(&bar[XB_TOPGEN], 1u);
            else XB_SPIN(xb_ld(&bar[XB_TOPGEN]) == tg, bar);
            __builtin_amdgcn_fence(__ATOMIC_ACQUIRE, "agent");
            xb_add(&bar[XB_XGEN(b.x)], 1u);
            asm volatile("s_waitcnt vmcnt(0)" ::: "memory");
        } else {
            XB_SPIN(xb_ld(&bar[XB_XGEN(b.x)]) == gen, bar);
            __builtin_amdgcn_fence(__ATOMIC_ACQUIRE, "agent");
            asm volatile("s_waitcnt vmcnt(0)" ::: "memory");
        }
    }
    __syncthreads();
}

__device__ __forceinline__ float dpp_shr1(float x) { return __builtin_bit_cast(float, __builtin_amdgcn_update_dpp(0, __builtin_bit_cast(int, x), 0x111, 0xf, 0xf, false)); }
struct EpiConvAct {
    static constexpr bool PERM = true, AFTER_DRAIN = false;
    bf16_t* act; bf16_t* halo; const float* cw; const float* cb;
    __device__ __forceinline__ void operator()(const f32x4 (&acc)[2][2][4][2], const pg8::Unit& u, int wr, int wc, int fr, int fq) const {
        const int tb = u.pm * 256 + 128 * wr, c0 = u.pn * 128 + wc * 32 + 8 * fq;
        bf16_t* hp = halo + (size_t)(tb >> 7) * 4 * DFF2;
#pragma unroll
        for (int n = 0; n < 2; ++n) {
            const int c = c0 + 4 * n;
            const f32x4 bg = *(const f32x4*)(cb + c), bv = *(const f32x4*)(cb + DFF + c);
            const f32x4 wg0 = *(const f32x4*)(cw + c), wg1 = *(const f32x4*)(cw + DFF2 + c), wg2 = *(const f32x4*)(cw + 2 * DFF2 + c);
            const f32x4 wv0 = *(const f32x4*)(cw + DFF + c), wv1 = *(const f32x4*)(cw + DFF2 + DFF + c), wv2 = *(const f32x4*)(cw + 2 * DFF2 + DFF + c);
            f32x4 pg6, pg7, pv6, pv7;
#pragma unroll
            for (int j = 0; j < 4; ++j) { pg6[j] = dpp_shr1(acc[1][0][2][n][j]); pg7[j] = dpp_shr1(acc[1][0][3][n][j]); pv6[j] = dpp_shr1(acc[1][1][2][n][j]); pv7[j] = dpp_shr1(acc[1][1][3][n][j]); }
#pragma unroll
            for (int q = 0; q < 8; ++q) {
                const f32x4 g = acc[q >> 2][0][q & 3][n], v = acc[q >> 2][1][q & 3][n];
                const f32x4 g1 = q >= 1 ? acc[(q - 1 + 8) % 8 >> 2][0][(q - 1 + 8) % 8 & 3][n] : pg7, g2 = q >= 2 ? acc[(q - 2 + 8) % 8 >> 2][0][(q - 2 + 8) % 8 & 3][n] : (q == 1 ? pg7 : pg6);
                const f32x4 v1 = q >= 1 ? acc[(q - 1 + 8) % 8 >> 2][1][(q - 1 + 8) % 8 & 3][n] : pv7, v2 = q >= 2 ? acc[(q - 2 + 8) % 8 >> 2][1][(q - 2 + 8) % 8 & 3][n] : (q == 1 ? pv7 : pv6);
                const f32x4 g1e = q == 0 ? pg7 : g1, g2e = q == 0 ? pg6 : g2, v1e = q == 0 ? pv7 : v1, v2e = q == 0 ? pv6 : v2;
                float o[4];
#pragma unroll
                for (int j = 0; j < 4; ++j) { const float cg = bg[j] + wg0[j] * g2e[j] + wg1[j] * g1e[j] + wg2[j] * g[j]; const float cv = bv[j] + wv0[j] * v2e[j] + wv1[j] * v1e[j] + wv2[j] * v[j]; o[j] = gelu_tanh(cg) * cv; }
                if (fr > 0 || q >= 2) { u32x2 w; w.x = pk2(o[0], o[1]); w.y = pk2(o[2], o[3]); *(u32x2*)(act + (size_t)(tb + 8 * fr + q) * DFF + c) = w; }
                if ((fr == 0 && q < 2) || (fr == 15 && q >= 6)) { const int r = q < 2 ? q : q - 4; u32x2 wgp, wvp; wgp.x = pk2(g[0], g[1]); wgp.y = pk2(g[2], g[3]); wvp.x = pk2(v[0], v[1]); wvp.y = pk2(v[2], v[3]);
                    *(u32x2*)(hp + (size_t)r * DFF2 + c) = wgp; *(u32x2*)(hp + (size_t)r * DFF2 + DFF + c) = wvp; }
            }
        }
    }
};

struct Args { const float* in[21]; float* out; unsigned char* ws; };
typedef const __attribute__((address_space(4))) Args* ArgsP;

__device__ void p0_mod(ArgsP a, LAS unsigned char* lds, const int wv) {
    const int tid = opaque_tid(wv), w = tid >> 6, lane = tid & 63;
    const float* c = a->in[1]; const float* aw = a->in[2]; const float* ab = a->in[3]; float* mod = (float*)(a->ws + WS_MOD);
    LAS float* red = (LAS float*)lds;
    for (int grp = blockIdx.x; grp < NL * 6144 / 48; grp += gridDim.x) {
        const int gl = grp * 48 + (lane < 48 ? lane : 47), l = gl / 6144, j = gl % 6144;
        const float* wp = aw + (size_t)l * DM * 6144 + j;
        float s0 = 0.f, s1 = 0.f, s2 = 0.f, s3 = 0.f;
#pragma unroll 16
        for (int k = w * 128; k < w * 128 + 128; ++k) { const float wv = wp[(size_t)k * 6144]; s0 += c[k] * wv; s1 += c[DM + k] * wv; s2 += c[2 * DM + k] * wv; s3 += c[3 * DM + k] * wv; }
        red[(w * 4 + 0) * 64 + lane] = s0; red[(w * 4 + 1) * 64 + lane] = s1; red[(w * 4 + 2) * 64 + lane] = s2; red[(w * 4 + 3) * 64 + lane] = s3;
        __syncthreads();
        if (tid < 256 && lane < 48) { const int b = tid >> 6; float s = ab[(size_t)l * 6144 + j];
#pragma unroll
            for (int ww = 0; ww < 8; ++ww) s += red[(ww * 4 + b) * 64 + lane];
            mod[((size_t)l * NB + b) * 6144 + j] = s; }
        __syncthreads();
    }
    bf16_t* gw = (bf16_t*)(a->ws + WS_GW);
    for (size_t idx = (size_t)blockIdx.x * NTH + tid; idx < (size_t)NL * 2 * 8 * 128 * 128; idx += (size_t)gridDim.x * NTH) {
        const int i = idx & 127, j = (idx >> 7) & 127, h = (idx >> 14) & 7, mat = (idx >> 17) & 1, l = (int)(idx >> 18);
        const float* src = a->in[mat ? 10 : 8];
        const float v = src[(((size_t)l * 8 + h) * 128 + i) * 128 + j];
        gw[idx] = (bf16_t)(pk2(v, v) & 0xffff);
    }
}
struct TMat { const float* W; bf16_t* Wt; int K, N, rmode, ntn; };
__device__ __forceinline__ TMat tmat_of(ArgsP a, int mi) {
    const int l = mi >> 2, k = mi & 3; bf16_t* wl = (bf16_t*)(a->ws + WS_W) + (size_t)l * W_LAYER_E; TMat m;
    if (k == 0) { m.W = a->in[5] + (size_t)l * DM * DIN; m.Wt = wl; m.K = DM; m.N = DIN; m.rmode = 1; }
    else if (k == 1) { m.W = a->in[15] + (size_t)l * DM * DM; m.Wt = wl + W_IN_E; m.K = DM; m.N = DM; m.rmode = 0; }
    else if (k == 2) { m.W = a->in[17] + (size_t)l * DM * DFF2; m.Wt = wl + W_IN_E + W_OUT_E; m.K = DM; m.N = DFF2; m.rmode = 2; }
    else { m.W = a->in[20] + (size_t)l * DFF * DM; m.Wt = wl + W_IN_E + W_OUT_E + W_UP_E; m.K = DFF; m.N = DM; m.rmode = 0; }
    m.ntn = m.N / 64; return m;
}
constexpr int TILES_IN = (DM / 64) * (DIN / 64), TILES_OUT = (DM / 64) * (DM / 64), TILES_UP = (DM / 64) * (DFF2 / 64), TILES_DN = (DFF / 64) * (DM / 64), TILES_L = TILES_IN + TILES_OUT + TILES_UP + TILES_DN;
__device__ __forceinline__ void tile_of(int g, int& mi, int& tile) {
    const int l = g / TILES_L; int r = g - l * TILES_L; int k = 0;
    if (r >= TILES_IN) { r -= TILES_IN; k = 1; if (r >= TILES_OUT) { r -= TILES_OUT; k = 2; if (r >= TILES_UP) { r -= TILES_UP; k = 3; } } }
    mi = l * 4 + k; tile = r;
}
__device__ void p0_weights(ArgsP a, LAS unsigned char* lds, const int wv) {
    const int tid = opaque_tid(wv), w = __builtin_amdgcn_readfirstlane(tid >> 6), lane = tid & 63;
    LAS float* t = (LAS float*)(lds + w * (64 * 68 * 4));
    const int NWV = gridDim.x * 8;
    for (int g = w * (int)gridDim.x + (int)blockIdx.x; g < NL * TILES_L; g += NWV) {
        int mi, tile; tile_of(g, mi, tile); const TMat m = tmat_of(a, mi);
        const int k0 = (tile / m.ntn) * 64, n0 = (tile % m.ntn) * 64;
        const float* p = m.W + (size_t)(k0 + (lane >> 4)) * m.N + n0 + (lane & 15) * 4;
        f32x4 v[16];
#pragma unroll
        for (int i = 0; i < 16; ++i) v[i] = *(const f32x4*)(p + (size_t)(4 * i) * m.N);
#pragma unroll
        for (int i = 0; i < 16; ++i) *(LAS f32x4*)(t + (4 * i + (lane >> 4)) * 68 + (lane & 15) * 4) = v[i];
        int nr = n0 + lane; if (m.rmode == 1) nr = nr < 2048 ? nr : (nr < 5120 ? nr + 2048 : nr - 3072);
        else if (m.rmode == 2) nr = nr < DFF ? ((nr >> 7) * 256 + (nr & 127)) : (((nr - DFF) >> 7) * 256 + 128 + ((nr - DFF) & 127));
        bf16_t* op = m.Wt + (size_t)nr * m.K + k0;
#pragma unroll
        for (int pz = 0; pz < 8; ++pz) { float x[8];
#pragma unroll
            for (int e = 0; e < 8; ++e) x[e] = t[(pz * 8 + e) * 68 + lane];
            u32x4 o; o.x = pk2(x[0], x[1]); o.y = pk2(x[2], x[3]); o.z = pk2(x[4], x[5]); o.w = pk2(x[6], x[7]);
            *(u32x4*)(op + pz * 8) = o; }
    }
}
__device__ void norm_phase(const float* __restrict__ x, const float* __restrict__ g, const float* __restrict__ modl  , int shk, int sck, bf16_t* __restrict__ xn, const int wv) {
    const int tid = opaque_tid(wv); const int w = tid >> 6, lane = tid & 63;
    for (int row = blockIdx.x * 8 + w; row < MTOK; row += gridDim.x * 8) {
        const int b = row / SEQ; const float* xr = x + (size_t)row * DM; f32x4 v[4]; float ss = 0.f;
#pragma unroll
        for (int i = 0; i < 4; ++i) { v[i] = *(const f32x4*)(xr + lane * 4 + 256 * i); ss += v[i][0] * v[i][0] + v[i][1] * v[i][1] + v[i][2] * v[i][2] + v[i][3] * v[i][3]; }
#pragma unroll
        for (int o = 32; o >= 1; o >>= 1) ss += lane_get(ss, lane ^ o);
        const float rstd = rsqrtf(ss * (1.0f / DM) + EPS);
        const float* sh = modl + (size_t)b * 6144 + shk * 1024; const float* sc = modl + (size_t)b * 6144 + sck * 1024;
#pragma unroll
        for (int i = 0; i < 4; ++i) { const int c = lane * 4 + 256 * i; const f32x4 gg = *(const f32x4*)(g + c), s1 = *(const f32x4*)(sc + c), s0 = *(const f32x4*)(sh + c);
            f32x4 y;
#pragma unroll
            for (int j = 0; j < 4; ++j) y[j] = v[i][j] * rstd * gg[j] * (1.0f + s1[j]) + s0[j];
            u32x2 o; o.x = pk2(y[0], y[1]); o.y = pk2(y[2], y[3]); *(u32x2*)(xn + (size_t)row * DM + c) = o; }
    }
}
constexpr int KP = 272, VP = 136;
constexpr int ASLOT = 64 * KP + 128 * VP;
constexpr float DEAD = 1e-30f;
typedef float f32x2 __attribute__((ext_vector_type(2)));
template <bool DIAG>
__device__ __forceinline__ void sb_weights(const f32x4 (&S)[4], float& carry, unsigned (&pw)[4][2], int q, int key0, int fq, int lane) {
    {
        f32x2 w01[4], w23[4]; float T[4], ab[4];
#pragma unroll
        for (int nb = 0; nb < 4; ++nb) {
            float E[4], be[4];
#pragma unroll
            for (int e = 0; e < 4; ++e) E[e] = __builtin_amdgcn_exp2f(-__builtin_amdgcn_fmed3f(S[nb][e], -115.f, 115.f));
            const f32x2 d01 = (f32x2){E[0], E[1]} + 1.0f, d23 = (f32x2){E[2], E[3]} + 1.0f;
            be[0] = __builtin_amdgcn_rcpf(d01.x); be[1] = __builtin_amdgcn_rcpf(d01.y); be[2] = __builtin_amdgcn_rcpf(d23.x); be[3] = __builtin_amdgcn_rcpf(d23.y);
            f32x2 b01 = (f32x2){be[0], be[1]}, b23 = (f32x2){be[2], be[3]};
            f32x2 o01 = (f32x2){E[0], E[1]} * b01, o23 = (f32x2){E[2], E[3]} * b23;
            if (DIAG) { const int k = key0 + 16 * nb;
                const bool m0 = k + 0 < q, m1 = k + 1 < q, m2 = k + 2 < q, m3 = k + 3 < q;
                b01.x = m0 ? b01.x : 0.f; o01.x = m0 ? o01.x : 1.f; b01.y = m1 ? b01.y : 0.f; o01.y = m1 ? o01.y : 1.f; b23.x = m2 ? b23.x : 0.f; o23.x = m2 ? o23.x : 1.f; b23.y = m3 ? b23.y : 0.f; o23.y = m3 ? o23.y : 1.f; }
            const float s1 = o23.y * o23.x, s0 = s1 * o01.y, run = s0 * o01.x;
            w01[nb] = b01 * (f32x2){s0, s1}; w23[nb] = b23 * (f32x2){o23.y, 1.0f};
            const float g1 = lane_get(run, lane ^ 16), g2 = lane_get(run, lane ^ 32), g3 = lane_get(g1, lane ^ 32);
            const float g23 = g2 * g3; T[nb] = (run * g1) * g23; ab[nb] = fq == 0 ? (g1 * g23) : fq == 1 ? g23 : fq == 2 ? g1 : 1.f; }
        float hi = carry;
#pragma unroll
        for (int nb = 3; nb >= 0; --nb) { const float base = hi * ab[nb]; const f32x2 p01 = w01[nb] * base, p23 = w23[nb] * base;
            pw[nb][0] = pk2(p01.x, p01.y); pw[nb][1] = pk2(p23.x, p23.y); hi *= T[nb]; }
        carry = hi;
    }
}
__device__ __forceinline__ void attn_stage(LAS unsigned char* Ks, LAS unsigned char* Vt, const u32x4 (&kr)[2], const u32x4 (&vr)[2], const float (&gks)[8], int sp, int skp, int lane) {
#pragma unroll
    for (int i = 0; i < 2; ++i) { float x[8]; float ss = 0.f;
#pragma unroll
        for (int j = 0; j < 4; ++j) { x[2 * j] = bflo(kr[i][j]); x[2 * j + 1] = bfhi(kr[i][j]); ss += x[2 * j] * x[2 * j] + x[2 * j + 1] * x[2 * j + 1]; }
        ss += lane_get(ss, lane ^ 1); ss += lane_get(ss, lane ^ 2); ss += lane_get(ss, lane ^ 4); ss += lane_get(ss, lane ^ 8);
        const float rs = rsqrtf(ss * (1.0f / 128.0f) + EPS);
        u32x4 o;
#pragma unroll
        for (int j = 0; j < 4; ++j) o[j] = pk2(x[2 * j] * rs * gks[2 * j], x[2 * j + 1] * rs * gks[2 * j + 1]);
        *(LAS u32x4*)(Ks + (2 * skp + i) * KP + sp * 16) = o; }
    const int wsz = skp ^ (sp & 14);
#pragma unroll
    for (int j = 0; j < 4; ++j) { *(LAS unsigned*)(Vt + (sp * 8 + 2 * j) * VP + wsz * 4) = (vr[0][j] & 0xffffu) | (vr[1][j] << 16); *(LAS unsigned*)(Vt + (sp * 8 + 2 * j + 1) * VP + wsz * 4) = (vr[0][j] >> 16) | (vr[1][j] & 0xffff0000u); }
}
__device__ void attn_phase(ArgsP a, int l, LAS unsigned char* lds, const int wv) {
    const int tid = opaque_tid(wv), w = __builtin_amdgcn_readfirstlane(tid >> 6), lane = tid & 63, fr = lane & 15, fq = lane >> 4;
    LAS int* flags = (LAS int*)(lds + 4 * ASLOT);
    const bf16_t* Qb = (const bf16_t*)(a->ws + WS_P); bf16_t* Yb = (bf16_t*)(a->ws + WS_P + 3 * PBUF); const bf16_t* Kb = (const bf16_t*)(a->ws + WS_P + PBUF); const bf16_t* Vb = (const bf16_t*)(a->ws + WS_P + 2 * PBUF);
    const float* gq = a->in[13] + l * 128; const float* gk = a->in[14] + l * 128;
    const int sp = tid & 15, skp = tid >> 4;
    float gks[8];
#pragma unroll
    for (int e = 0; e < 8; ++e) gks[e] = gk[sp * 8 + e] * gq[sp * 8 + e];
    const int nunits = NB * 8 * (SEQ / 256);
    for (int unit = blockIdx.x; unit < nunits; unit += gridDim.x) {
        const int qt = (SEQ / 256 - 1) - unit / (NB * 8), bh = unit % (NB * 8), b = bh >> 3, hh = bh & 7;
        const size_t rowbase = (size_t)b * SEQ; const int t0 = qt * 256, r0 = t0 + 32 * w;
        const int kbw = qt * 4 + (w >> 1);
        const bf16_t* kbase = Kb + rowbase * DM + hh * 128 + sp * 8; const bf16_t* vbase = Vb + rowbase * DM + hh * 128 + sp * 8;
        u32x4 kr[2], vr[2];
#pragma unroll
        for (int h2 = 0; h2 < 2; ++h2) { u32x4 k4[2][2], v4[2][2];
#pragma unroll
          for (int i4 = 0; i4 < 2; ++i4)
#pragma unroll
              for (int i = 0; i < 2; ++i) { const size_t ro = (size_t)((qt * 4 + 2 * h2 + i4) * 64 + 2 * skp + i) * DM; k4[i4][i] = *(const u32x4*)(kbase + ro); v4[i4][i] = *(const u32x4*)(vbase + ro); }
#pragma unroll
          for (int i4 = 0; i4 < 2; ++i4) attn_stage(lds + (2 * h2 + i4) * ASLOT, lds + (2 * h2 + i4) * ASLOT + 64 * KP, k4[i4], v4[i4], gks, sp, skp, lane); }
        bf16x8 qf[2][4];
#pragma unroll
        for (int rb = 0; rb < 2; ++rb) {
            const bf16_t* qp = Qb + (rowbase + r0 + 16 * rb + fr) * DM + hh * 128 + 8 * fq; u32x4 raw[4]; float ss = 0.f;
#pragma unroll
            for (int ks = 0; ks < 4; ++ks) { raw[ks] = *(const u32x4*)(qp + 32 * ks);
#pragma unroll
                for (int j = 0; j < 4; ++j) { const float x0 = bflo(raw[ks][j]), x1 = bfhi(raw[ks][j]); ss += x0 * x0 + x1 * x1; } }
            ss += lane_get(ss, lane ^ 16); ss += lane_get(ss, lane ^ 32);
            const float rs = rsqrtf(ss * (1.0f / 128.0f) + EPS) * (0.08838834764831845f * 1.4426950408889634f);
#pragma unroll
            for (int ks = 0; ks < 4; ++ks) { u32x4 o;
#pragma unroll
                for (int j = 0; j < 4; ++j) o[j] = pk2(bflo(raw[ks][j]) * rs, bfhi(raw[ks][j]) * rs);
                qf[rb][ks] = __builtin_bit_cast(bf16x8, o); }
        }
        f32x4 O[2][8];
#pragma unroll
        for (int rb = 0; rb < 2; ++rb)
#pragma unroll
            for (int db = 0; db < 8; ++db) O[rb][db] = (f32x4){0.f, 0.f, 0.f, 0.f};
        float carry[2] = {1.f, 1.f};
        bool alive = true;
        __syncthreads();
        for (int s_ = 0;; ++s_) {
            const int kb = kbw - s_, nbn = qt * 4 - s_ - 1;
            if (nbn >= 0) {
#pragma unroll
                for (int i = 0; i < 2; ++i) { const size_t ro = (size_t)(nbn * 64 + 2 * skp + i) * DM; kr[i] = *(const u32x4*)(kbase + ro); vr[i] = *(const u32x4*)(vbase + ro); } }
            if (alive && kb >= 0) {
                const LAS unsigned char* Ks = lds + (kb & 3) * ASLOT; const LAS unsigned char* Vt = Ks + 64 * KP;
                unsigned pw[2][4][2];
#pragma unroll
                for (int rb = 0; rb < 2; ++rb) {
                    f32x4 S[4];
#pragma unroll
                    for (int nb = 0; nb < 4; ++nb) { f32x4 sacc = (f32x4){0.f, 0.f, 0.f, 0.f};
#pragma unroll
                        for (int ks = 0; ks < 4; ++ks) { const bf16x8 kf = *(const LAS bf16x8*)(Ks + (16 * nb + fr) * KP + (32 * ks + 8 * fq) * 2); sacc = __builtin_amdgcn_mfma_f32_16x16x32_bf16(kf, qf[rb][ks], sacc, 0, 0, 0); }
                        S[nb] = sacc; }
                    if (s_ == 0) sb_weights<true>(S, carry[rb], pw[rb], r0 + 16 * rb + fr, kb * 64 + 4 * fq, fq, lane);
                    else sb_weights<false>(S, carry[rb], pw[rb], r0 + 16 * rb + fr, kb * 64 + 4 * fq, fq, lane);
                }
#pragma unroll
                for (int ks2 = 0; ks2 < 2; ++ks2) {
                    bf16x8 pf[2];
#pragma unroll
                    for (int rb = 0; rb < 2; ++rb) { u32x4 t; t.x = pw[rb][2 * ks2][0]; t.y = pw[rb][2 * ks2][1]; t.z = pw[rb][2 * ks2 + 1][0]; t.w = pw[rb][2 * ks2 + 1][1]; pf[rb] = __builtin_bit_cast(bf16x8, t); }
#pragma unroll
                    for (int db = 0; db < 8; ++db) { const LAS unsigned char* vrow = Vt + (16 * db + fr) * VP;
                        const u32x2 va = *(const LAS u32x2*)(vrow + 4 * ((16 * ks2 + 2 * fq) ^ (2 * db))), vb = *(const LAS u32x2*)(vrow + 4 * ((16 * ks2 + 8 + 2 * fq) ^ (2 * db)));
                        u32x4 t; t.x = va.x; t.y = va.y; t.z = vb.x; t.w = vb.y; const bf16x8 vf = __builtin_bit_cast(bf16x8, t);
#pragma unroll
                        for (int rb = 0; rb < 2; ++rb) O[rb][db] = __builtin_amdgcn_mfma_f32_16x16x32_bf16(vf, pf[rb], O[rb][db], 0, 0, 0); }
                }
                alive = !__all((carry[0] < DEAD) && (carry[1] < DEAD));
            }
            if (lane == 0) flags[w] = (alive && kb >= 1) ? 1 : 0;
            __syncthreads();
            int any = 0;
#pragma unroll
            for (int ww = 0; ww < 8; ++ww) any |= flags[ww];
            if (!any) break;
            if (nbn >= 0) attn_stage(lds + (nbn & 3) * ASLOT, lds + (nbn & 3) * ASLOT + 64 * KP, kr, vr, gks, sp, skp, lane);
            __syncthreads();
        }
#pragma unroll
        for (int rb = 0; rb < 2; ++rb) { bf16_t* op = Yb + (rowbase + r0 + 16 * rb + fr) * DM + hh * 128 + 4 * fq;
#pragma unroll
            for (int db = 0; db < 8; ++db) { u32x2 o; o.x = pk2(O[rb][db][0], O[rb][db][1]); o.y = pk2(O[rb][db][2], O[rb][db][3]); *(u32x2*)(op + 16 * db) = o; } }
        __syncthreads();
    }
}
constexpr int XP = 272;
__device__ void rnn_phase(ArgsP a, int l, LAS unsigned char* lds, const int wv) {
    const int tid = opaque_tid(wv), w = __builtin_amdgcn_readfirstlane(tid >> 6), lane = tid & 63, fr = lane & 15, fq = lane >> 4;
    LAS unsigned char* XC = lds; LAS unsigned char* HT = lds + RT * XP; LAS unsigned char* PT = lds + 2 * RT * XP;
    const bf16_t* XR = (const bf16_t*)(a->ws + WS_P); const bf16_t* GY = (const bf16_t*)(a->ws + WS_P + PBUF); bf16_t* SGA = (bf16_t*)(a->ws + WS_P + 2 * PBUF);
    bf16_t* SGB = (bf16_t*)(a->ws + WS_P + 4 * PBUF); const bf16_t* YB = (const bf16_t*)(a->ws + WS_P + 3 * PBUF);
    float* SUM = (float*)(a->ws + WS_SUM);
    const bf16_t* gw = (const bf16_t*)(a->ws + WS_GW) + (size_t)l * 2 * 8 * 16384;
    const float* cw = a->in[6] + (size_t)l * 4 * DM; const float* cb = a->in[7] + (size_t)l * DM;
    const float* ba = a->in[9] + (size_t)l * DM; const float* bx = a->in[11] + (size_t)l * DM; const float* lam = a->in[12] + (size_t)l * DM;
    const int sp = tid & 15, tg = tid >> 4;
    const int nunits = NB * 8 * NT;
    for (int unit = blockIdx.x; unit < nunits; unit += gridDim.x) {
        const int hh = unit & 7, b = (unit >> 3) & 3, j = unit >> 5; const int t0 = j * RT; const size_t rowbase = (size_t)b * SEQ;
        const int cbase = hh * 128;
        { u32x4 r[7];
#pragma unroll
          for (int i = 0; i < 7; ++i) { const int ts = t0 + 4 * tg - 3 + i; r[i] = (u32x4){0, 0, 0, 0}; if (ts >= 0) r[i] = *(const u32x4*)(XR + (rowbase + ts) * DM + cbase + sp * 8); }
          float wvv[4][8], bv[8];
#pragma unroll
          for (int e = 0; e < 8; ++e) { bv[e] = cb[cbase + sp * 8 + e];
#pragma unroll
              for (int k = 0; k < 4; ++k) wvv[k][e] = cw[k * DM + cbase + sp * 8 + e]; }
#pragma unroll
          for (int i = 0; i < 4; ++i) { float acc[8];
#pragma unroll
              for (int e = 0; e < 8; ++e) acc[e] = bv[e];
#pragma unroll
              for (int k = 0; k < 4; ++k) {
#pragma unroll
                  for (int jj = 0; jj < 4; ++jj) { acc[2 * jj] += wvv[k][2 * jj] * bflo(r[i + k][jj]); acc[2 * jj + 1] += wvv[k][2 * jj + 1] * bfhi(r[i + k][jj]); } }
              u32x4 o; o.x = pk2(acc[0], acc[1]); o.y = pk2(acc[2], acc[3]); o.z = pk2(acc[4], acc[5]); o.w = pk2(acc[6], acc[7]);
              *(LAS u32x4*)(XC + (4 * tg + i) * XP + sp * 16) = o; } }
        bf16x8 wa[4], wx[4];
        { const bf16_t* pa = gw + ((size_t)(0 * 8 + hh) * 128 + 16 * w + fr) * 128 + 8 * fq; const bf16_t* px = gw + ((size_t)(1 * 8 + hh) * 128 + 16 * w + fr) * 128 + 8 * fq;
#pragma unroll
          for (int ks = 0; ks < 4; ++ks) { wa[ks] = *(const bf16x8*)(pa + 32 * ks); wx[ks] = *(const bf16x8*)(px + 32 * ks); } }
        const int c = cbase + 16 * w + fr;
        const float bac = ba[c], bxc = bx[c]; const float lm = lam[c];
        const float sp8l = 8.0f * 1.4426950408889634f * (fmaxf(-lm, 0.f) + __logf(1.0f + __expf(-fabsf(lm))));
        __syncthreads();
        f32x4 A[8], U[8];
#pragma unroll
        for (int mb = 0; mb < 8; ++mb) { f32x4 ra = (f32x4){0.f, 0.f, 0.f, 0.f}, rx = ra;
#pragma unroll
            for (int ks = 0; ks < 4; ++ks) { const bf16x8 xf = *(const LAS bf16x8*)(XC + (16 * mb + fr) * XP + (32 * ks + 8 * fq) * 2);
                ra = __builtin_amdgcn_mfma_f32_16x16x32_bf16(xf, wa[ks], ra, 0, 0, 0); rx = __builtin_amdgcn_mfma_f32_16x16x32_bf16(xf, wx[ks], rx, 0, 0, 0); }
#pragma unroll
            for (int e = 0; e < 4; ++e) { const float r = __builtin_amdgcn_rcpf(1.0f + __builtin_amdgcn_exp2f(-1.4426950408889634f * (ra[e] + bac)));
                const float ig = __builtin_amdgcn_rcpf(1.0f + __builtin_amdgcn_exp2f(-1.4426950408889634f * (rx[e] + bxc)));
                const float la2 = -sp8l * r; const float av = __builtin_amdgcn_exp2f(la2);
                const float x2 = 1.3862943611198906f * la2;
                const float om = x2 > -0.02f ? -x2 * (1.0f + x2 * (0.5f + x2 * (1.0f / 6.0f))) : 1.0f - av * av;
                const float xc = bf2f(*(const LAS bf16_t*)(XC + (16 * mb + 4 * fq + e) * XP + (16 * w + fr) * 2));
                ra[e] = av; rx[e] = __builtin_amdgcn_sqrtf(om) * ig * xc; }
            A[mb] = ra; U[mb] = rx; }
        u32x4 mg[4], ms1[4], ms2[4], myb[4];
#pragma unroll
        for (int i = 0; i < 4; ++i) { const size_t go = (rowbase + t0 + 4 * tg + i) * DM + cbase + sp * 8; mg[i] = *(const u32x4*)(GY + go); ms1[i] = *(const u32x4*)(SGA + go); ms2[i] = *(const u32x4*)(SGB + go); myb[i] = *(const u32x4*)(YB + go); }
        float H = 0.f, Pp = 1.0f;
#pragma unroll
        for (int mb = 0; mb < 8; ++mb) {
            float Ag = A[mb][0] * A[mb][1] * A[mb][2] * A[mb][3];
            float Ug = ((U[mb][0] * A[mb][1] + U[mb][1]) * A[mb][2] + U[mb][2]) * A[mb][3] + U[mb][3];
            { const float a1 = lane_get(Ag, lane - 16), u1 = lane_get(Ug, lane - 16); if (fq >= 1) { Ug = Ag * u1 + Ug; Ag = Ag * a1; } }
            { const float a2 = lane_get(Ag, lane - 32), u2 = lane_get(Ug, lane - 32); if (fq >= 2) { Ug = Ag * u2 + Ug; Ag = Ag * a2; } }
            const float ap = lane_get(Ag, lane - 16), up = lane_get(Ug, lane - 16);
            float h = fq == 0 ? H : ap * H + up, p = fq == 0 ? Pp : ap * Pp;
#pragma unroll
            for (int e = 0; e < 4; ++e) { h = A[mb][e] * h + U[mb][e]; p *= A[mb][e]; const unsigned hp2 = pk2(h, p); const int off = (16 * mb + 4 * fq + e) * XP + (16 * w + fr) * 2;
                *(LAS bf16_t*)(HT + off) = (bf16_t)(hp2 & 0xffff); *(LAS bf16_t*)(PT + off) = (bf16_t)(hp2 >> 16); }
            const float Am = lane_get(Ag, 48 + fr), Um = lane_get(Ug, 48 + fr);
            H = Am * H + Um; Pp *= Am;
        }
        if (fq == 0) { float* sm = SUM + (((size_t)b * NT + j) * DM + c) * 2; sm[0] = Pp; sm[1] = H; }
        __syncthreads();
#pragma unroll
        for (int i = 0; i < 4; ++i) { const int tl = 4 * tg + i; const size_t go = (rowbase + t0 + tl) * DM + cbase + sp * 8;
            const u32x4 hv = *(const LAS u32x4*)(HT + tl * XP + sp * 16), pv = *(const LAS u32x4*)(PT + tl * XP + sp * 16);
            u32x4 o0, o1;
#pragma unroll
            for (int jj = 0; jj < 4; ++jj) { const float ga = bflo(ms1[i][jj]) * bflo(mg[i][jj]), gb = bfhi(ms1[i][jj]) * bfhi(mg[i][jj]);
                o0[jj] = pk2(ga * bflo(hv[jj]) + bflo(ms2[i][jj]) * bflo(myb[i][jj]), gb * bfhi(hv[jj]) + bfhi(ms2[i][jj]) * bfhi(myb[i][jj]));
                o1[jj] = pk2(ga * bflo(pv[jj]), gb * bfhi(pv[jj])); }
            *(u32x4*)(SGB + go) = o0; *(u32x4*)(SGA + go) = o1; }
    }
}
__device__ void carry_phase(ArgsP a, const int wv) {
    const float* SUM = (const float*)(a->ws + WS_SUM); float* HIN = (float*)(a->ws + WS_HIN);
    const int gt = blockIdx.x * NTH + opaque_tid(wv); if (gt >= NB * DM) return;
    const int b = gt / DM, c = gt % DM; float H = 0.f;
#pragma unroll 8
    for (int j = 0; j < NT; ++j) { const size_t o = ((size_t)b * NT + j) * DM + c; HIN[o] = H; const float p = SUM[o * 2], h = SUM[o * 2 + 1]; H = p * H + h; }
}
__device__ void mix_phase(ArgsP a, const int wv) {
    const bf16_t* M0 = (const bf16_t*)(a->ws + WS_P + 4 * PBUF); const bf16_t* M1 = (const bf16_t*)(a->ws + WS_P + 2 * PBUF); bf16_t* MIX = (bf16_t*)(a->ws + WS_XN); const float* HIN = (const float*)(a->ws + WS_HIN);
    for (int it = blockIdx.x * NTH + opaque_tid(wv); it < (MTOK / 32) * (DM / 8); it += gridDim.x * NTH) {
        const int pc = it & 127, rg = it >> 7; const int row0 = rg * 32, b = row0 / SEQ, j = (row0 % SEQ) / RT;
        const float* hp = HIN + ((size_t)b * NT + j) * DM + pc * 8; const f32x4 h0 = *(const f32x4*)hp, h1 = *(const f32x4*)(hp + 4);
#pragma unroll 8
        for (int r = 0; r < 32; ++r) { const size_t go = (size_t)(row0 + r) * DM + pc * 8; const u32x4 m0 = *(const u32x4*)(M0 + go), m1 = *(const u32x4*)(M1 + go); u32x4 o;
            o.x = pk2(bflo(m0.x) + bflo(m1.x) * h0[0], bfhi(m0.x) + bfhi(m1.x) * h0[1]); o.y = pk2(bflo(m0.y) + bflo(m1.y) * h0[2], bfhi(m0.y) + bfhi(m1.y) * h0[3]);
            o.z = pk2(bflo(m0.z) + bflo(m1.z) * h1[0], bfhi(m0.z) + bfhi(m1.z) * h1[1]); o.w = pk2(bflo(m0.w) + bflo(m1.w) * h1[2], bfhi(m0.w) + bfhi(m1.w) * h1[3]);
            *(u32x4*)(MIX + go) = o; }
    }
}
template <class Sched>
__device__ void ffn_fixup(ArgsP a, int l, const Sched& S, const int wv) {
    bf16_t* ACT = (bf16_t*)(a->ws + WS_P); const bf16_t* HALO = (const bf16_t*)(a->ws + WS_P + ACT_BYTES);
    const float* cw = a->in[18] + (size_t)l * 3 * DFF2; const float* cb = a->in[19] + (size_t)l * DFF2;
    const int tid = opaque_tid(wv); pg8::Unit u;
    for (int ui = 0; S.next(ui, u); ++ui)
    for (int it = tid; it < 2 * (DFF / 8); it += NTH) {
        const int cgp = it % (DFF / 8), wb = 2 * u.pm + it / (DFF / 8); const int c0 = cgp * 8, t0 = wb * 128; const bool first = (t0 & (SEQ - 1)) == 0;
        const bf16_t* hc = HALO + (size_t)wb * 4 * DFF2; const bf16_t* hpv = hc - 4 * DFF2;
        u32x4 z = (u32x4){0, 0, 0, 0}; u32x4 gm2 = z, gm1 = z, vm2 = z, vm1 = z;
        if (!first) { gm2 = *(const u32x4*)(hpv + 2 * DFF2 + c0); gm1 = *(const u32x4*)(hpv + 3 * DFF2 + c0); vm2 = *(const u32x4*)(hpv + 2 * DFF2 + DFF + c0); vm1 = *(const u32x4*)(hpv + 3 * DFF2 + DFF + c0); }
        const u32x4 g0 = *(const u32x4*)(hc + c0), g1 = *(const u32x4*)(hc + DFF2 + c0), v0 = *(const u32x4*)(hc + DFF + c0), v1 = *(const u32x4*)(hc + DFF2 + DFF + c0);
        u32x4 o0, o1;
#pragma unroll
        for (int jj = 0; jj < 4; ++jj) {
            float r0[2], r1[2];
#pragma unroll
            for (int hl = 0; hl < 2; ++hl) { const int c = c0 + 2 * jj + hl;
                const float wg0 = cw[c], wg1 = cw[DFF2 + c], wg2 = cw[2 * DFF2 + c], wv0 = cw[DFF + c], wv1 = cw[DFF2 + DFF + c], wv2 = cw[2 * DFF2 + DFF + c], bg = cb[c], bv = cb[DFF + c];
                const float G2 = hl ? bfhi(gm2[jj]) : bflo(gm2[jj]), G1 = hl ? bfhi(gm1[jj]) : bflo(gm1[jj]), Ga = hl ? bfhi(g0[jj]) : bflo(g0[jj]), Gb = hl ? bfhi(g1[jj]) : bflo(g1[jj]);
                const float V2 = hl ? bfhi(vm2[jj]) : bflo(vm2[jj]), V1 = hl ? bfhi(vm1[jj]) : bflo(vm1[jj]), Va = hl ? bfhi(v0[jj]) : bflo(v0[jj]), Vb = hl ? bfhi(v1[jj]) : bflo(v1[jj]);
                r0[hl] = gelu_tanh(bg + wg0 * G2 + wg1 * G1 + wg2 * Ga) * (bv + wv0 * V2 + wv1 * V1 + wv2 * Va);
                r1[hl] = gelu_tanh(bg + wg0 * G1 + wg1 * Ga + wg2 * Gb) * (bv + wv0 * V1 + wv1 * Va + wv2 * Vb); }
            o0[jj] = pk2(r0[0], r0[1]); o1[jj] = pk2(r1[0], r1[1]); }
        *(u32x4*)(ACT + (size_t)t0 * DFF + c0) = o0; *(u32x4*)(ACT + (size_t)(t0 + 1) * DFF + c0) = o1;
    }
}
constexpr int LDS_BYTES = 137 * 1024;
__global__ void __launch_bounds__(NTH, 2) mk_fwd(Args a_unused) {
    ArgsP a = (ArgsP)__builtin_amdgcn_kernarg_segment_ptr(); asm volatile("" : "+s"(a));
    const int wv = __builtin_amdgcn_readfirstlane(threadIdx.x >> 6);
    extern __shared__ __attribute__((aligned(16))) unsigned char lds_raw[];
    LAS unsigned char* lds = (LAS unsigned char*)lds_raw;
    cg::grid_group grid = cg::this_grid();
    volatile LAS unsigned* xbst = (volatile LAS unsigned*)(lds + LDS_BYTES - 16);
    if (threadIdx.x < 4) xbst[threadIdx.x] = 0u;
    __syncthreads();
    const XcdBarrier xbar = xcd_barrier_post((unsigned*)(a->ws + WS_BAR), xbst);
    const int G = gridDim.x, bid = blockIdx.x;
    float* mod = (float*)(a->ws + WS_MOD);
    bf16_t* XN = (bf16_t*)(a->ws + WS_XN); bf16_t* P = (bf16_t*)(a->ws + WS_P);
#ifndef REPMASK
#define REPMASK 0
#endif
#ifndef XSYNC
#define XSYNC 0
#endif
#define RUN(k, ...) for (int _r = 0; _r < (((REPMASK >> (k)) & 1) ? 2 : 1); ++_r) { __VA_ARGS__ xcd_barrier(xbar, wv); }
    if (a->out == nullptr) grid.sync();
    RUN(0, p0_mod(a, lds, wv); p0_weights(a, lds, wv);)
    for (int _x = 0; _x < XSYNC; ++_x) xcd_barrier(xbar, wv);
    for (int l = 0; l < NL; ++l) {
        const float* modl = mod + (size_t)l * NB * 6144;
        const bf16_t* wl = (const bf16_t*)(a->ws + WS_W) + (size_t)l * W_LAYER_E;
        const float* xin = l == 0 ? a->in[0] : a->out;
        RUN(1, norm_phase(xin, a->in[4] + l * DM, modl, 0, 1, XN, wv);)
        RUN(2, { pg8::Gemm g{XN, wl + (size_t)4096 * DM, MTOK, 3072, DM}; pg8::StaticOrder S; S.init(MTOK, 3072, G, bid);
          EpiSplit E{P, (size_t)MTOK * DM, 0x0000, 0}; pg8::gemm_phase<EpiSplit, pg8::StaticOrder, true, true>(lds, g, S, E, wv); })
        RUN(3, attn_phase(a, l, lds, wv);)
        RUN(4, { pg8::Gemm g{XN, wl, MTOK, 4096, DM}; pg8::StaticOrder S; S.init(MTOK, 4096, G, bid);
          EpiSplit E{P, (size_t)MTOK * DM, 0x2210, 1}; pg8::gemm_phase<EpiSplit, pg8::StaticOrder, true, true>(lds, g, S, E, wv); })
        RUN(5, rnn_phase(a, l, lds, wv);)
        RUN(6, carry_phase(a, wv);)
        RUN(7, mix_phase(a, wv);)
        RUN(13, { pg8::Gemm g{XN, wl + W_IN_E, MTOK, DM, DM}; pg8::StaticOrder S; S.init(MTOK, DM, G, bid);
          EpiRes E{xin, a->out, modl + 2 * 1024, 0}; pg8::gemm_phase<EpiRes, pg8::StaticOrder, true, true>(lds, g, S, E, wv); })
        RUN(9, norm_phase(a->out, a->in[16] + l * DM, modl, 3, 4, XN, wv);)
        RUN(10, { pg8::Gemm g{XN, wl + W_IN_E + W_OUT_E, MTOK, DFF2, DM}; pg8::StaticOrder S; S.init(MTOK, DFF2, G, bid);
          EpiConvAct E{P, (bf16_t*)(a->ws + WS_P + ACT_BYTES), a->in[18] + (size_t)l * 3 * DFF2, a->in[19] + (size_t)l * DFF2};
          pg8::gemm_phase<EpiConvAct, pg8::StaticOrder, true, true, true>(lds, g, S, E, wv); })
        RUN(13, { pg8::Gemm g{P, wl + W_IN_E + W_OUT_E + W_UP_E, MTOK, DM, DFF}; pg8::StaticOrder S; S.init(MTOK, DM, G, bid);
          ffn_fixup(a, l, S, wv); asm volatile("s_waitcnt vmcnt(0)" ::: "memory"); __syncthreads();
          EpiRes E{a->out, a->out, modl + 5 * 1024, 0}; pg8::gemm_phase<EpiRes, pg8::StaticOrder, true, true>(lds, g, S, E, wv); })
    }
}
extern "C" void kernel_launch(void* const* d_in, const int* in_sizes, int n_in, void* d_out, int out_size, void* d_ws, size_t ws_size, hipStream_t stream) {
    static int grid = 0;
    if (!grid) {
        int dev = 0, cus = 0, per_cu = 0;
        (void)hipGetDevice(&dev);
        (void)hipDeviceGetAttribute(&cus, hipDeviceAttributeMultiprocessorCount, dev);
        (void)hipFuncSetAttribute((const void*)mk_fwd, hipFuncAttributeMaxDynamicSharedMemorySize, LDS_BYTES);
        (void)hipOccupancyMaxActiveBlocksPerMultiprocessor(&per_cu, (const void*)mk_fwd, NTH, LDS_BYTES);
        if (per_cu < 1) per_cu = 1;
        grid = cus * per_cu;
        if (ws_size < WS_END) { fprintf(stderr, "kernel_launch: workspace too small: %zu < %zu\n", ws_size, (size_t)WS_END); grid = -1; }
        if (n_in != 21 || out_size != MTOK * DM) { fprintf(stderr, "kernel_launch: unexpected shapes\n"); grid = -1; }
    }
    if (grid < 0) return;
    (void)hipMemsetAsync((char*)d_ws + WS_BAR, 0, XCD_BAR_WORDS * 4, stream);
    Args a{};
    for (int i = 0; i < 21; ++i) a.in[i] = (const float*)d_in[i];
    a.out = (float*)d_out; a.ws = (unsigned char*)d_ws;
    void* args[] = {&a};
    hipError_t e = hipLaunchCooperativeKernel((const void*)mk_fwd, dim3(grid), dim3(NTH), args, LDS_BYTES, stream);
    if (e != hipSuccess) fprintf(stderr, "cooperative launch failed: %s (grid %d)\n", hipGetErrorString(e), grid);
}
```

```cpp
#include <hip/hip_runtime.h>
#include <hip/hip_cooperative_groups.h>
#include <cstdio>
#include <cstdint>
namespace cg = cooperative_groups;
__device__ __forceinline__ int opaque_tid(int wv) { int t; asm volatile("v_mbcnt_lo_u32_b32 %0, -1, 0\n\tv_mbcnt_hi_u32_b32 %0, -1, %0" : "=v"(t)); return t | (wv << 6); }
__device__ __forceinline__ int opaque_bid() { int t = blockIdx.x; asm volatile("" : "+s"(t)); return t; }
namespace pg8 {
#define PG8_LAS __attribute__((address_space(3)))
typedef unsigned short bf16_t;
typedef short bf16x8 __attribute__((ext_vector_type(8)));
typedef float f32x4 __attribute__((ext_vector_type(4)));
typedef unsigned u32x4 __attribute__((ext_vector_type(4)));
constexpr int BM = 256, BK = 64, HALF = 128, HTB = HALF * BK * 2  , STAGE_BYTES = 8 * HTB, NXCD = 8, WGM = 8;

__host__ __device__ __forceinline__ int lds_byte(int r, int c) { const int st = (r >> 4) * 2 + (c >> 5), rr = r & 15, cc = c & 31, ob = rr * 64 + cc * 2; return st * 1024 + (ob ^ (((ob >> 9) & 1) << 5)); }
__host__ __device__ __forceinline__ void stage_rc(int b, int& R, int& C) { const int st = b / 1024, sb = b % 1024, swz = sb ^ (((sb >> 9) & 1) << 5); R = (st >> 1) * 16 + swz / 64; C = (st & 1) * 32 + (swz % 64) / 2; }
__host__ __device__ __forceinline__ int perm32(int rho) { const int n = rho >> 4, i = rho & 15; return 8 * (i >> 2) + 4 * n + (i & 3); }

struct Unit { int pm, pn; };
struct Gemm { const bf16_t* A; const bf16_t* Bt; int M, N, K; };

struct StaticOrder {
    int nM, nN, nwg, G, c;
    __host__ __device__ void init(int M, int N, int G_, int c_) { nM = M / BM; nN = N / BM; nwg = nM * nN; G = G_; c = c_; }
    __host__ __device__ bool next(int i, Unit& u) const {
        const long L = (long)i * G + c; if (L >= nwg) return false;
        int wgid = (int)L; { const int q = nwg / NXCD, r = nwg % NXCD, xcd = wgid % NXCD, off = wgid / NXCD; wgid = (xcd < r ? xcd * (q + 1) : r * (q + 1) + (xcd - r) * q) + off; }
        const int nig = WGM * nN, gid = wgid / nig, fm = gid * WGM, gsz = (nM - fm) < WGM ? (nM - fm) : WGM;
        u.pm = fm + ((wgid % nig) % gsz); u.pn = (wgid % nig) / gsz; return true;
    }
    __device__ __forceinline__ void a_ready(const Unit&) const {}
    __device__ __forceinline__ void done(const Unit&) const {}
};

template <class Epi, class Sched, bool ALIGN_EPI = false, bool SP2 = false, bool ROWPERM = false>
__device__ __forceinline__ void gemm_phase(PG8_LAS unsigned char* lds, const Gemm g, const Sched& S, const Epi& E, const int wv) {
    const int tid = opaque_tid(wv), wid = __builtin_amdgcn_readfirstlane(tid >> 6), lane = tid & 63, wr = wid >> 2, wc = wid & 3, fr = lane & 15, fq = lane >> 4;
    const int K = g.K, nt = K / BK;
    unsigned voffA[2], voffB[2];
#pragma unroll
    for (int i = 0; i < 2; ++i) { int R, C; stage_rc(tid * 16 + i * 8192, R, C); const int Rb = Epi::PERM ? ((R & ~31) + perm32(R & 31)) : R;
        const int Ra = ROWPERM ? (128 * (R >> 6) + 8 * (R & 15) + ((R >> 4) & 3)) : R;
        voffA[i] = (unsigned)(Ra * K + C) * 2u; voffB[i] = (unsigned)(Rb * K + C) * 2u; }
    const size_t kstep = (size_t)(BK * 2);
    const size_t hstep = (size_t)HALF * K * 2;
    const size_t tstep = 2 * hstep; const size_t hstepA = ROWPERM ? (size_t)4 * K * 2 : hstep;
    const unsigned ldsw = (unsigned)wid * 1024u;
    const int aoff = lds_byte(wr * 64 + fr, fq * 8), boff = lds_byte(wc * 32 + fr, fq * 8);
#define PG8_SA(b, h) (((b) * 2 + (h)) * HTB)
#define PG8_SB(b, h) ((4 + (b) * 2 + (h)) * HTB)
#define PG8_STAGE(bufoff, gbase, voff) do { _Pragma("unroll") for (int _i = 0; _i < 2; ++_i) \
        __builtin_amdgcn_global_load_lds((const unsigned*)((const char*)(gbase) + (voff)[_i]), (PG8_LAS unsigned*)(lds + (bufoff) + ldsw + _i * 8192), 16, 0, 0); } while (0)
#define PG8_LDA(dst, b, h) do { _Pragma("unroll") for (int m = 0; m < 4; ++m) _Pragma("unroll") for (int k = 0; k < 2; ++k) dst[m][k] = *(const PG8_LAS bf16x8*)(lds + PG8_SA(b, h) + aoff + m * 2048 + k * 1024); } while (0)
#define PG8_LDB(dst, b, h) do { _Pragma("unroll") for (int n = 0; n < 2; ++n) _Pragma("unroll") for (int k = 0; k < 2; ++k) dst[n][k] = *(const PG8_LAS bf16x8*)(lds + PG8_SB(b, h) + boff + n * 2048 + k * 1024); } while (0)
#define PG8_MMA(ai, bj, At, Bt) do { __builtin_amdgcn_s_setprio(1); _Pragma("unroll") for (int m = 0; m < 4; ++m) _Pragma("unroll") for (int n = 0; n < 2; ++n) _Pragma("unroll") for (int k = 0; k < 2; ++k) \
        acc[ai][bj][m][n] = __builtin_amdgcn_mfma_f32_16x16x32_bf16(Bt[n][k], At[m][k], acc[ai][bj][m][n], 0, 0, 0); __builtin_amdgcn_s_setprio(0); } while (0)
#define PG8_WAIT_V(n) asm volatile("s_waitcnt vmcnt(" #n ")" ::: "memory")
#define PG8_WAIT_L(n) asm volatile("s_waitcnt lgkmcnt(" #n ")" ::: "memory")
#define PG8_BAR __builtin_amdgcn_s_barrier()
#define PG8_SCHED __builtin_amdgcn_sched_barrier(0)
    Unit cur, nxt; int ui = 0;
    if (!S.next(0, cur)) return;
    f32x4 acc[2][2][4][2];
#pragma unroll
    for (int a = 0; a < 2; ++a)
#pragma unroll
        for (int b = 0; b < 2; ++b)
#pragma unroll
            for (int m = 0; m < 4; ++m)
#pragma unroll
                for (int n = 0; n < 2; ++n) acc[a][b][m][n] = (f32x4){0.f, 0.f, 0.f, 0.f};
    bf16x8 At[4][2], B0[2][2], B1[2][2];
    const char* cA = (const char*)g.A + (size_t)cur.pm * tstep; const char* cB = (const char*)g.Bt + (size_t)cur.pn * tstep;
    S.a_ready(cur);
    if constexpr (SP2) {
        PG8_STAGE(PG8_SB(0, 0), cB, voffB); PG8_STAGE(PG8_SB(0, 1), cB + hstep, voffB); PG8_STAGE(PG8_SA(0, 0), cA, voffA); PG8_STAGE(PG8_SA(0, 1), cA + hstepA, voffA);
        if (wr == 1) PG8_BAR;
        PG8_WAIT_V(2); PG8_BAR;
        PG8_STAGE(PG8_SB(1, 0), cB + kstep, voffB); PG8_STAGE(PG8_SA(1, 0), cA + kstep, voffA); PG8_STAGE(PG8_SB(1, 1), cB + hstep + kstep, voffB);
        PG8_WAIT_V(6); PG8_BAR;
    } else {
        PG8_STAGE(PG8_SB(0, 0), cB, voffB); PG8_STAGE(PG8_SA(0, 0), cA, voffA); PG8_STAGE(PG8_SB(0, 1), cB + hstep, voffB); PG8_STAGE(PG8_SA(0, 1), cA + hstepA, voffA);
        if (wr == 1) PG8_BAR;
        PG8_WAIT_V(4); PG8_BAR;
        PG8_STAGE(PG8_SB(1, 0), cB + kstep, voffB); PG8_STAGE(PG8_SA(1, 0), cA + kstep, voffA); PG8_STAGE(PG8_SB(1, 1), cB + hstep + kstep, voffB);
        PG8_WAIT_V(6); PG8_BAR;
    }
    for (;;) {
        const bool has_next = S.next(ui + 1, nxt);
        const char* nA = has_next ? (const char*)g.A + (size_t)nxt.pm * tstep : cA; const char* nB = has_next ? (const char*)g.Bt + (size_t)nxt.pn * tstep : cB;
        for (int t = 0; t < nt; t += 2) {
            const bool last = (t == nt - 2);
            const char* a1 = cA + (size_t)(t + 1) * kstep;
            const char* a2 = last ? nA : cA + (size_t)(t + 2) * kstep; const char* b2 = last ? nB : cB + (size_t)(t + 2) * kstep;
            const char* a3 = a2 + kstep; const char* b3 = b2 + kstep;
            if (last && has_next) S.a_ready(nxt);
            if constexpr (SP2) {
            PG8_LDB(B0, 0, 0); PG8_LDB(B1, 0, 1); PG8_SCHED; PG8_LDA(At, 0, 0); PG8_STAGE(PG8_SA(1, 1), a1 + hstepA, voffA);
            PG8_WAIT_V(8); PG8_WAIT_L(0); PG8_BAR; PG8_MMA(0, 0, At, B0); PG8_MMA(0, 1, At, B1); PG8_BAR; PG8_SCHED;
            PG8_LDA(At, 0, 1); PG8_STAGE(PG8_SB(0, 0), b2, voffB); PG8_STAGE(PG8_SB(0, 1), b2 + hstep, voffB); PG8_STAGE(PG8_SA(0, 0), a2, voffA);
            PG8_WAIT_V(8); PG8_WAIT_L(0); PG8_BAR; PG8_MMA(1, 0, At, B0); PG8_MMA(1, 1, At, B1); PG8_BAR; PG8_SCHED;
            PG8_LDB(B0, 1, 0); PG8_LDB(B1, 1, 1); PG8_SCHED; PG8_LDA(At, 1, 0); PG8_STAGE(PG8_SA(0, 1), a2 + hstepA, voffA);
            PG8_WAIT_V(8); PG8_WAIT_L(0); PG8_BAR; PG8_MMA(0, 0, At, B0); PG8_MMA(0, 1, At, B1); PG8_BAR; PG8_SCHED;
            PG8_LDA(At, 1, 1); PG8_STAGE(PG8_SB(1, 0), b3, voffB); PG8_STAGE(PG8_SB(1, 1), b3 + hstep, voffB); PG8_STAGE(PG8_SA(1, 0), a3, voffA);
            PG8_WAIT_V(8); PG8_WAIT_L(0); PG8_BAR; PG8_MMA(1, 0, At, B0); PG8_MMA(1, 1, At, B1); PG8_BAR; PG8_SCHED;
            } else {
            PG8_LDB(B0, 0, 0); PG8_SCHED; PG8_LDA(At, 0, 0); PG8_STAGE(PG8_SA(1, 1), a1 + hstepA, voffA);
            PG8_WAIT_L(8); PG8_BAR; PG8_WAIT_L(0); PG8_MMA(0, 0, At, B0); PG8_BAR; PG8_SCHED;
            PG8_LDB(B1, 0, 1); PG8_STAGE(PG8_SB(0, 0), b2, voffB);
            PG8_BAR; PG8_WAIT_L(0); PG8_MMA(0, 1, At, B1); PG8_BAR;
            PG8_LDA(At, 0, 1); PG8_STAGE(PG8_SA(0, 0), a2, voffA);
            PG8_BAR; PG8_WAIT_L(0); PG8_MMA(1, 0, At, B0); PG8_BAR; PG8_SCHED;
            PG8_STAGE(PG8_SB(0, 1), b2 + hstep, voffB);
            PG8_WAIT_V(6); PG8_BAR; PG8_MMA(1, 1, At, B1); PG8_BAR;
            PG8_LDB(B0, 1, 0); PG8_SCHED; PG8_LDA(At, 1, 0); PG8_STAGE(PG8_SA(0, 1), a2 + hstepA, voffA);
            PG8_WAIT_L(8); PG8_BAR; PG8_WAIT_L(0); PG8_MMA(0, 0, At, B0); PG8_BAR; PG8_SCHED;
            PG8_LDB(B1, 1, 1); PG8_STAGE(PG8_SB(1, 0), b3, voffB);
            PG8_BAR; PG8_WAIT_L(0); PG8_MMA(0, 1, At, B1); PG8_BAR;
            PG8_LDA(At, 1, 1); PG8_STAGE(PG8_SA(1, 0), a3, voffA);
            PG8_BAR; PG8_WAIT_L(0); PG8_MMA(1, 0, At, B0); PG8_BAR; PG8_SCHED;
            PG8_STAGE(PG8_SB(1, 1), b3 + hstep, voffB);
            PG8_WAIT_V(6); PG8_BAR; PG8_MMA(1, 1, At, B1); PG8_BAR;
            }
        }
        if constexpr (ALIGN_EPI) { if (wr == 0) PG8_BAR; }
        if constexpr (!Epi::AFTER_DRAIN) { E(acc, cur, wr, wc, fr, fq); S.done(cur); }
        if (!has_next) break;
#pragma unroll
        for (int a = 0; a < 2; ++a)
#pragma unroll
            for (int b = 0; b < 2; ++b)
#pragma unroll
                for (int m = 0; m < 4; ++m)
#pragma unroll
                    for (int n = 0; n < 2; ++n) acc[a][b][m][n] = (f32x4){0.f, 0.f, 0.f, 0.f};
        cur = nxt; cA = nA; cB = nB; ++ui;
        if constexpr (ALIGN_EPI) { if (wr == 1) PG8_BAR; }
    }
    PG8_WAIT_V(0);
    if constexpr (!ALIGN_EPI) { if (wr == 0) PG8_BAR; }
    PG8_BAR;
    if constexpr (Epi::AFTER_DRAIN) { E.fused(acc, cur, wr, wc, fr, fq, lds, wid, lane); S.done(cur); }
#undef PG8_SA
#undef PG8_SB
#undef PG8_STAGE
#undef PG8_LDA
#undef PG8_LDB
#undef PG8_MMA
#undef PG8_WAIT_V
#undef PG8_WAIT_L
#undef PG8_BAR
#undef PG8_SCHED
}
}
typedef pg8::bf16_t bf16_t;
typedef pg8::bf16x8 bf16x8;
typedef pg8::f32x4 f32x4;
typedef pg8::u32x4 u32x4;
typedef unsigned u32x2 __attribute__((ext_vector_type(2)));
#define LAS __attribute__((address_space(3)))

constexpr int DM = 1024, NB = 4, SEQ = 8192, MTOK = NB * SEQ, DIN = 7168, DFF = 3072, DFF2 = 6144, NL = 2;
constexpr int NTH = 512;
constexpr float EPS = 1e-6f;
constexpr int RT = 128, NT = SEQ / RT;
constexpr size_t WS_BAR = 0;
constexpr size_t WS_MOD = 16384;
constexpr size_t WS_GW = WS_MOD + (size_t)NL * NB * 6144 * 4;
constexpr size_t WS_SUM = WS_GW + (size_t)NL * 2 * 8 * 128 * 128 * 2;
constexpr size_t WS_HIN = WS_SUM + (size_t)NB * NT * 1024 * 2 * 4;
constexpr size_t WS_W = (WS_HIN + (size_t)NB * NT * 1024 * 4 + 4095) / 4096 * 4096;
constexpr size_t W_IN_E = (size_t)DIN * DM, W_OUT_E = (size_t)DM * DM, W_UP_E = (size_t)DFF2 * DM, W_DN_E = (size_t)DM * DFF, W_LAYER_E = W_IN_E + W_OUT_E + W_UP_E + W_DN_E;
constexpr size_t WS_XN = WS_W + NL * W_LAYER_E * 2;
constexpr size_t PBUF = (size_t)MTOK * DM * 2;
constexpr size_t WS_P = WS_XN + PBUF;
constexpr size_t WS_XB = WS_XN;
constexpr size_t WS_END = WS_P + 5 * PBUF;
constexpr size_t ACT_BYTES = (size_t)MTOK * DFF * 2;

__device__ __forceinline__ float bf2f(bf16_t b) { return __uint_as_float(((unsigned)b) << 16); }
__device__ __forceinline__ unsigned pk2(float lo, float hi) { unsigned r; asm volatile("v_cvt_pk_bf16_f32 %0, %1, %2" : "=v"(r) : "v"(lo), "v"(hi)); return r; }
__device__ __forceinline__ float bflo(unsigned w) { return __uint_as_float(w << 16); }
__device__ __forceinline__ float bfhi(unsigned w) { return __uint_as_float(w & 0xffff0000u); }
__device__ __forceinline__ float lane_get(float x, int srclane) { return __builtin_bit_cast(float, __builtin_amdgcn_ds_bpermute(srclane << 2, __builtin_bit_cast(int, x))); }
__device__ __forceinline__ float sigmoidf_(float x) { return __builtin_amdgcn_rcpf(1.0f + __expf(-x)); }
__device__ __forceinline__ float gelu_tanh(float x) { const float u = 1.5957691216057308f * (x + 0.044715f * x * x * x); return x * sigmoidf_(u); }

struct EpiSplit {
    static constexpr bool PERM = true, AFTER_DRAIN = false;
    bf16_t* base; size_t tstride; int modes; int skip3;
    __device__ __forceinline__ void operator()(const f32x4 (&acc)[2][2][4][2], const pg8::Unit& u, int wr, int wc, int fr, int fq) const {
        const int colt = u.pn * 256, t = colt >> 10; const int mode = (modes >> (4 * t)) & 15;
        bf16_t* o = base + (size_t)(t + ((skip3 && t == 3) ? 1 : 0)) * tstride; const int col0 = (colt & 1023) + wc * 32 + 8 * fq; const int row0 = u.pm * 256 + wr * 64 + fr;
#pragma unroll
        for (int ai = 0; ai < 2; ++ai)
#pragma unroll
            for (int m = 0; m < 4; ++m) { bf16_t* rowp = o + (size_t)(row0 + ai * 128 + m * 16) * DM + col0;
#pragma unroll
                for (int bj = 0; bj < 2; ++bj) { f32x4 v0 = acc[ai][bj][m][0], v1 = acc[ai][bj][m][1];
                    if (mode == 1) {
#pragma unroll
                        for (int j = 0; j < 4; ++j) { v0[j] = gelu_tanh(v0[j]); v1[j] = gelu_tanh(v1[j]); } }
                    else if (mode == 2) {
#pragma unroll
                        for (int j = 0; j < 4; ++j) { v0[j] = sigmoidf_(v0[j]); v1[j] = sigmoidf_(v1[j]); } }
                    u32x4 w; w.x = pk2(v0[0], v0[1]); w.y = pk2(v0[2], v0[3]); w.z = pk2(v1[0], v1[1]); w.w = pk2(v1[2], v1[3]);
                    *(u32x4*)(rowp + bj * 128) = w; } }
    }
};
struct EpiIn {
    static constexpr bool PERM = true, AFTER_DRAIN = false;
    bf16_t* P; bf16_t* P5;
    __device__ __forceinline__ void operator()(const f32x4 (&acc)[2][2][4][2], const pg8::Unit& u, int wr, int wc, int fr, int fq) const {
        const int row0 = u.pm * 256 + wr * 64 + fr; const int pn = u.pn;
        if (pn >= 4 && pn < 12) {
            bf16_t* o = P + (size_t)4 * MTOK * DM + (pn - 4) * 128 + wc * 32 + 8 * fq;
#pragma unroll
            for (int ai = 0; ai < 2; ++ai)
#pragma unroll
                for (int m = 0; m < 4; ++m) { float g[8];
#pragma unroll
                    for (int j = 0; j < 4; ++j) { g[j] = gelu_tanh(acc[ai][0][m][0][j]) * sigmoidf_(acc[ai][1][m][0][j]); g[4 + j] = gelu_tanh(acc[ai][0][m][1][j]) * sigmoidf_(acc[ai][1][m][1][j]); }
                    u32x4 w; w.x = pk2(g[0], g[1]); w.y = pk2(g[2], g[3]); w.z = pk2(g[4], g[5]); w.w = pk2(g[6], g[7]);
                    *(u32x4*)(o + (size_t)(row0 + ai * 128 + m * 16) * DM) = w; }
        } else {
            const bool sg = pn >= 12 && pn < 16;
            bf16_t* o = (pn < 4 ? P + (size_t)3 * MTOK * DM + pn * 256 : sg ? P5 + (pn - 12) * 256 : P + (size_t)((pn - 16) >> 2) * MTOK * DM + ((pn - 16) & 3) * 256) + wc * 32 + 8 * fq;
#pragma unroll
            for (int ai = 0; ai < 2; ++ai)
#pragma unroll
                for (int m = 0; m < 4; ++m) { bf16_t* rowp = o + (size_t)(row0 + ai * 128 + m * 16) * DM;
#pragma unroll
                    for (int bj = 0; bj < 2; ++bj) { f32x4 v0 = acc[ai][bj][m][0], v1 = acc[ai][bj][m][1];
                        if (sg) {
#pragma unroll
                            for (int j = 0; j < 4; ++j) { v0[j] = sigmoidf_(v0[j]); v1[j] = sigmoidf_(v1[j]); } }
                        u32x4 w; w.x = pk2(v0[0], v0[1]); w.y = pk2(v0[2], v0[3]); w.z = pk2(v1[0], v1[1]); w.w = pk2(v1[2], v1[3]);
                        *(u32x4*)(rowp + bj * 128) = w; } }
        }
    }
};
struct EpiPlain {
    static constexpr bool PERM = true, AFTER_DRAIN = false;
    bf16_t* o; int ldc;
    __device__ __forceinline__ void operator()(const f32x4 (&acc)[2][2][4][2], const pg8::Unit& u, int wr, int wc, int fr, int fq) const {
        const int col0 = u.pn * 256 + wc * 32 + 8 * fq; const int row0 = u.pm * 256 + wr * 64 + fr;
#pragma unroll
        for (int ai = 0; ai < 2; ++ai)
#pragma unroll
            for (int m = 0; m < 4; ++m) { bf16_t* rowp = o + (size_t)(row0 + ai * 128 + m * 16) * ldc + col0;
#pragma unroll
                for (int bj = 0; bj < 2; ++bj) { const f32x4 v0 = acc[ai][bj][m][0], v1 = acc[ai][bj][m][1];
                    u32x4 w; w.x = pk2(v0[0], v0[1]); w.y = pk2(v0[2], v0[3]); w.z = pk2(v1[0], v1[1]); w.w = pk2(v1[2], v1[3]);
                    *(u32x4*)(rowp + bj * 128) = w; } }
    }
};
struct EpiRes {
    static constexpr bool PERM = true, AFTER_DRAIN = false;
    const float* resf; const bf16_t* resb; bf16_t* xb; float* outf; const float* gate  ;
    __device__ __forceinline__ void operator()(const f32x4 (&acc)[2][2][4][2], const pg8::Unit& u, int wr, int wc, int fr, int fq) const {
        const int grow0 = u.pm * 256; const int b = grow0 / SEQ; const int row0 = grow0 + wr * 64 + fr, col0 = u.pn * 256 + wc * 32 + 8 * fq;
        f32x4 gv[2][2];
#pragma unroll
        for (int bj = 0; bj < 2; ++bj)
#pragma unroll
            for (int n = 0; n < 2; ++n) gv[bj][n] = *(const f32x4*)(gate + (size_t)b * 6144 + col0 + bj * 128 + n * 4);
#pragma unroll
        for (int am = 0; am < 4; ++am) { const int ai = am >> 1, m0 = (am & 1) * 2;
            f32x4 rv[2][2][2];
            if (resf) {
#pragma unroll
                for (int mm = 0; mm < 2; ++mm) { const size_t off = (size_t)(row0 + ai * 128 + (m0 + mm) * 16) * DM + col0;
#pragma unroll
                    for (int bj = 0; bj < 2; ++bj)
#pragma unroll
                        for (int n = 0; n < 2; ++n) rv[mm][bj][n] = *(const f32x4*)(resf + off + bj * 128 + n * 4); }
            } else {
#pragma unroll
                for (int mm = 0; mm < 2; ++mm) { const size_t off = (size_t)(row0 + ai * 128 + (m0 + mm) * 16) * DM + col0;
#pragma unroll
                    for (int bj = 0; bj < 2; ++bj) { const u32x4 rw = *(const u32x4*)(resb + off + bj * 128);
                        rv[mm][bj][0] = (f32x4){bflo(rw.x), bfhi(rw.x), bflo(rw.y), bfhi(rw.y)}; rv[mm][bj][1] = (f32x4){bflo(rw.z), bfhi(rw.z), bflo(rw.w), bfhi(rw.w)}; } }
            }
#pragma unroll
            for (int mm = 0; mm < 2; ++mm) { const int m = m0 + mm; const size_t off = (size_t)(row0 + ai * 128 + m * 16) * DM + col0;
#pragma unroll
                for (int bj = 0; bj < 2; ++bj) { const f32x4 y0 = rv[mm][bj][0] + gv[bj][0] * acc[ai][bj][m][0], y1 = rv[mm][bj][1] + gv[bj][1] * acc[ai][bj][m][1];
                    if (outf) { *(f32x4*)(outf + off + bj * 128) = y0; *(f32x4*)(outf + off + bj * 128 + 4) = y1; }
                    else { u32x4 w; w.x = pk2(y0[0], y0[1]); w.y = pk2(y0[2], y0[3]); w.z = pk2(y1[0], y1[1]); w.w = pk2(y1[2], y1[3]); *(u32x4*)(xb + off + bj * 128) = w; } } }
            asm volatile("" ::: "memory"); }
    }
};


#define XB_TMO      128
#define XB_XCNT(j)  (256  + 64 * (j))
#define XB_XSUB(j)  (1280 + 64 * (j))
#define XB_XGEN(j)  (2304 + 64 * (j))
#define XB_TOP      3328
#define XB_TOPGEN   3392
#define XCD_BAR_WORDS 3456
#define XB_SPIN_CAP (1u << 22)
__device__ __forceinline__ unsigned xb_ld(unsigned* p)              { return __hip_atomic_load(p, __ATOMIC_RELAXED, __HIP_MEMORY_SCOPE_AGENT); }
__device__ __forceinline__ unsigned xb_add(unsigned* p, unsigned v) { return __hip_atomic_fetch_add(p, v, __ATOMIC_RELAXED, __HIP_MEMORY_SCOPE_AGENT); }
__device__ __forceinline__ unsigned xb_xcc_id() { return (unsigned)__builtin_amdgcn_s_getreg((3 << 11) | 20) & 0xFu; }
#define XB_SPIN(cond, bar) do { unsigned _sp = 0; while (cond) { __builtin_amdgcn_s_sleep(1); \
    if ((++_sp & 255u) == 0u) { if (xb_ld(&(bar)[XB_TMO])) break; if (_sp > XB_SPIN_CAP) { atomicAdd(&(bar)[XB_TMO], 1u); break; } } } } while (0)
struct XcdBarrier { unsigned* bar; unsigned x; volatile LAS unsigned* st; };
__device__ __forceinline__ XcdBarrier xcd_barrier_post(unsigned* bar, volatile LAS unsigned* st) {
    XcdBarrier b; b.bar = bar; b.x = xb_xcc_id(); b.st = st;
    if (threadIdx.x == 0) (void)xb_add(&bar[XB_XCNT(b.x)], 1u);
    return b;
}
__device__ __forceinline__ void xcd_barrier_complete(unsigned* bar, unsigned x, unsigned& nloc, unsigned& nx) {
    const unsigned G = gridDim.x * gridDim.y * gridDim.z;
    unsigned sum, cnt, mine, sp = 0u;
    for (;;) {
        sum = 0u; cnt = 0u; mine = 0u;
#pragma unroll
        for (unsigned j = 0; j < 16; ++j) { const unsigned c = xb_ld(&bar[XB_XCNT(j)]); sum += c; cnt += (c > 0u) ? 1u : 0u; mine = (j == x) ? c : mine; }
        if (sum == G) break;
        __builtin_amdgcn_s_sleep(1);
        if ((++sp & 255u) == 0u) { if (xb_ld(&bar[XB_TMO])) break; if (sp > XB_SPIN_CAP) { atomicAdd(&bar[XB_TMO], 1u); break; } }
    }
    nloc = mine > 0u ? mine : 1u; nx = cnt > 0u ? cnt : 1u;
}
__device__ __forceinline__ void xcd_barrier(const XcdBarrier& b, const int wv) {
    asm volatile("s_waitcnt vmcnt(0)" ::: "memory");
    __syncthreads();
    if (opaque_tid(wv) == 0) {
        unsigned* bar = b.bar;
        __builtin_amdgcn_s_waitcnt(0);
        unsigned nloc = b.st[0], nx = b.st[1];
        if (nloc == 0u) { xcd_barrier_complete(bar, b.x, nloc, nx); b.st[0] = nloc; b.st[1] = nx; }
        const unsigned old = xb_add(&bar[XB_XSUB(b.x)], 1u);
        const unsigned gen = old / nloc;
        if (old + 1u == (gen + 1u) * nloc) {
            __builtin_amdgcn_fence(__ATOMIC_RELEASE, "agent");
            asm volatile("s_waitcnt vmcnt(0)" ::: "memory");
            const unsigned og = xb_add(&bar[XB_TOP], 1u);
            const unsigned tg = og / nx;
            if (og + 1u == (tg + 1u) * nx) xb_add(&bar[XB_TOPGEN], 1u);
            else XB_SPIN(xb_ld(&bar[XB_TOPGEN]) == tg, bar);
            __builtin_amdgcn_fence(__ATOMIC_ACQUIRE, "agent");
            xb_add(&bar[XB_XGEN(b.x)], 1u);
            asm volatile("s_waitcnt vmcnt(0)" ::: "memory");
        } else {
            XB_SPIN(xb_ld(&bar[XB_XGEN(b.x)]) == gen, bar);
            __builtin_amdgcn_fence(__ATOMIC_ACQUIRE, "agent");
            asm volatile("s_waitcnt vmcnt(0)" ::: "memory");
        }
    }
    __syncthreads();
}

__device__ __forceinline__ float dpp_shr1(float x) { return __builtin_bit_cast(float, __builtin_amdgcn_update_dpp(0, __builtin_bit_cast(int, x), 0x111, 0xf, 0xf, false)); }
struct EpiConvAct {
    static constexpr bool PERM = true, AFTER_DRAIN = false;
    bf16_t* act; bf16_t* halo; const float* cw; const float* cb;
    __device__ __forceinline__ void operator()(const f32x4 (&acc)[2][2][4][2], const pg8::Unit& u, int wr, int wc, int fr, int fq) const {
        const int tb = u.pm * 256 + 128 * wr, c0 = u.pn * 128 + wc * 32 + 8 * fq;
        bf16_t* hp = halo + (size_t)(tb >> 7) * 4 * DFF2;
#pragma unroll
        for (int n = 0; n < 2; ++n) {
            const int c = c0 + 4 * n;
            const f32x4 bg = *(const f32x4*)(cb + c), bv = *(const f32x4*)(cb + DFF + c);
            const f32x4 wg0 = *(const f32x4*)(cw + c), wg1 = *(const f32x4*)(cw + DFF2 + c), wg2 = *(const f32x4*)(cw + 2 * DFF2 + c);
            const f32x4 wv0 = *(const f32x4*)(cw + DFF + c), wv1 = *(const f32x4*)(cw + DFF2 + DFF + c), wv2 = *(const f32x4*)(cw + 2 * DFF2 + DFF + c);
            f32x4 pg6, pg7, pv6, pv7;
#pragma unroll
            for (int j = 0; j < 4; ++j) { pg6[j] = dpp_shr1(acc[1][0][2][n][j]); pg7[j] = dpp_shr1(acc[1][0][3][n][j]); pv6[j] = dpp_shr1(acc[1][1][2][n][j]); pv7[j] = dpp_shr1(acc[1][1][3][n][j]); }
#pragma unroll
            for (int q = 0; q < 8; ++q) {
                const f32x4 g = acc[q >> 2][0][q & 3][n], v = acc[q >> 2][1][q & 3][n];
                const f32x4 g1 = q >= 1 ? acc[(q - 1 + 8) % 8 >> 2][0][(q - 1 + 8) % 8 & 3][n] : pg7, g2 = q >= 2 ? acc[(q - 2 + 8) % 8 >> 2][0][(q - 2 + 8) % 8 & 3][n] : (q == 1 ? pg7 : pg6);
                const f32x4 v1 = q >= 1 ? acc[(q - 1 + 8) % 8 >> 2][1][(q - 1 + 8) % 8 & 3][n] : pv7, v2 = q >= 2 ? acc[(q - 2 + 8) % 8 >> 2][1][(q - 2 + 8) % 8 & 3][n] : (q == 1 ? pv7 : pv6);
                const f32x4 g1e = q == 0 ? pg7 : g1, g2e = q == 0 ? pg6 : g2, v1e = q == 0 ? pv7 : v1, v2e = q == 0 ? pv6 : v2;
                float o[4];
#pragma unroll
                for (int j = 0; j < 4; ++j) { const float cg = bg[j] + wg0[j] * g2e[j] + wg1[j] * g1e[j] + wg2[j] * g[j]; const float cv = bv[j] + wv0[j] * v2e[j] + wv1[j] * v1e[j] + wv2[j] * v[j]; o[j] = gelu_tanh(cg) * cv; }
                if (fr > 0 || q >= 2) { u32x2 w; w.x = pk2(o[0], o[1]); w.y = pk2(o[2], o[3]); *(u32x2*)(act + (size_t)(tb + 8 * fr + q) * DFF + c) = w; }
                if ((fr == 0 && q < 2) || (fr == 15 && q >= 6)) { const int r = q < 2 ? q : q - 4; u32x2 wgp, wvp; wgp.x = pk2(g[0], g[1]); wgp.y = pk2(g[2], g[3]); wvp.x = pk2(v[0], v[1]); wvp.y = pk2(v[2], v[3]);
                    *(u32x2*)(hp + (size_t)r * DFF2 + c) = wgp; *(u32x2*)(hp + (size_t)r * DFF2 + DFF + c) = wvp; }
            }
        }
    }
};

struct Args { const float* in[21]; float* out; unsigned char* ws; };
typedef const __attribute__((address_space(4))) Args* ArgsP;

__device__ void p0_mod(ArgsP a, LAS unsigned char* lds, const int wv) {
    const int tid = opaque_tid(wv), w = tid >> 6, lane = tid & 63;
    const float* c = a->in[1]; const float* aw = a->in[2]; const float* ab = a->in[3]; float* mod = (float*)(a->ws + WS_MOD);
    LAS float* cs = (LAS float*)lds;
    LAS float* red = (LAS float*)(lds + 16384);
    if ((int)blockIdx.x < NL * 6144 / 64) {
        for (int i = tid; i < NB * DM; i += NTH) cs[i] = c[i];
        __syncthreads();
        const int gl = blockIdx.x * 64, l = gl / 6144, j0 = gl % 6144; const int c4 = lane & 15, kq = lane >> 4;
        const float* wp = aw + (size_t)l * DM * 6144 + (size_t)(w * 128 + kq) * 6144 + j0 + 4 * c4;
        f32x4 s0 = (f32x4){0.f, 0.f, 0.f, 0.f}, s1 = s0, s2 = s0, s3 = s0;
#pragma unroll 8
        for (int i = 0; i < 32; ++i) { const f32x4 wv4 = *(const f32x4*)(wp + (size_t)(4 * i) * 6144); const int k = w * 128 + 4 * i + kq;
            s0 += cs[k] * wv4; s1 += cs[DM + k] * wv4; s2 += cs[2 * DM + k] * wv4; s3 += cs[3 * DM + k] * wv4; }
#pragma unroll
        for (int e = 0; e < 4; ++e) { s0[e] += lane_get(s0[e], lane ^ 16); s0[e] += lane_get(s0[e], lane ^ 32); s1[e] += lane_get(s1[e], lane ^ 16); s1[e] += lane_get(s1[e], lane ^ 32);
            s2[e] += lane_get(s2[e], lane ^ 16); s2[e] += lane_get(s2[e], lane ^ 32); s3[e] += lane_get(s3[e], lane ^ 16); s3[e] += lane_get(s3[e], lane ^ 32); }
        if (kq == 0) { *(LAS f32x4*)(red + (w * 4 + 0) * 64 + 4 * c4) = s0; *(LAS f32x4*)(red + (w * 4 + 1) * 64 + 4 * c4) = s1; *(LAS f32x4*)(red + (w * 4 + 2) * 64 + 4 * c4) = s2; *(LAS f32x4*)(red + (w * 4 + 3) * 64 + 4 * c4) = s3; }
        __syncthreads();
        if (tid < 256) { const int b = tid >> 6; float sacc = ab[(size_t)l * 6144 + j0 + lane];
#pragma unroll
            for (int ww = 0; ww < 8; ++ww) sacc += red[(ww * 4 + b) * 64 + lane];
            mod[((size_t)l * NB + b) * 6144 + j0 + lane] = sacc; }
        __syncthreads();
    }
    bf16_t* gw = (bf16_t*)(a->ws + WS_GW);
    for (size_t idx = (size_t)blockIdx.x * NTH + tid; idx < (size_t)NL * 2 * 8 * 128 * 128; idx += (size_t)gridDim.x * NTH) {
        const int i = idx & 127, j = (idx >> 7) & 127, h = (idx >> 14) & 7, mat = (idx >> 17) & 1, l = (int)(idx >> 18);
        const float* src = a->in[mat ? 10 : 8];
        const float v = src[(((size_t)l * 8 + h) * 128 + i) * 128 + j];
        gw[idx] = (bf16_t)(pk2(v, v) & 0xffff);
    }
}
struct TMat { const float* W; bf16_t* Wt; int K, N, rmode, ntn; };
__device__ __forceinline__ TMat tmat_of(ArgsP a, int mi) {
    const int l = mi >> 2, k = mi & 3; bf16_t* wl = (bf16_t*)(a->ws + WS_W) + (size_t)l * W_LAYER_E; TMat m;
    if (k == 0) { m.W = a->in[5] + (size_t)l * DM * DIN; m.Wt = wl; m.K = DM; m.N = DIN; m.rmode = 1; }
    else if (k == 1) { m.W = a->in[15] + (size_t)l * DM * DM; m.Wt = wl + W_IN_E; m.K = DM; m.N = DM; m.rmode = 0; }
    else if (k == 2) { m.W = a->in[17] + (size_t)l * DM * DFF2; m.Wt = wl + W_IN_E + W_OUT_E; m.K = DM; m.N = DFF2; m.rmode = 2; }
    else { m.W = a->in[20] + (size_t)l * DFF * DM; m.Wt = wl + W_IN_E + W_OUT_E + W_UP_E; m.K = DFF; m.N = DM; m.rmode = 0; }
    m.ntn = m.N / 64; return m;
}
constexpr int TILES_IN = (DM / 64) * (DIN / 64), TILES_OUT = (DM / 64) * (DM / 64), TILES_UP = (DM / 64) * (DFF2 / 64), TILES_DN = (DFF / 64) * (DM / 64), TILES_L = TILES_IN + TILES_OUT + TILES_UP + TILES_DN;
__device__ __forceinline__ void tile_of(int g, int& mi, int& tile) {
    const int l = g / TILES_L; int r = g - l * TILES_L; int k = 0;
    if (r >= TILES_IN) { r -= TILES_IN; k = 1; if (r >= TILES_OUT) { r -= TILES_OUT; k = 2; if (r >= TILES_UP) { r -= TILES_UP; k = 3; } } }
    mi = l * 4 + k; tile = r;
}
__device__ void p0_weights(ArgsP a, LAS unsigned char* lds, const int wv) {
    const int tid = opaque_tid(wv), w = __builtin_amdgcn_readfirstlane(tid >> 6), lane = tid & 63;
    LAS float* t = (LAS float*)(lds + w * (64 * 68 * 4));
    const int NWV = gridDim.x * 8;
    for (int g = w * (int)gridDim.x + (int)blockIdx.x; g < NL * TILES_L; g += NWV) {
        int mi, tile; tile_of(g, mi, tile); const TMat m = tmat_of(a, mi);
        const int k0 = (tile / m.ntn) * 64, n0 = (tile % m.ntn) * 64;
        const float* p = m.W + (size_t)(k0 + (lane >> 4)) * m.N + n0 + (lane & 15) * 4;
        f32x4 v[16];
#pragma unroll
        for (int i = 0; i < 16; ++i) v[i] = *(const f32x4*)(p + (size_t)(4 * i) * m.N);
#pragma unroll
        for (int i = 0; i < 16; ++i) *(LAS f32x4*)(t + (4 * i + (lane >> 4)) * 68 + (lane & 15) * 4) = v[i];
        int nr = n0 + lane; if (m.rmode == 1) nr = nr < 1024 ? nr : nr < 2048 ? (1024 + ((nr - 1024) >> 7) * 256 + (nr & 127)) : nr < 5120 ? nr + 2048 : nr < 6144 ? (1024 + ((nr - 5120) >> 7) * 256 + 128 + (nr & 127)) : nr - 3072;
        else if (m.rmode == 2) nr = nr < DFF ? ((nr >> 7) * 256 + (nr & 127)) : (((nr - DFF) >> 7) * 256 + 128 + ((nr - DFF) & 127));
        bf16_t* op = m.Wt + (size_t)nr * m.K + k0;
#pragma unroll
        for (int pz = 0; pz < 8; ++pz) { float x[8];
#pragma unroll
            for (int e = 0; e < 8; ++e) x[e] = t[(pz * 8 + e) * 68 + lane];
            u32x4 o; o.x = pk2(x[0], x[1]); o.y = pk2(x[2], x[3]); o.z = pk2(x[4], x[5]); o.w = pk2(x[6], x[7]);
            *(u32x4*)(op + pz * 8) = o; }
    }
}
__device__ void norm_phase(const float* __restrict__ xf, const bf16_t* __restrict__ xbf, const float* __restrict__ g, const float* __restrict__ modl  , int shk, int sck, bf16_t* __restrict__ xn, const int wv) {
    const int tid = opaque_tid(wv); const int w = tid >> 6, lane = tid & 63;
    for (int rowp = blockIdx.x * 8 + w; rowp < MTOK / 2; rowp += gridDim.x * 8) {
        f32x4 v[2][4]; float ss[2] = {0.f, 0.f};
#pragma unroll
        for (int h = 0; h < 2; ++h) { const int row = rowp + h * (MTOK / 2);
            if (xf) { const float* xr = xf + (size_t)row * DM;
#pragma unroll
                for (int i = 0; i < 4; ++i) v[h][i] = *(const f32x4*)(xr + lane * 4 + 256 * i);
            } else { const bf16_t* xr = xbf + (size_t)row * DM;
#pragma unroll
                for (int i = 0; i < 4; ++i) { const u32x2 t = *(const u32x2*)(xr + lane * 4 + 256 * i); v[h][i] = (f32x4){bflo(t.x), bfhi(t.x), bflo(t.y), bfhi(t.y)}; } } }
#pragma unroll
        for (int h = 0; h < 2; ++h) {
#pragma unroll
            for (int i = 0; i < 4; ++i) ss[h] += v[h][i][0] * v[h][i][0] + v[h][i][1] * v[h][i][1] + v[h][i][2] * v[h][i][2] + v[h][i][3] * v[h][i][3]; }
#pragma unroll
        for (int o = 32; o >= 1; o >>= 1) { ss[0] += lane_get(ss[0], lane ^ o); ss[1] += lane_get(ss[1], lane ^ o); }
#pragma unroll
        for (int h = 0; h < 2; ++h) { const int row = rowp + h * (MTOK / 2); const int b = row / SEQ;
            const float rstd = rsqrtf(ss[h] * (1.0f / DM) + EPS);
            const float* sh = modl + (size_t)b * 6144 + shk * 1024; const float* sc = modl + (size_t)b * 6144 + sck * 1024;
#pragma unroll
            for (int i = 0; i < 4; ++i) { const int c = lane * 4 + 256 * i; const f32x4 gg = *(const f32x4*)(g + c), s1 = *(const f32x4*)(sc + c), s0 = *(const f32x4*)(sh + c);
                f32x4 y;
#pragma unroll
                for (int j = 0; j < 4; ++j) y[j] = v[h][i][j] * rstd * gg[j] * (1.0f + s1[j]) + s0[j];
                u32x2 o; o.x = pk2(y[0], y[1]); o.y = pk2(y[2], y[3]); *(u32x2*)(xn + (size_t)row * DM + c) = o; } }
    }
}
constexpr int KP = 272, VP = 136;
constexpr int ASLOT = 64 * KP + 128 * VP;
constexpr float DEAD = 1e-20f;
typedef float f32x2 __attribute__((ext_vector_type(2)));
template <bool DIAG>
__device__ __forceinline__ void sb_weights(const f32x4 (&S)[4], float& carry, unsigned (&pw)[4][2], int q, int key0, int fq, int lane) {
    {
        f32x2 w01[4], w23[4]; float T[4], ab[4];
#pragma unroll
        for (int nb = 0; nb < 4; ++nb) {
            float E[4], be[4];
#pragma unroll
            for (int e = 0; e < 4; ++e) E[e] = __builtin_amdgcn_exp2f(-__builtin_amdgcn_fmed3f(S[nb][e], -115.f, 115.f));
            const f32x2 d01 = (f32x2){E[0], E[1]} + 1.0f, d23 = (f32x2){E[2], E[3]} + 1.0f;
            be[0] = __builtin_amdgcn_rcpf(d01.x); be[1] = __builtin_amdgcn_rcpf(d01.y); be[2] = __builtin_amdgcn_rcpf(d23.x); be[3] = __builtin_amdgcn_rcpf(d23.y);
            f32x2 b01 = (f32x2){be[0], be[1]}, b23 = (f32x2){be[2], be[3]};
            f32x2 o01 = (f32x2){E[0], E[1]} * b01, o23 = (f32x2){E[2], E[3]} * b23;
            if (DIAG) { const int k = key0 + 16 * nb;
                const bool m0 = k + 0 < q, m1 = k + 1 < q, m2 = k + 2 < q, m3 = k + 3 < q;
                b01.x = m0 ? b01.x : 0.f; o01.x = m0 ? o01.x : 1.f; b01.y = m1 ? b01.y : 0.f; o01.y = m1 ? o01.y : 1.f; b23.x = m2 ? b23.x : 0.f; o23.x = m2 ? o23.x : 1.f; b23.y = m3 ? b23.y : 0.f; o23.y = m3 ? o23.y : 1.f; }
            const float s1 = o23.y * o23.x, s0 = s1 * o01.y, run = s0 * o01.x;
            w01[nb] = b01 * (f32x2){s0, s1}; w23[nb] = b23 * (f32x2){o23.y, 1.0f};
            const float g1 = lane_get(run, lane ^ 16), g2 = lane_get(run, lane ^ 32), g3 = lane_get(g1, lane ^ 32);
            const float g23 = g2 * g3; T[nb] = (run * g1) * g23; ab[nb] = fq == 0 ? (g1 * g23) : fq == 1 ? g23 : fq == 2 ? g1 : 1.f; }
        float hi = carry;
#pragma unroll
        for (int nb = 3; nb >= 0; --nb) { const float base = hi * ab[nb]; const f32x2 p01 = w01[nb] * base, p23 = w23[nb] * base;
            pw[nb][0] = pk2(p01.x, p01.y); pw[nb][1] = pk2(p23.x, p23.y); hi *= T[nb]; }
        carry = hi;
    }
}
__device__ __forceinline__ void attn_stage(LAS unsigned char* Ks, LAS unsigned char* Vt, const u32x4 (&kr)[2], const u32x4 (&vr)[2], const float (&gks)[8], int sp, int skp, int lane) {
#pragma unroll
    for (int i = 0; i < 2; ++i) { float x[8]; float ss = 0.f;
#pragma unroll
        for (int j = 0; j < 4; ++j) { x[2 * j] = bflo(kr[i][j]); x[2 * j + 1] = bfhi(kr[i][j]); ss += x[2 * j] * x[2 * j] + x[2 * j + 1] * x[2 * j + 1]; }
        ss += lane_get(ss, lane ^ 1); ss += lane_get(ss, lane ^ 2); ss += lane_get(ss, lane ^ 4); ss += lane_get(ss, lane ^ 8);
        const float rs = rsqrtf(ss * (1.0f / 128.0f) + EPS);
        u32x4 o;
#pragma unroll
        for (int j = 0; j < 4; ++j) o[j] = pk2(x[2 * j] * rs * gks[2 * j], x[2 * j + 1] * rs * gks[2 * j + 1]);
        *(LAS u32x4*)(Ks + (2 * skp + i) * KP + sp * 16) = o; }
    const int wsz = skp ^ (sp & 14);
#pragma unroll
    for (int j = 0; j < 4; ++j) { *(LAS unsigned*)(Vt + (sp * 8 + 2 * j) * VP + wsz * 4) = (vr[0][j] & 0xffffu) | (vr[1][j] << 16); *(LAS unsigned*)(Vt + (sp * 8 + 2 * j + 1) * VP + wsz * 4) = (vr[0][j] >> 16) | (vr[1][j] & 0xffff0000u); }
}
__device__ void attn_phase(ArgsP a, int l, LAS unsigned char* lds, const int wv) {
    const int tid = opaque_tid(wv), w = __builtin_amdgcn_readfirstlane(tid >> 6), lane = tid & 63, fr = lane & 15, fq = lane >> 4;
    LAS int* flags = (LAS int*)(lds + 4 * ASLOT);
    const bf16_t* Qb = (const bf16_t*)(a->ws + WS_P); bf16_t* Yb = (bf16_t*)(a->ws + WS_P);     const bf16_t* Kb = (const bf16_t*)(a->ws + WS_P + PBUF); const bf16_t* Vb = (const bf16_t*)(a->ws + WS_P + 2 * PBUF);
    const float* gq = a->in[13] + l * 128; const float* gk = a->in[14] + l * 128;
    const int sp = tid & 15, skp = tid >> 4;
    float gks[8];
#pragma unroll
    for (int e = 0; e < 8; ++e) gks[e] = gk[sp * 8 + e] * gq[sp * 8 + e];
    const int nunits = NB * 8 * (SEQ / 256);
    for (int unit = blockIdx.x; unit < nunits; unit += gridDim.x) {
        const int qt = (SEQ / 256 - 1) - unit / (NB * 8), bh = unit % (NB * 8), b = bh >> 3, hh = bh & 7;
        const size_t rowbase = (size_t)b * SEQ; const int t0 = qt * 256, r0 = t0 + 32 * w;
        const int kbw = qt * 4 + (w >> 1);
        const bf16_t* kbase = Kb + rowbase * DM + hh * 128 + sp * 8; const bf16_t* vbase = Vb + rowbase * DM + hh * 128 + sp * 8;
        u32x4 kr[2], vr[2];
#pragma unroll
        for (int h2 = 0; h2 < 2; ++h2) { u32x4 k4[2][2], v4[2][2];
#pragma unroll
          for (int i4 = 0; i4 < 2; ++i4)
#pragma unroll
              for (int i = 0; i < 2; ++i) { const size_t ro = (size_t)((qt * 4 + 2 * h2 + i4) * 64 + 2 * skp + i) * DM; k4[i4][i] = *(const u32x4*)(kbase + ro); v4[i4][i] = *(const u32x4*)(vbase + ro); }
#pragma unroll
          for (int i4 = 0; i4 < 2; ++i4) attn_stage(lds + (2 * h2 + i4) * ASLOT, lds + (2 * h2 + i4) * ASLOT + 64 * KP, k4[i4], v4[i4], gks, sp, skp, lane); }
        bf16x8 qf[2][4];
#pragma unroll
        for (int rb = 0; rb < 2; ++rb) {
            const bf16_t* qp = Qb + (rowbase + r0 + 16 * rb + fr) * DM + hh * 128 + 8 * fq; u32x4 raw[4]; float ss = 0.f;
#pragma unroll
            for (int ks = 0; ks < 4; ++ks) { raw[ks] = *(const u32x4*)(qp + 32 * ks);
#pragma unroll
                for (int j = 0; j < 4; ++j) { const float x0 = bflo(raw[ks][j]), x1 = bfhi(raw[ks][j]); ss += x0 * x0 + x1 * x1; } }
            ss += lane_get(ss, lane ^ 16); ss += lane_get(ss, lane ^ 32);
            const float rs = rsqrtf(ss * (1.0f / 128.0f) + EPS) * (0.08838834764831845f * 1.4426950408889634f);
#pragma unroll
            for (int ks = 0; ks < 4; ++ks) { u32x4 o;
#pragma unroll
                for (int j = 0; j < 4; ++j) o[j] = pk2(bflo(raw[ks][j]) * rs, bfhi(raw[ks][j]) * rs);
                qf[rb][ks] = __builtin_bit_cast(bf16x8, o); }
        }
        f32x4 O[2][8];
#pragma unroll
        for (int rb = 0; rb < 2; ++rb)
#pragma unroll
            for (int db = 0; db < 8; ++db) O[rb][db] = (f32x4){0.f, 0.f, 0.f, 0.f};
        float carry[2] = {1.f, 1.f};
        bool alive = true;
        __syncthreads();
        for (int s_ = 0;; ++s_) {
            const int kb = kbw - s_, nbn = qt * 4 - s_ - 1;
            if (nbn >= 0) {
#pragma unroll
                for (int i = 0; i < 2; ++i) { const size_t ro = (size_t)(nbn * 64 + 2 * skp + i) * DM; kr[i] = *(const u32x4*)(kbase + ro); vr[i] = *(const u32x4*)(vbase + ro); } }
            if (alive && kb >= 0) {
                const LAS unsigned char* Ks = lds + (kb & 3) * ASLOT; const LAS unsigned char* Vt = Ks + 64 * KP;
                unsigned pw[2][4][2];
#pragma unroll
                for (int rb = 0; rb < 2; ++rb) {
                    f32x4 S[4];
#pragma unroll
                    for (int nb = 0; nb < 4; ++nb) { f32x4 sacc = (f32x4){0.f, 0.f, 0.f, 0.f};
#pragma unroll
                        for (int ks = 0; ks < 4; ++ks) { const bf16x8 kf = *(const LAS bf16x8*)(Ks + (16 * nb + fr) * KP + (32 * ks + 8 * fq) * 2); sacc = __builtin_amdgcn_mfma_f32_16x16x32_bf16(kf, qf[rb][ks], sacc, 0, 0, 0); }
                        S[nb] = sacc; }
                    if (s_ == 0) sb_weights<true>(S, carry[rb], pw[rb], r0 + 16 * rb + fr, kb * 64 + 4 * fq, fq, lane);
                    else sb_weights<false>(S, carry[rb], pw[rb], r0 + 16 * rb + fr, kb * 64 + 4 * fq, fq, lane);
                }
#pragma unroll
                for (int ks2 = 0; ks2 < 2; ++ks2) {
                    bf16x8 pf[2];
#pragma unroll
                    for (int rb = 0; rb < 2; ++rb) { u32x4 t; t.x = pw[rb][2 * ks2][0]; t.y = pw[rb][2 * ks2][1]; t.z = pw[rb][2 * ks2 + 1][0]; t.w = pw[rb][2 * ks2 + 1][1]; pf[rb] = __builtin_bit_cast(bf16x8, t); }
#pragma unroll
                    for (int db = 0; db < 8; ++db) { const LAS unsigned char* vrow = Vt + (16 * db + fr) * VP;
                        const u32x2 va = *(const LAS u32x2*)(vrow + 4 * ((16 * ks2 + 2 * fq) ^ (2 * db))), vb = *(const LAS u32x2*)(vrow + 4 * ((16 * ks2 + 8 + 2 * fq) ^ (2 * db)));
                        u32x4 t; t.x = va.x; t.y = va.y; t.z = vb.x; t.w = vb.y; const bf16x8 vf = __builtin_bit_cast(bf16x8, t);
#pragma unroll
                        for (int rb = 0; rb < 2; ++rb) O[rb][db] = __builtin_amdgcn_mfma_f32_16x16x32_bf16(vf, pf[rb], O[rb][db], 0, 0, 0); }
                }
                alive = !__all((carry[0] < DEAD) && (carry[1] < DEAD));
            }
            if (lane == 0) flags[w] = (alive && kb >= 1) ? 1 : 0;
            __syncthreads();
            int any = 0;
#pragma unroll
            for (int ww = 0; ww < 8; ++ww) any |= flags[ww];
            if (!any) break;
            if (nbn >= 0) attn_stage(lds + (nbn & 3) * ASLOT, lds + (nbn & 3) * ASLOT + 64 * KP, kr, vr, gks, sp, skp, lane);
            __syncthreads();
        }
#pragma unroll
        for (int rb = 0; rb < 2; ++rb) { bf16_t* op = Yb + (rowbase + r0 + 16 * rb + fr) * DM + hh * 128 + 4 * fq;
#pragma unroll
            for (int db = 0; db < 8; ++db) { u32x2 o; o.x = pk2(O[rb][db][0], O[rb][db][1]); o.y = pk2(O[rb][db][2], O[rb][db][3]); *(u32x2*)(op + 16 * db) = o; } }
        __syncthreads();
    }
}
constexpr int XP = 272;
__device__ void rnn_phase(ArgsP a, int l, LAS unsigned char* lds, const int wv) {
    const int tid = opaque_tid(wv), w = __builtin_amdgcn_readfirstlane(tid >> 6), lane = tid & 63, fr = lane & 15, fq = lane >> 4;
    LAS unsigned char* XC = lds; LAS unsigned char* HT = lds + RT * XP; LAS unsigned char* PT = lds + 2 * RT * XP;
    const bf16_t* XR = (const bf16_t*)(a->ws + WS_P + 3 * PBUF); const bf16_t* GY = (const bf16_t*)(a->ws + WS_P + 4 * PBUF); bf16_t* SGA = (bf16_t*)(a->ws + WS_P + 4 * PBUF);
    bf16_t* M0o = (bf16_t*)(a->out);
    float* SUM = (float*)(a->ws + WS_SUM);
    const bf16_t* gw = (const bf16_t*)(a->ws + WS_GW) + (size_t)l * 2 * 8 * 16384;
    const float* cw = a->in[6] + (size_t)l * 4 * DM; const float* cb = a->in[7] + (size_t)l * DM;
    const float* ba = a->in[9] + (size_t)l * DM; const float* bx = a->in[11] + (size_t)l * DM; const float* lam = a->in[12] + (size_t)l * DM;
    const int sp = tid & 15, tg = tid >> 4;
    const int nunits = NB * 8 * NT;
    const int hh = blockIdx.x & 7, cbase = hh * 128;
    const int c = cbase + 16 * w + fr;
    const float bac = ba[c], bxc = bx[c]; const float lm = lam[c];
    const float sp8l = 8.0f * 1.4426950408889634f * (fmaxf(-lm, 0.f) + __logf(1.0f + __expf(-fabsf(lm))));
    u32x4 r[7];
    { const int unit = blockIdx.x; if (unit < nunits) { const int b = (unit >> 3) & 3, j = unit >> 5; const size_t rowbase = (size_t)b * SEQ;
#pragma unroll
        for (int i = 0; i < 7; ++i) { const int ts = j * RT + 4 * tg - 3 + i; r[i] = (u32x4){0, 0, 0, 0}; if (ts >= 0) r[i] = *(const u32x4*)(XR + (rowbase + ts) * DM + cbase + sp * 8); } } }
    for (int unit = blockIdx.x; unit < nunits; unit += gridDim.x) {
        const int b = (unit >> 3) & 3, j = unit >> 5; const int t0 = j * RT; const size_t rowbase = (size_t)b * SEQ;
        { f32x2 wv2[4][4], bv2[4];
#pragma unroll
          for (int jj = 0; jj < 4; ++jj) { bv2[jj] = *(const f32x2*)(cb + cbase + sp * 8 + 2 * jj);
#pragma unroll
              for (int k = 0; k < 4; ++k) wv2[k][jj] = *(const f32x2*)(cw + k * DM + cbase + sp * 8 + 2 * jj); }
#pragma unroll
          for (int i = 0; i < 4; ++i) { f32x2 acc2[4];
#pragma unroll
              for (int jj = 0; jj < 4; ++jj) acc2[jj] = bv2[jj];
#pragma unroll
              for (int k = 0; k < 4; ++k) {
#pragma unroll
                  for (int jj = 0; jj < 4; ++jj) acc2[jj] += wv2[k][jj] * (f32x2){bflo(r[i + k][jj]), bfhi(r[i + k][jj])}; }
              u32x4 o; o.x = pk2(acc2[0].x, acc2[0].y); o.y = pk2(acc2[1].x, acc2[1].y); o.z = pk2(acc2[2].x, acc2[2].y); o.w = pk2(acc2[3].x, acc2[3].y);
              *(LAS u32x4*)(XC + (4 * tg + i) * XP + sp * 16) = o; } }
        bf16x8 wa[4], wx[4];
        { const bf16_t* pa = gw + ((size_t)(0 * 8 + hh) * 128 + 16 * w + fr) * 128 + 8 * fq; const bf16_t* px = gw + ((size_t)(1 * 8 + hh) * 128 + 16 * w + fr) * 128 + 8 * fq;
#pragma unroll
          for (int ks = 0; ks < 4; ++ks) { wa[ks] = *(const bf16x8*)(pa + 32 * ks); wx[ks] = *(const bf16x8*)(px + 32 * ks); } }
        { const int un = unit + gridDim.x; if (un < nunits) { const int bn = (un >> 3) & 3, jn = un >> 5; const size_t rbn = (size_t)bn * SEQ;
#pragma unroll
            for (int i = 0; i < 7; ++i) { const int ts = jn * RT + 4 * tg - 3 + i; r[i] = (u32x4){0, 0, 0, 0}; if (ts >= 0) r[i] = *(const u32x4*)(XR + (rbn + ts) * DM + cbase + sp * 8); } } }
        __syncthreads();
        f32x4 A[8], U[8];
#pragma unroll
        for (int mb = 0; mb < 8; ++mb) { f32x4 ra = (f32x4){0.f, 0.f, 0.f, 0.f}, rx = ra;
#pragma unroll
            for (int ks = 0; ks < 4; ++ks) { const bf16x8 xf = *(const LAS bf16x8*)(XC + (16 * mb + fr) * XP + (32 * ks + 8 * fq) * 2);
                ra = __builtin_amdgcn_mfma_f32_16x16x32_bf16(xf, wa[ks], ra, 0, 0, 0); rx = __builtin_amdgcn_mfma_f32_16x16x32_bf16(xf, wx[ks], rx, 0, 0, 0); }
#pragma unroll
            for (int hp = 0; hp < 2; ++hp) {
                const f32x2 ta = (f32x2){ra[2 * hp], ra[2 * hp + 1]} * (-1.4426950408889634f) + (-1.4426950408889634f * bac), tx = (f32x2){rx[2 * hp], rx[2 * hp + 1]} * (-1.4426950408889634f) + (-1.4426950408889634f * bxc);
                const f32x2 da = (f32x2){__builtin_amdgcn_exp2f(ta.x), __builtin_amdgcn_exp2f(ta.y)} + 1.0f, dx = (f32x2){__builtin_amdgcn_exp2f(tx.x), __builtin_amdgcn_exp2f(tx.y)} + 1.0f;
                const f32x2 r = (f32x2){__builtin_amdgcn_rcpf(da.x), __builtin_amdgcn_rcpf(da.y)}, ig = (f32x2){__builtin_amdgcn_rcpf(dx.x), __builtin_amdgcn_rcpf(dx.y)};
                const f32x2 la2 = r * (-sp8l);
                const f32x2 av = (f32x2){__builtin_amdgcn_exp2f(la2.x), __builtin_amdgcn_exp2f(la2.y)};
                const f32x2 x2 = la2 * 1.3862943611198906f;
                const f32x2 ser = -x2 * (x2 * (x2 * (1.0f / 6.0f) + 0.5f) + 1.0f), alt = 1.0f - av * av;
                const f32x2 om = (f32x2){x2.x > -0.02f ? ser.x : alt.x, x2.y > -0.02f ? ser.y : alt.y};
                const f32x2 xc = (f32x2){bf2f(*(const LAS bf16_t*)(XC + (16 * mb + 4 * fq + 2 * hp) * XP + (16 * w + fr) * 2)), bf2f(*(const LAS bf16_t*)(XC + (16 * mb + 4 * fq + 2 * hp + 1) * XP + (16 * w + fr) * 2))};
                const f32x2 uu = (f32x2){__builtin_amdgcn_sqrtf(om.x), __builtin_amdgcn_sqrtf(om.y)} * (ig * xc);
                ra[2 * hp] = av.x; ra[2 * hp + 1] = av.y; rx[2 * hp] = uu.x; rx[2 * hp + 1] = uu.y; }
            A[mb] = ra; U[mb] = rx; }
        u32x4 mg[4];
#pragma unroll
        for (int i = 0; i < 4; ++i) { const size_t go = (rowbase + t0 + 4 * tg + i) * DM + cbase + sp * 8; mg[i] = *(const u32x4*)(GY + go); }
        float H = 0.f, Pp = 1.0f;
#pragma unroll
        for (int mb = 0; mb < 8; ++mb) {
            float Ag = A[mb][0] * A[mb][1] * A[mb][2] * A[mb][3];
            float Ug = ((U[mb][0] * A[mb][1] + U[mb][1]) * A[mb][2] + U[mb][2]) * A[mb][3] + U[mb][3];
            { const float a1 = lane_get(Ag, lane - 16), u1 = lane_get(Ug, lane - 16); if (fq >= 1) { const f32x2 t = (f32x2){u1, a1} * Ag + (f32x2){Ug, 0.f}; Ug = t.x; Ag = t.y; } }
            { const float a2 = lane_get(Ag, lane - 32), u2 = lane_get(Ug, lane - 32); if (fq >= 2) { const f32x2 t = (f32x2){u2, a2} * Ag + (f32x2){Ug, 0.f}; Ug = t.x; Ag = t.y; } }
            const float ap = lane_get(Ag, lane - 16), up = lane_get(Ug, lane - 16);
            f32x2 hp = fq == 0 ? (f32x2){H, Pp} : (f32x2){H, Pp} * ap + (f32x2){up, 0.f};
#pragma unroll
            for (int e = 0; e < 4; ++e) { hp = hp * A[mb][e] + (f32x2){U[mb][e], 0.f}; const unsigned hp2 = pk2(hp.x, hp.y); const int off = (16 * mb + 4 * fq + e) * XP + (16 * w + fr) * 2;
                *(LAS bf16_t*)(HT + off) = (bf16_t)(hp2 & 0xffff); *(LAS bf16_t*)(PT + off) = (bf16_t)(hp2 >> 16); }
            const float Am = lane_get(Ag, 48 + fr), Um = lane_get(Ug, 48 + fr);
            { const f32x2 t = (f32x2){H, Pp} * Am + (f32x2){Um, 0.f}; H = t.x; Pp = t.y; }
        }
        if (fq == 0) { float* sm = SUM + (((size_t)b * NT + j) * DM + c) * 2; sm[0] = Pp; sm[1] = H; }
        __syncthreads();
#pragma unroll
        for (int i = 0; i < 4; ++i) { const int tl = 4 * tg + i; const size_t go = (rowbase + t0 + tl) * DM + cbase + sp * 8;
            const u32x4 hv = *(const LAS u32x4*)(HT + tl * XP + sp * 16), pv = *(const LAS u32x4*)(PT + tl * XP + sp * 16);
            u32x4 o0, o1;
#pragma unroll
            for (int jj = 0; jj < 4; ++jj) { const f32x2 g2 = (f32x2){bflo(mg[i][jj]), bfhi(mg[i][jj])};
                const f32x2 m0 = g2 * (f32x2){bflo(hv[jj]), bfhi(hv[jj])}, m1 = g2 * (f32x2){bflo(pv[jj]), bfhi(pv[jj])};
                o0[jj] = pk2(m0.x, m0.y); o1[jj] = pk2(m1.x, m1.y); }
            *(u32x4*)(M0o + go) = o0; *(u32x4*)(SGA + go) = o1; }
    }
}
__device__ void mix_phase(ArgsP a, LAS unsigned char* lds, const int wv) {
    const bf16_t* M0 = (const bf16_t*)(a->out); const bf16_t* M1 = (const bf16_t*)(a->ws + WS_P + 4 * PBUF); const bf16_t* SGB = (const bf16_t*)(a->out) + (size_t)MTOK * DM; const bf16_t* YB = (const bf16_t*)(a->ws + WS_P);
    bf16_t* MIX = (bf16_t*)(a->out); const float* SUM = (const float*)(a->ws + WS_SUM);
    LAS float* hin = (LAS float*)lds;
    const int tid = opaque_tid(wv);
    for (int tile = blockIdx.x; tile < NB * NT; tile += gridDim.x) {
        const int b = tile / NT, j = tile % NT;
        { float H0 = 0.f, H1 = 0.f; const float* sp_ = SUM + ((size_t)b * NT * DM + 2 * tid) * 2;
#pragma unroll 8
          for (int jj = 0; jj < j; ++jj) { const f32x4 v = *(const f32x4*)(sp_ + (size_t)jj * DM * 2); H0 = v[0] * H0 + v[1]; H1 = v[2] * H1 + v[3]; }
          hin[2 * tid] = H0; hin[2 * tid + 1] = H1; }
        __syncthreads();
        const int pc = tid & 127, r0 = tid >> 7; const f32x4 h0 = *(const LAS f32x4*)(hin + pc * 8), h1 = *(const LAS f32x4*)(hin + pc * 8 + 4);
        const size_t rowbase = (size_t)b * SEQ + (size_t)j * RT;
#pragma unroll 8
        for (int r = r0; r < RT; r += 4) { const size_t go = (rowbase + r) * DM + pc * 8; const u32x4 m0 = *(const u32x4*)(M0 + go), m1 = *(const u32x4*)(M1 + go), sg = *(const u32x4*)(SGB + go), yb = *(const u32x4*)(YB + go); u32x4 o;
            o.x = pk2(bflo(m0.x) + bflo(m1.x) * h0[0] + bflo(sg.x) * bflo(yb.x), bfhi(m0.x) + bfhi(m1.x) * h0[1] + bfhi(sg.x) * bfhi(yb.x)); o.y = pk2(bflo(m0.y) + bflo(m1.y) * h0[2] + bflo(sg.y) * bflo(yb.y), bfhi(m0.y) + bfhi(m1.y) * h0[3] + bfhi(sg.y) * bfhi(yb.y));
            o.z = pk2(bflo(m0.z) + bflo(m1.z) * h1[0] + bflo(sg.z) * bflo(yb.z), bfhi(m0.z) + bfhi(m1.z) * h1[1] + bfhi(sg.z) * bfhi(yb.z)); o.w = pk2(bflo(m0.w) + bflo(m1.w) * h1[2] + bflo(sg.w) * bflo(yb.w), bfhi(m0.w) + bfhi(m1.w) * h1[3] + bfhi(sg.w) * bfhi(yb.w));
            *(u32x4*)(MIX + go) = o; }
        __syncthreads();
    }
}
template <class Sched>
__device__ void ffn_fixup(ArgsP a, int l, const Sched& S, const int wv) {
    bf16_t* ACT = (bf16_t*)(a->ws + WS_P); const bf16_t* HALO = (const bf16_t*)(a->ws + WS_P + ACT_BYTES);
    const float* cw = a->in[18] + (size_t)l * 3 * DFF2; const float* cb = a->in[19] + (size_t)l * DFF2;
    const int tid = opaque_tid(wv); pg8::Unit u;
    for (int ui = 0; S.next(ui, u); ++ui)
    for (int it = tid; it < 2 * (DFF / 8); it += NTH) {
        const int cgp = it % (DFF / 8), wb = 2 * u.pm + it / (DFF / 8); const int c0 = cgp * 8, t0 = wb * 128; const bool first = (t0 & (SEQ - 1)) == 0;
        const bf16_t* hc = HALO + (size_t)wb * 4 * DFF2; const bf16_t* hpv = hc - 4 * DFF2;
        u32x4 z = (u32x4){0, 0, 0, 0}; u32x4 gm2 = z, gm1 = z, vm2 = z, vm1 = z;
        if (!first) { gm2 = *(const u32x4*)(hpv + 2 * DFF2 + c0); gm1 = *(const u32x4*)(hpv + 3 * DFF2 + c0); vm2 = *(const u32x4*)(hpv + 2 * DFF2 + DFF + c0); vm1 = *(const u32x4*)(hpv + 3 * DFF2 + DFF + c0); }
        const u32x4 g0 = *(const u32x4*)(hc + c0), g1 = *(const u32x4*)(hc + DFF2 + c0), v0 = *(const u32x4*)(hc + DFF + c0), v1 = *(const u32x4*)(hc + DFF2 + DFF + c0);
        u32x4 o0, o1;
#pragma unroll
        for (int jj = 0; jj < 4; ++jj) {
            float r0[2], r1[2];
#pragma unroll
            for (int hl = 0; hl < 2; ++hl) { const int c = c0 + 2 * jj + hl;
                const float wg0 = cw[c], wg1 = cw[DFF2 + c], wg2 = cw[2 * DFF2 + c], wv0 = cw[DFF + c], wv1 = cw[DFF2 + DFF + c], wv2 = cw[2 * DFF2 + DFF + c], bg = cb[c], bv = cb[DFF + c];
                const float G2 = hl ? bfhi(gm2[jj]) : bflo(gm2[jj]), G1 = hl ? bfhi(gm1[jj]) : bflo(gm1[jj]), Ga = hl ? bfhi(g0[jj]) : bflo(g0[jj]), Gb = hl ? bfhi(g1[jj]) : bflo(g1[jj]);
                const float V2 = hl ? bfhi(vm2[jj]) : bflo(vm2[jj]), V1 = hl ? bfhi(vm1[jj]) : bflo(vm1[jj]), Va = hl ? bfhi(v0[jj]) : bflo(v0[jj]), Vb = hl ? bfhi(v1[jj]) : bflo(v1[jj]);
                r0[hl] = gelu_tanh(bg + wg0 * G2 + wg1 * G1 + wg2 * Ga) * (bv + wv0 * V2 + wv1 * V1 + wv2 * Va);
                r1[hl] = gelu_tanh(bg + wg0 * G1 + wg1 * Ga + wg2 * Gb) * (bv + wv0 * V1 + wv1 * Va + wv2 * Vb); }
            o0[jj] = pk2(r0[0], r0[1]); o1[jj] = pk2(r1[0], r1[1]); }
        *(u32x4*)(ACT + (size_t)t0 * DFF + c0) = o0; *(u32x4*)(ACT + (size_t)(t0 + 1) * DFF + c0) = o1;
    }
}
constexpr int LDS_BYTES = 137 * 1024;
__global__ void __launch_bounds__(NTH, 2) mk_fwd(Args a_unused) {
    ArgsP a = (ArgsP)__builtin_amdgcn_kernarg_segment_ptr(); asm volatile("" : "+s"(a));
    const int wv = __builtin_amdgcn_readfirstlane(threadIdx.x >> 6);
    extern __shared__ __attribute__((aligned(16))) unsigned char lds_raw[];
    LAS unsigned char* lds = (LAS unsigned char*)lds_raw;
    cg::grid_group grid = cg::this_grid();
    volatile LAS unsigned* xbst = (volatile LAS unsigned*)(lds + LDS_BYTES - 16);
    if (threadIdx.x < 4) xbst[threadIdx.x] = 0u;
    __syncthreads();
    const XcdBarrier xbar = xcd_barrier_post((unsigned*)(a->ws + WS_BAR), xbst);
    const int G = gridDim.x, bid = blockIdx.x;
    float* mod = (float*)(a->ws + WS_MOD);
    bf16_t* XN = (bf16_t*)(a->out); bf16_t* P = (bf16_t*)(a->ws + WS_P);
#ifndef REPMASK
#define REPMASK 0
#endif
#ifndef XSYNC
#define XSYNC 0
#endif
#ifndef TMASK
#define TMASK 0
#endif
    unsigned long long tacc = 0ull;
#define RUN(k, ...) for (int _r = 0; _r < (((REPMASK >> (k)) & 1) ? 2 : 1); ++_r) { const unsigned long long _t0 = ((TMASK >> (k)) & 1) ? __builtin_amdgcn_s_memrealtime() : 0ull; __VA_ARGS__ xcd_barrier(xbar, wv); if ((TMASK >> (k)) & 1) tacc += __builtin_amdgcn_s_memrealtime() - _t0; }
    if (a->out == nullptr) grid.sync();
    RUN(0, p0_mod(a, lds, wv); p0_weights(a, lds, wv);)
    for (int _x = 0; _x < XSYNC; ++_x) xcd_barrier(xbar, wv);
    for (int l = 0; l < NL; ++l) {
        const float* modl = mod + (size_t)l * NB * 6144;
        const bf16_t* wl = (const bf16_t*)(a->ws + WS_W) + (size_t)l * W_LAYER_E;
        bf16_t* XB = (bf16_t*)(a->ws + WS_XB);
        RUN(1, norm_phase(l == 0 ? a->in[0] : nullptr, XB, a->in[4] + l * DM, modl, 0, 1, XN, wv);)
        RUN(2, { pg8::Gemm g{XN, wl, MTOK, DIN, DM}; pg8::StaticOrder S; S.init(MTOK, DIN, G, bid);
          EpiIn E{P, (bf16_t*)(a->out) + (size_t)MTOK * DM}; pg8::gemm_phase<EpiIn, pg8::StaticOrder, true, true>(lds, g, S, E, wv); })
        RUN(3, attn_phase(a, l, lds, wv); rnn_phase(a, l, lds, wv);)
        RUN(7, mix_phase(a, lds, wv);)
        RUN(8, { pg8::Gemm g{XN, wl + W_IN_E, MTOK, DM, DM}; pg8::StaticOrder S; S.init(MTOK, DM, G, bid);
          EpiRes E{l == 0 ? a->in[0] : nullptr, XB, XB, nullptr, modl + 2 * 1024}; pg8::gemm_phase<EpiRes, pg8::StaticOrder, true, true>(lds, g, S, E, wv); })
        RUN(9, norm_phase(nullptr, XB, a->in[16] + l * DM, modl, 3, 4, XN, wv);)
        RUN(10, { pg8::Gemm g{XN, wl + W_IN_E + W_OUT_E, MTOK, DFF2, DM}; pg8::StaticOrder S; S.init(MTOK, DFF2, G, bid);
          EpiConvAct E{P, (bf16_t*)(a->ws + WS_P + ACT_BYTES), a->in[18] + (size_t)l * 3 * DFF2, a->in[19] + (size_t)l * DFF2};
          pg8::gemm_phase<EpiConvAct, pg8::StaticOrder, true, true, true>(lds, g, S, E, wv); })
        RUN(12, { pg8::Gemm g{P, wl + W_IN_E + W_OUT_E + W_UP_E, MTOK, DM, DFF}; pg8::StaticOrder S; S.init(MTOK, DM, G, bid);
          ffn_fixup(a, l, S, wv); asm volatile("s_waitcnt vmcnt(0)" ::: "memory"); __syncthreads();
          EpiRes E{nullptr, XB, XB, l == NL - 1 ? a->out : nullptr, modl + 5 * 1024}; pg8::gemm_phase<EpiRes, pg8::StaticOrder, true, true>(lds, g, S, E, wv); })
    }
    if (TMASK != 0 && blockIdx.x == 0) { const unsigned long long t0 = __builtin_amdgcn_s_memrealtime(); while (__builtin_amdgcn_s_memrealtime() - t0 < tacc) __builtin_amdgcn_s_sleep(8); }
}
extern "C" void kernel_launch(void* const* d_in, const int* in_sizes, int n_in, void* d_out, int out_size, void* d_ws, size_t ws_size, hipStream_t stream) {
    static int grid = 0;
    if (!grid) {
        int dev = 0, cus = 0, per_cu = 0;
        (void)hipGetDevice(&dev);
        (void)hipDeviceGetAttribute(&cus, hipDeviceAttributeMultiprocessorCount, dev);
        (void)hipFuncSetAttribute((const void*)mk_fwd, hipFuncAttributeMaxDynamicSharedMemorySize, LDS_BYTES);
        (void)hipOccupancyMaxActiveBlocksPerMultiprocessor(&per_cu, (const void*)mk_fwd, NTH, LDS_BYTES);
        if (per_cu < 1) per_cu = 1;
        grid = cus * per_cu;
        if (ws_size < WS_END) { fprintf(stderr, "kernel_launch: workspace too small: %zu < %zu\n", ws_size, (size_t)WS_END); grid = -1; }
        if (n_in != 21 || out_size != MTOK * DM) { fprintf(stderr, "kernel_launch: unexpected shapes\n"); grid = -1; }
    }
    if (grid < 0) return;
    (void)hipMemsetAsync((char*)d_ws + WS_BAR, 0, XCD_BAR_WORDS * 4, stream);
    Args a{};
    for (int i = 0; i < 21; ++i) a.in[i] = (const float*)d_in[i];
    a.out = (float*)d_out; a.ws = (unsigned char*)d_ws;
    void* args[] = {&a};
    hipError_t e = hipLaunchCooperativeKernel((const void*)mk_fwd, dim3(grid), dim3(NTH), args, LDS_BYTES, stream);
    if (e != hipSuccess) fprintf(stderr, "cooperative launch failed: %s (grid %d)\n", hipGetErrorString(e), grid);
}
```

```cpp
#include <hip/hip_runtime.h>
#include <hip/hip_cooperative_groups.h>
#include <cstdio>
#include <cstdint>
namespace cg = cooperative_groups;
__device__ __forceinline__ int opaque_tid(int wv) { int t; asm volatile("v_mbcnt_lo_u32_b32 %0, -1, 0\n\tv_mbcnt_hi_u32_b32 %0, -1, %0" : "=v"(t)); return t | (wv << 6); }
__device__ __forceinline__ int opaque_bid() { int t = blockIdx.x; asm volatile("" : "+s"(t)); return t; }
namespace pg8 {
#define PG8_LAS __attribute__((address_space(3)))
typedef unsigned short bf16_t;
typedef short bf16x8 __attribute__((ext_vector_type(8)));
typedef float f32x4 __attribute__((ext_vector_type(4)));
typedef unsigned u32x4 __attribute__((ext_vector_type(4)));
constexpr int BM = 256, BK = 64, HALF = 128, HTB = HALF * BK * 2  , STAGE_BYTES = 8 * HTB, NXCD = 8, WGM = 8;

__host__ __device__ __forceinline__ int lds_byte(int r, int c) { const int st = (r >> 4) * 2 + (c >> 5), rr = r & 15, cc = c & 31, ob = rr * 64 + cc * 2; return st * 1024 + (ob ^ (((ob >> 9) & 1) << 5)); }
__host__ __device__ __forceinline__ void stage_rc(int b, int& R, int& C) { const int st = b / 1024, sb = b % 1024, swz = sb ^ (((sb >> 9) & 1) << 5); R = (st >> 1) * 16 + swz / 64; C = (st & 1) * 32 + (swz % 64) / 2; }
__host__ __device__ __forceinline__ int perm32(int rho) { const int n = rho >> 4, i = rho & 15; return 8 * (i >> 2) + 4 * n + (i & 3); }

struct Unit { int pm, pn; };
struct Gemm { const bf16_t* A; const bf16_t* Bt; int M, N, K; };

struct StaticOrder {
    int nM, nN, nwg, G, c;
    __host__ __device__ void init(int M, int N, int G_, int c_) { nM = M / BM; nN = N / BM; nwg = nM * nN; G = G_; c = c_; }
    __host__ __device__ bool next(int i, Unit& u) const {
        const long L = (long)i * G + c; if (L >= nwg) return false;
        int wgid = (int)L; { const int q = nwg / NXCD, r = nwg % NXCD, xcd = wgid % NXCD, off = wgid / NXCD; wgid = (xcd < r ? xcd * (q + 1) : r * (q + 1) + (xcd - r) * q) + off; }
        const int nig = WGM * nN, gid = wgid / nig, fm = gid * WGM, gsz = (nM - fm) < WGM ? (nM - fm) : WGM;
        u.pm = fm + ((wgid % nig) % gsz); u.pn = (wgid % nig) / gsz; return true;
    }
    __device__ __forceinline__ void a_ready(const Unit&) const {}
    __device__ __forceinline__ void done(const Unit&) const {}
};

template <class Epi, class Sched, bool ALIGN_EPI = false, bool SP2 = false, bool ROWPERM = false>
__device__ __forceinline__ void gemm_phase(PG8_LAS unsigned char* lds, const Gemm g, const Sched& S, const Epi& E, const int wv) {
    const int tid = opaque_tid(wv), wid = __builtin_amdgcn_readfirstlane(tid >> 6), lane = tid & 63, wr = wid >> 2, wc = wid & 3, fr = lane & 15, fq = lane >> 4;
    const int K = g.K, nt = K / BK;
    unsigned voffA[2], voffB[2];
#pragma unroll
    for (int i = 0; i < 2; ++i) { int R, C; stage_rc(tid * 16 + i * 8192, R, C); const int Rb = Epi::PERM ? ((R & ~31) + perm32(R & 31)) : R;
        const int Ra = ROWPERM ? (128 * (R >> 6) + 8 * (R & 15) + ((R >> 4) & 3)) : R;
        voffA[i] = (unsigned)(Ra * K + C) * 2u; voffB[i] = (unsigned)(Rb * K + C) * 2u; }
    const size_t kstep = (size_t)(BK * 2);
    const size_t hstep = (size_t)HALF * K * 2;
    const size_t tstep = 2 * hstep; const size_t hstepA = ROWPERM ? (size_t)4 * K * 2 : hstep;
    const unsigned ldsw = (unsigned)wid * 1024u;
    const int aoff = lds_byte(wr * 64 + fr, fq * 8), boff = lds_byte(wc * 32 + fr, fq * 8);
#define PG8_SA(b, h) (((b) * 2 + (h)) * HTB)
#define PG8_SB(b, h) ((4 + (b) * 2 + (h)) * HTB)
#define PG8_STAGE(bufoff, gbase, voff) do { _Pragma("unroll") for (int _i = 0; _i < 2; ++_i) \
        __builtin_amdgcn_global_load_lds((const unsigned*)((const char*)(gbase) + (voff)[_i]), (PG8_LAS unsigned*)(lds + (bufoff) + ldsw + _i * 8192), 16, 0, 0); } while (0)
#define PG8_LDA(dst, b, h) do { _Pragma("unroll") for (int m = 0; m < 4; ++m) _Pragma("unroll") for (int k = 0; k < 2; ++k) dst[m][k] = *(const PG8_LAS bf16x8*)(lds + PG8_SA(b, h) + aoff + m * 2048 + k * 1024); } while (0)
#define PG8_LDB(dst, b, h) do { _Pragma("unroll") for (int n = 0; n < 2; ++n) _Pragma("unroll") for (int k = 0; k < 2; ++k) dst[n][k] = *(const PG8_LAS bf16x8*)(lds + PG8_SB(b, h) + boff + n * 2048 + k * 1024); } while (0)
#define PG8_MMA(ai, bj, At, Bt) do { __builtin_amdgcn_s_setprio(1); _Pragma("unroll") for (int m = 0; m < 4; ++m) _Pragma("unroll") for (int n = 0; n < 2; ++n) _Pragma("unroll") for (int k = 0; k < 2; ++k) \
        acc[ai][bj][m][n] = __builtin_amdgcn_mfma_f32_16x16x32_bf16(Bt[n][k], At[m][k], acc[ai][bj][m][n], 0, 0, 0); __builtin_amdgcn_s_setprio(0); } while (0)
#define PG8_WAIT_V(n) asm volatile("s_waitcnt vmcnt(" #n ")" ::: "memory")
#define PG8_WAIT_L(n) asm volatile("s_waitcnt lgkmcnt(" #n ")" ::: "memory")
#define PG8_BAR __builtin_amdgcn_s_barrier()
#define PG8_SCHED __builtin_amdgcn_sched_barrier(0)
    Unit cur, nxt; int ui = 0;
    if (!S.next(0, cur)) return;
    f32x4 acc[2][2][4][2];
#pragma unroll
    for (int a = 0; a < 2; ++a)
#pragma unroll
        for (int b = 0; b < 2; ++b)
#pragma unroll
            for (int m = 0; m < 4; ++m)
#pragma unroll
                for (int n = 0; n < 2; ++n) acc[a][b][m][n] = (f32x4){0.f, 0.f, 0.f, 0.f};
    bf16x8 At[4][2], B0[2][2], B1[2][2];
    const char* cA = (const char*)g.A + (size_t)cur.pm * tstep; const char* cB = (const char*)g.Bt + (size_t)cur.pn * tstep;
    S.a_ready(cur);
    if constexpr (SP2) {
        PG8_STAGE(PG8_SB(0, 0), cB, voffB); PG8_STAGE(PG8_SB(0, 1), cB + hstep, voffB); PG8_STAGE(PG8_SA(0, 0), cA, voffA); PG8_STAGE(PG8_SA(0, 1), cA + hstepA, voffA);
        if (wr == 1) PG8_BAR;
        PG8_WAIT_V(2); PG8_BAR;
        PG8_STAGE(PG8_SB(1, 0), cB + kstep, voffB); PG8_STAGE(PG8_SA(1, 0), cA + kstep, voffA); PG8_STAGE(PG8_SB(1, 1), cB + hstep + kstep, voffB);
        PG8_WAIT_V(6); PG8_BAR;
    } else {
        PG8_STAGE(PG8_SB(0, 0), cB, voffB); PG8_STAGE(PG8_SA(0, 0), cA, voffA); PG8_STAGE(PG8_SB(0, 1), cB + hstep, voffB); PG8_STAGE(PG8_SA(0, 1), cA + hstepA, voffA);
        if (wr == 1) PG8_BAR;
        PG8_WAIT_V(4); PG8_BAR;
        PG8_STAGE(PG8_SB(1, 0), cB + kstep, voffB); PG8_STAGE(PG8_SA(1, 0), cA + kstep, voffA); PG8_STAGE(PG8_SB(1, 1), cB + hstep + kstep, voffB);
        PG8_WAIT_V(6); PG8_BAR;
    }
    for (;;) {
        const bool has_next = S.next(ui + 1, nxt);
        const char* nA = has_next ? (const char*)g.A + (size_t)nxt.pm * tstep : cA; const char* nB = has_next ? (const char*)g.Bt + (size_t)nxt.pn * tstep : cB;
        for (int t = 0; t < nt; t += 2) {
            const bool last = (t == nt - 2);
            const char* a1 = cA + (size_t)(t + 1) * kstep;
            const char* a2 = last ? nA : cA + (size_t)(t + 2) * kstep; const char* b2 = last ? nB : cB + (size_t)(t + 2) * kstep;
            const char* a3 = a2 + kstep; const char* b3 = b2 + kstep;
            if (last && has_next) S.a_ready(nxt);
            if constexpr (SP2) {
            PG8_LDB(B0, 0, 0); PG8_LDB(B1, 0, 1); PG8_SCHED; PG8_LDA(At, 0, 0); PG8_STAGE(PG8_SA(1, 1), a1 + hstepA, voffA);
            PG8_WAIT_V(8); PG8_WAIT_L(0); PG8_BAR; PG8_MMA(0, 0, At, B0); PG8_MMA(0, 1, At, B1); PG8_BAR; PG8_SCHED;
            PG8_LDA(At, 0, 1); PG8_STAGE(PG8_SB(0, 0), b2, voffB); PG8_STAGE(PG8_SB(0, 1), b2 + hstep, voffB); PG8_STAGE(PG8_SA(0, 0), a2, voffA);
            PG8_WAIT_V(8); PG8_WAIT_L(0); PG8_BAR; PG8_MMA(1, 0, At, B0); PG8_MMA(1, 1, At, B1); PG8_BAR; PG8_SCHED;
            PG8_LDB(B0, 1, 0); PG8_LDB(B1, 1, 1); PG8_SCHED; PG8_LDA(At, 1, 0); PG8_STAGE(PG8_SA(0, 1), a2 + hstepA, voffA);
            PG8_WAIT_V(8); PG8_WAIT_L(0); PG8_BAR; PG8_MMA(0, 0, At, B0); PG8_MMA(0, 1, At, B1); PG8_BAR; PG8_SCHED;
            PG8_LDA(At, 1, 1); PG8_STAGE(PG8_SB(1, 0), b3, voffB); PG8_STAGE(PG8_SB(1, 1), b3 + hstep, voffB); PG8_STAGE(PG8_SA(1, 0), a3, voffA);
            PG8_WAIT_V(8); PG8_WAIT_L(0); PG8_BAR; PG8_MMA(1, 0, At, B0); PG8_MMA(1, 1, At, B1); PG8_BAR; PG8_SCHED;
            } else {
            PG8_LDB(B0, 0, 0); PG8_SCHED; PG8_LDA(At, 0, 0); PG8_STAGE(PG8_SA(1, 1), a1 + hstepA, voffA);
            PG8_WAIT_L(8); PG8_BAR; PG8_WAIT_L(0); PG8_MMA(0, 0, At, B0); PG8_BAR; PG8_SCHED;
            PG8_LDB(B1, 0, 1); PG8_STAGE(PG8_SB(0, 0), b2, voffB);
            PG8_BAR; PG8_WAIT_L(0); PG8_MMA(0, 1, At, B1); PG8_BAR;
            PG8_LDA(At, 0, 1); PG8_STAGE(PG8_SA(0, 0), a2, voffA);
            PG8_BAR; PG8_WAIT_L(0); PG8_MMA(1, 0, At, B0); PG8_BAR; PG8_SCHED;
            PG8_STAGE(PG8_SB(0, 1), b2 + hstep, voffB);
            PG8_WAIT_V(6); PG8_BAR; PG8_MMA(1, 1, At, B1); PG8_BAR;
            PG8_LDB(B0, 1, 0); PG8_SCHED; PG8_LDA(At, 1, 0); PG8_STAGE(PG8_SA(0, 1), a2 + hstepA, voffA);
            PG8_WAIT_L(8); PG8_BAR; PG8_WAIT_L(0); PG8_MMA(0, 0, At, B0); PG8_BAR; PG8_SCHED;
            PG8_LDB(B1, 1, 1); PG8_STAGE(PG8_SB(1, 0), b3, voffB);
            PG8_BAR; PG8_WAIT_L(0); PG8_MMA(0, 1, At, B1); PG8_BAR;
            PG8_LDA(At, 1, 1); PG8_STAGE(PG8_SA(1, 0), a3, voffA);
            PG8_BAR; PG8_WAIT_L(0); PG8_MMA(1, 0, At, B0); PG8_BAR; PG8_SCHED;
            PG8_STAGE(PG8_SB(1, 1), b3 + hstep, voffB);
            PG8_WAIT_V(6); PG8_BAR; PG8_MMA(1, 1, At, B1); PG8_BAR;
            }
        }
        if constexpr (ALIGN_EPI) { if (wr == 0) PG8_BAR; }
        if constexpr (!Epi::AFTER_DRAIN) { E(acc, cur, wr, wc, fr, fq); S.done(cur); }
        if (!has_next) break;
#pragma unroll
        for (int a = 0; a < 2; ++a)
#pragma unroll
            for (int b = 0; b < 2; ++b)
#pragma unroll
                for (int m = 0; m < 4; ++m)
#pragma unroll
                    for (int n = 0; n < 2; ++n) acc[a][b][m][n] = (f32x4){0.f, 0.f, 0.f, 0.f};
        cur = nxt; cA = nA; cB = nB; ++ui;
        if constexpr (ALIGN_EPI) { if (wr == 1) PG8_BAR; }
    }
    PG8_WAIT_V(0);
    if constexpr (!ALIGN_EPI) { if (wr == 0) PG8_BAR; }
    PG8_BAR;
    if constexpr (Epi::AFTER_DRAIN) { E.fused(acc, cur, wr, wc, fr, fq, lds, wid, lane); S.done(cur); }
#undef PG8_SA
#undef PG8_SB
#undef PG8_STAGE
#undef PG8_LDA
#undef PG8_LDB
#undef PG8_MMA
#undef PG8_WAIT_V
#undef PG8_WAIT_L
#undef PG8_BAR
#undef PG8_SCHED
}
}
typedef pg8::bf16_t bf16_t;
typedef pg8::bf16x8 bf16x8;
typedef pg8::f32x4 f32x4;
typedef pg8::u32x4 u32x4;
typedef unsigned u32x2 __attribute__((ext_vector_type(2)));
#define LAS __attribute__((address_space(3)))

constexpr int DM = 1024, NB = 4, SEQ = 8192, MTOK = NB * SEQ, DIN = 7168, DFF = 3072, DFF2 = 6144, NL = 2;
constexpr int NTH = 512;
constexpr float EPS = 1e-6f;
constexpr int RT = 128, NT = SEQ / RT;
constexpr size_t WS_BAR = 0;
constexpr size_t WS_MOD = 16384;
constexpr size_t WS_GW = WS_MOD + (size_t)NL * NB * 6144 * 4;
constexpr size_t WS_SUM = WS_GW + (size_t)NL * 2 * 8 * 128 * 128 * 2;
constexpr size_t WS_HIN = WS_SUM + (size_t)NB * NT * 1024 * 2 * 4;
constexpr size_t WS_W = (WS_HIN + (size_t)NB * NT * 1024 * 4 + 4095) / 4096 * 4096;
constexpr size_t W_IN_E = (size_t)DIN * DM, W_OUT_E = (size_t)DM * DM, W_UP_E = (size_t)DFF2 * DM, W_DN_E = (size_t)DM * DFF, W_LAYER_E = W_IN_E + W_OUT_E + W_UP_E + W_DN_E;
constexpr size_t WS_XN = WS_W + NL * W_LAYER_E * 2;
constexpr size_t PBUF = (size_t)MTOK * DM * 2;
constexpr size_t WS_P = WS_XN + PBUF;
constexpr size_t WS_XB = WS_XN;
constexpr size_t WS_END = WS_P + 5 * PBUF;
constexpr size_t ACT_BYTES = (size_t)MTOK * DFF * 2;

__device__ __forceinline__ float bf2f(bf16_t b) { return __uint_as_float(((unsigned)b) << 16); }
__device__ __forceinline__ unsigned pk2(float lo, float hi) { unsigned r; asm volatile("v_cvt_pk_bf16_f32 %0, %1, %2" : "=v"(r) : "v"(lo), "v"(hi)); return r; }
__device__ __forceinline__ float bflo(unsigned w) { return __uint_as_float(w << 16); }
__device__ __forceinline__ float bfhi(unsigned w) { return __uint_as_float(w & 0xffff0000u); }
__device__ __forceinline__ float lane_get(float x, int srclane) { return __builtin_bit_cast(float, __builtin_amdgcn_ds_bpermute(srclane << 2, __builtin_bit_cast(int, x))); }
__device__ __forceinline__ float sigmoidf_(float x) { return __builtin_amdgcn_rcpf(1.0f + __expf(-x)); }
__device__ __forceinline__ float gelu_tanh(float x) { const float u = 1.5957691216057308f * (x + 0.044715f * x * x * x); return x * sigmoidf_(u); }

__device__ __forceinline__ pg8::f32x4 exp2_4(pg8::f32x4 t) { return (pg8::f32x4){__builtin_amdgcn_exp2f(t[0]), __builtin_amdgcn_exp2f(t[1]), __builtin_amdgcn_exp2f(t[2]), __builtin_amdgcn_exp2f(t[3])}; }
__device__ __forceinline__ pg8::f32x4 rcp_4(pg8::f32x4 t) { return (pg8::f32x4){__builtin_amdgcn_rcpf(t[0]), __builtin_amdgcn_rcpf(t[1]), __builtin_amdgcn_rcpf(t[2]), __builtin_amdgcn_rcpf(t[3])}; }
__device__ __forceinline__ pg8::f32x4 gelu_den4(pg8::f32x4 x) { return exp2_4(x * (x * x * (0.044715f * -2.3022082f) + -2.3022082f)) + 1.0f; }
__device__ __forceinline__ pg8::f32x4 sig_den4(pg8::f32x4 x) { return exp2_4(x * -1.4426950408889634f) + 1.0f; }

struct EpiSplit {
    static constexpr bool PERM = true, AFTER_DRAIN = false;
    bf16_t* base; size_t tstride; int modes; int skip3;
    __device__ __forceinline__ void operator()(const f32x4 (&acc)[2][2][4][2], const pg8::Unit& u, int wr, int wc, int fr, int fq) const {
        const int colt = u.pn * 256, t = colt >> 10; const int mode = (modes >> (4 * t)) & 15;
        bf16_t* o = base + (size_t)(t + ((skip3 && t == 3) ? 1 : 0)) * tstride; const int col0 = (colt & 1023) + wc * 32 + 8 * fq; const int row0 = u.pm * 256 + wr * 64 + fr;
#pragma unroll
        for (int ai = 0; ai < 2; ++ai)
#pragma unroll
            for (int m = 0; m < 4; ++m) { bf16_t* rowp = o + (size_t)(row0 + ai * 128 + m * 16) * DM + col0;
#pragma unroll
                for (int bj = 0; bj < 2; ++bj) { f32x4 v0 = acc[ai][bj][m][0], v1 = acc[ai][bj][m][1];
                    if (mode == 1) {
#pragma unroll
                        for (int j = 0; j < 4; ++j) { v0[j] = gelu_tanh(v0[j]); v1[j] = gelu_tanh(v1[j]); } }
                    else if (mode == 2) {
#pragma unroll
                        for (int j = 0; j < 4; ++j) { v0[j] = sigmoidf_(v0[j]); v1[j] = sigmoidf_(v1[j]); } }
                    u32x4 w; w.x = pk2(v0[0], v0[1]); w.y = pk2(v0[2], v0[3]); w.z = pk2(v1[0], v1[1]); w.w = pk2(v1[2], v1[3]);
                    *(u32x4*)(rowp + bj * 128) = w; } }
    }
};
struct EpiIn {
    static constexpr bool PERM = true, AFTER_DRAIN = false;
    bf16_t* P; bf16_t* P5;
    __device__ __forceinline__ void operator()(const f32x4 (&acc)[2][2][4][2], const pg8::Unit& u, int wr, int wc, int fr, int fq) const {
        const int row0 = u.pm * 256 + wr * 64 + fr; const int pn = u.pn;
        if (pn >= 4 && pn < 12) {
            bf16_t* o = P + (size_t)4 * MTOK * DM + (pn - 4) * 128 + wc * 32 + 8 * fq;
#pragma unroll
            for (int ai = 0; ai < 2; ++ai)
#pragma unroll
                for (int m = 0; m < 4; ++m) { float g[8];
                    { const f32x4 g0 = acc[ai][0][m][0] * rcp_4(gelu_den4(acc[ai][0][m][0]) * sig_den4(acc[ai][1][m][0])), g1 = acc[ai][0][m][1] * rcp_4(gelu_den4(acc[ai][0][m][1]) * sig_den4(acc[ai][1][m][1]));
                      g[0] = g0[0]; g[1] = g0[1]; g[2] = g0[2]; g[3] = g0[3]; g[4] = g1[0]; g[5] = g1[1]; g[6] = g1[2]; g[7] = g1[3]; }
                    u32x4 w; w.x = pk2(g[0], g[1]); w.y = pk2(g[2], g[3]); w.z = pk2(g[4], g[5]); w.w = pk2(g[6], g[7]);
                    *(u32x4*)(o + (size_t)(row0 + ai * 128 + m * 16) * DM) = w; }
        } else {
            const bool sg = pn >= 12 && pn < 16;
            bf16_t* o = (pn < 4 ? P + (size_t)3 * MTOK * DM + pn * 256 : sg ? P5 + (pn - 12) * 256 : P + (size_t)((pn - 16) >> 2) * MTOK * DM + ((pn - 16) & 3) * 256) + wc * 32 + 8 * fq;
#pragma unroll
            for (int ai = 0; ai < 2; ++ai)
#pragma unroll
                for (int m = 0; m < 4; ++m) { bf16_t* rowp = o + (size_t)(row0 + ai * 128 + m * 16) * DM;
#pragma unroll
                    for (int bj = 0; bj < 2; ++bj) { f32x4 v0 = acc[ai][bj][m][0], v1 = acc[ai][bj][m][1];
                        if (sg) { v0 = rcp_4(sig_den4(v0)); v1 = rcp_4(sig_den4(v1)); }
                        u32x4 w; w.x = pk2(v0[0], v0[1]); w.y = pk2(v0[2], v0[3]); w.z = pk2(v1[0], v1[1]); w.w = pk2(v1[2], v1[3]);
                        *(u32x4*)(rowp + bj * 128) = w; } }
        }
    }
};
struct EpiPlain {
    static constexpr bool PERM = true, AFTER_DRAIN = false;
    bf16_t* o; int ldc;
    __device__ __forceinline__ void operator()(const f32x4 (&acc)[2][2][4][2], const pg8::Unit& u, int wr, int wc, int fr, int fq) const {
        const int col0 = u.pn * 256 + wc * 32 + 8 * fq; const int row0 = u.pm * 256 + wr * 64 + fr;
#pragma unroll
        for (int ai = 0; ai < 2; ++ai)
#pragma unroll
            for (int m = 0; m < 4; ++m) { bf16_t* rowp = o + (size_t)(row0 + ai * 128 + m * 16) * ldc + col0;
#pragma unroll
                for (int bj = 0; bj < 2; ++bj) { const f32x4 v0 = acc[ai][bj][m][0], v1 = acc[ai][bj][m][1];
                    u32x4 w; w.x = pk2(v0[0], v0[1]); w.y = pk2(v0[2], v0[3]); w.z = pk2(v1[0], v1[1]); w.w = pk2(v1[2], v1[3]);
                    *(u32x4*)(rowp + bj * 128) = w; } }
    }
};
struct EpiRes {
    static constexpr bool PERM = true, AFTER_DRAIN = false;
    const float* resf; const bf16_t* resb; bf16_t* xb; float* outf; const float* gate  ;
    __device__ __forceinline__ void operator()(const f32x4 (&acc)[2][2][4][2], const pg8::Unit& u, int wr, int wc, int fr, int fq) const {
        const int grow0 = u.pm * 256; const int b = grow0 / SEQ; const int row0 = grow0 + wr * 64 + fr, col0 = u.pn * 256 + wc * 32 + 8 * fq;
        f32x4 gv[2][2];
#pragma unroll
        for (int bj = 0; bj < 2; ++bj)
#pragma unroll
            for (int n = 0; n < 2; ++n) gv[bj][n] = *(const f32x4*)(gate + (size_t)b * 6144 + col0 + bj * 128 + n * 4);
#pragma unroll
        for (int am = 0; am < 4; ++am) { const int ai = am >> 1, m0 = (am & 1) * 2;
            f32x4 rv[2][2][2];
            if (resf) {
#pragma unroll
                for (int mm = 0; mm < 2; ++mm) { const size_t off = (size_t)(row0 + ai * 128 + (m0 + mm) * 16) * DM + col0;
#pragma unroll
                    for (int bj = 0; bj < 2; ++bj)
#pragma unroll
                        for (int n = 0; n < 2; ++n) rv[mm][bj][n] = *(const f32x4*)(resf + off + bj * 128 + n * 4); }
            } else {
#pragma unroll
                for (int mm = 0; mm < 2; ++mm) { const size_t off = (size_t)(row0 + ai * 128 + (m0 + mm) * 16) * DM + col0;
#pragma unroll
                    for (int bj = 0; bj < 2; ++bj) { const u32x4 rw = *(const u32x4*)(resb + off + bj * 128);
                        rv[mm][bj][0] = (f32x4){bflo(rw.x), bfhi(rw.x), bflo(rw.y), bfhi(rw.y)}; rv[mm][bj][1] = (f32x4){bflo(rw.z), bfhi(rw.z), bflo(rw.w), bfhi(rw.w)}; } }
            }
#pragma unroll
            for (int mm = 0; mm < 2; ++mm) { const int m = m0 + mm; const size_t off = (size_t)(row0 + ai * 128 + m * 16) * DM + col0;
#pragma unroll
                for (int bj = 0; bj < 2; ++bj) { const f32x4 y0 = rv[mm][bj][0] + gv[bj][0] * acc[ai][bj][m][0], y1 = rv[mm][bj][1] + gv[bj][1] * acc[ai][bj][m][1];
                    if (outf) { *(f32x4*)(outf + off + bj * 128) = y0; *(f32x4*)(outf + off + bj * 128 + 4) = y1; }
                    else { u32x4 w; w.x = pk2(y0[0], y0[1]); w.y = pk2(y0[2], y0[3]); w.z = pk2(y1[0], y1[1]); w.w = pk2(y1[2], y1[3]); *(u32x4*)(xb + off + bj * 128) = w; } } }
            asm volatile("" ::: "memory"); }
    }
};


#define XB_TMO      128
#define XB_XCNT(j)  (256  + 64 * (j))
#define XB_XSUB(j)  (1280 + 64 * (j))
#define XB_XGEN(j)  (2304 + 64 * (j))
#define XB_TOP      3328
#define XB_TOPGEN   3392
#define XCD_BAR_WORDS 3456
#define XB_SPIN_CAP (1u << 22)
__device__ __forceinline__ unsigned xb_ld(unsigned* p)              { return __hip_atomic_load(p, __ATOMIC_RELAXED, __HIP_MEMORY_SCOPE_AGENT); }
__device__ __forceinline__ unsigned xb_add(unsigned* p, unsigned v) { return __hip_atomic_fetch_add(p, v, __ATOMIC_RELAXED, __HIP_MEMORY_SCOPE_AGENT); }
__device__ __forceinline__ unsigned xb_xcc_id() { return (unsigned)__builtin_amdgcn_s_getreg((3 << 11) | 20) & 0xFu; }
#define XB_SPIN(cond, bar) do { unsigned _sp = 0; while (cond) { __builtin_amdgcn_s_sleep(1); \
    if ((++_sp & 255u) == 0u) { if (xb_ld(&(bar)[XB_TMO])) break; if (_sp > XB_SPIN_CAP) { atomicAdd(&(bar)[XB_TMO], 1u); break; } } } } while (0)
struct XcdBarrier { unsigned* bar; unsigned x; volatile LAS unsigned* st; };
__device__ __forceinline__ XcdBarrier xcd_barrier_post(unsigned* bar, volatile LAS unsigned* st) {
    XcdBarrier b; b.bar = bar; b.x = xb_xcc_id(); b.st = st;
    if (threadIdx.x == 0) (void)xb_add(&bar[XB_XCNT(b.x)], 1u);
    return b;
}
__device__ __forceinline__ void xcd_barrier_complete(unsigned* bar, unsigned x, unsigned& nloc, unsigned& nx) {
    const unsigned G = gridDim.x * gridDim.y * gridDim.z;
    unsigned sum, cnt, mine, sp = 0u;
    for (;;) {
        sum = 0u; cnt = 0u; mine = 0u;
#pragma unroll
        for (unsigned j = 0; j < 16; ++j) { const unsigned c = xb_ld(&bar[XB_XCNT(j)]); sum += c; cnt += (c > 0u) ? 1u : 0u; mine = (j == x) ? c : mine; }
        if (sum == G) break;
        __builtin_amdgcn_s_sleep(1);
        if ((++sp & 255u) == 0u) { if (xb_ld(&bar[XB_TMO])) break; if (sp > XB_SPIN_CAP) { atomicAdd(&bar[XB_TMO], 1u); break; } }
    }
    nloc = mine > 0u ? mine : 1u; nx = cnt > 0u ? cnt : 1u;
}
__device__ __forceinline__ void xcd_barrier(const XcdBarrier& b, const int wv) {
    asm volatile("s_waitcnt vmcnt(0)" ::: "memory");
    __syncthreads();
    if (opaque_tid(wv) == 0) {
        unsigned* bar = b.bar;
        __builtin_amdgcn_s_waitcnt(0);
        unsigned nloc = b.st[0], nx = b.st[1];
        if (nloc == 0u) { xcd_barrier_complete(bar, b.x, nloc, nx); b.st[0] = nloc; b.st[1] = nx; }
        const unsigned old = xb_add(&bar[XB_XSUB(b.x)], 1u);
        const unsigned gen = old / nloc;
        if (old + 1u == (gen + 1u) * nloc) {
            __builtin_amdgcn_fence(__ATOMIC_RELEASE, "agent");
            asm volatile("s_waitcnt vmcnt(0)" ::: "memory");
            const unsigned og = xb_add(&bar[XB_TOP], 1u);
            const unsigned tg = og / nx;
            if (og + 1u == (tg + 1u) * nx) xb_add(&bar[XB_TOPGEN], 1u);
            else XB_SPIN(xb_ld(&bar[XB_TOPGEN]) == tg, bar);
            __builtin_amdgcn_fence(__ATOMIC_ACQUIRE, "agent");
            xb_add(&bar[XB_XGEN(b.x)], 1u);
            asm volatile("s_waitcnt vmcnt(0)" ::: "memory");
        } else {
            XB_SPIN(xb_ld(&bar[XB_XGEN(b.x)]) == gen, bar);
            __builtin_amdgcn_fence(__ATOMIC_ACQUIRE, "agent");
            asm volatile("s_waitcnt vmcnt(0)" ::: "memory");
        }
    }
    __syncthreads();
}

__device__ __forceinline__ float dpp_shr1(float x) { return __builtin_bit_cast(float, __builtin_amdgcn_update_dpp(0, __builtin_bit_cast(int, x), 0x111, 0xf, 0xf, false)); }
struct EpiConvAct {
    static constexpr bool PERM = true, AFTER_DRAIN = false;
    bf16_t* act; bf16_t* halo; const float* cw; const float* cb;
    __device__ __forceinline__ void operator()(const f32x4 (&acc)[2][2][4][2], const pg8::Unit& u, int wr, int wc, int fr, int fq) const {
        const int tb = u.pm * 256 + 128 * wr, c0 = u.pn * 128 + wc * 32 + 8 * fq;
        bf16_t* hp = halo + (size_t)(tb >> 7) * 4 * DFF2;
#pragma unroll
        for (int n = 0; n < 2; ++n) {
            const int c = c0 + 4 * n;
            const f32x4 bg = *(const f32x4*)(cb + c), bv = *(const f32x4*)(cb + DFF + c);
            const f32x4 wg0 = *(const f32x4*)(cw + c), wg1 = *(const f32x4*)(cw + DFF2 + c), wg2 = *(const f32x4*)(cw + 2 * DFF2 + c);
            const f32x4 wv0 = *(const f32x4*)(cw + DFF + c), wv1 = *(const f32x4*)(cw + DFF2 + DFF + c), wv2 = *(const f32x4*)(cw + 2 * DFF2 + DFF + c);
            f32x4 pg6, pg7, pv6, pv7;
#pragma unroll
            for (int j = 0; j < 4; ++j) { pg6[j] = dpp_shr1(acc[1][0][2][n][j]); pg7[j] = dpp_shr1(acc[1][0][3][n][j]); pv6[j] = dpp_shr1(acc[1][1][2][n][j]); pv7[j] = dpp_shr1(acc[1][1][3][n][j]); }
#pragma unroll
            for (int q = 0; q < 8; ++q) {
                const f32x4 g = acc[q >> 2][0][q & 3][n], v = acc[q >> 2][1][q & 3][n];
                const f32x4 g1 = q >= 1 ? acc[(q - 1 + 8) % 8 >> 2][0][(q - 1 + 8) % 8 & 3][n] : pg7, g2 = q >= 2 ? acc[(q - 2 + 8) % 8 >> 2][0][(q - 2 + 8) % 8 & 3][n] : (q == 1 ? pg7 : pg6);
                const f32x4 v1 = q >= 1 ? acc[(q - 1 + 8) % 8 >> 2][1][(q - 1 + 8) % 8 & 3][n] : pv7, v2 = q >= 2 ? acc[(q - 2 + 8) % 8 >> 2][1][(q - 2 + 8) % 8 & 3][n] : (q == 1 ? pv7 : pv6);
                const f32x4 g1e = q == 0 ? pg7 : g1, g2e = q == 0 ? pg6 : g2, v1e = q == 0 ? pv7 : v1, v2e = q == 0 ? pv6 : v2;
                const f32x4 cg4 = bg + wg0 * g2e + wg1 * g1e + wg2 * g, cv4 = bv + wv0 * v2e + wv1 * v1e + wv2 * v; const f32x4 o = cg4 * cv4 * rcp_4(gelu_den4(cg4));
                if (fr > 0 || q >= 2) { u32x2 w; w.x = pk2(o[0], o[1]); w.y = pk2(o[2], o[3]); *(u32x2*)(act + (size_t)(tb + 8 * fr + q) * DFF + c) = w; }
                if ((fr == 0 && q < 2) || (fr == 15 && q >= 6)) { const int r = q < 2 ? q : q - 4; u32x2 wgp, wvp; wgp.x = pk2(g[0], g[1]); wgp.y = pk2(g[2], g[3]); wvp.x = pk2(v[0], v[1]); wvp.y = pk2(v[2], v[3]);
                    *(u32x2*)(hp + (size_t)r * DFF2 + c) = wgp; *(u32x2*)(hp + (size_t)r * DFF2 + DFF + c) = wvp; }
            }
        }
    }
};

struct Args { const float* in[21]; float* out; unsigned char* ws; };
typedef const __attribute__((address_space(4))) Args* ArgsP;

__device__ void p0_mod(ArgsP a, LAS unsigned char* lds, const int wv) {
    const int tid = opaque_tid(wv), w = tid >> 6, lane = tid & 63;
    const float* c = a->in[1]; const float* aw = a->in[2]; const float* ab = a->in[3]; float* mod = (float*)(a->ws + WS_MOD);
    LAS float* cs = (LAS float*)lds;
    LAS float* red = (LAS float*)(lds + 16384);
    if ((int)blockIdx.x < NL * 6144 / 64) {
        for (int i = tid; i < NB * DM; i += NTH) cs[i] = c[i];
        __syncthreads();
        const int gl = blockIdx.x * 64, l = gl / 6144, j0 = gl % 6144; const int c4 = lane & 15, kq = lane >> 4;
        const float* wp = aw + (size_t)l * DM * 6144 + (size_t)(w * 128 + kq) * 6144 + j0 + 4 * c4;
        f32x4 s0 = (f32x4){0.f, 0.f, 0.f, 0.f}, s1 = s0, s2 = s0, s3 = s0;
#pragma unroll 8
        for (int i = 0; i < 32; ++i) { const f32x4 wv4 = *(const f32x4*)(wp + (size_t)(4 * i) * 6144); const int k = w * 128 + 4 * i + kq;
            s0 += cs[k] * wv4; s1 += cs[DM + k] * wv4; s2 += cs[2 * DM + k] * wv4; s3 += cs[3 * DM + k] * wv4; }
#pragma unroll
        for (int e = 0; e < 4; ++e) { s0[e] += lane_get(s0[e], lane ^ 16); s0[e] += lane_get(s0[e], lane ^ 32); s1[e] += lane_get(s1[e], lane ^ 16); s1[e] += lane_get(s1[e], lane ^ 32);
            s2[e] += lane_get(s2[e], lane ^ 16); s2[e] += lane_get(s2[e], lane ^ 32); s3[e] += lane_get(s3[e], lane ^ 16); s3[e] += lane_get(s3[e], lane ^ 32); }
        if (kq == 0) { *(LAS f32x4*)(red + (w * 4 + 0) * 64 + 4 * c4) = s0; *(LAS f32x4*)(red + (w * 4 + 1) * 64 + 4 * c4) = s1; *(LAS f32x4*)(red + (w * 4 + 2) * 64 + 4 * c4) = s2; *(LAS f32x4*)(red + (w * 4 + 3) * 64 + 4 * c4) = s3; }
        __syncthreads();
        if (tid < 256) { const int b = tid >> 6; float sacc = ab[(size_t)l * 6144 + j0 + lane];
#pragma unroll
            for (int ww = 0; ww < 8; ++ww) sacc += red[(ww * 4 + b) * 64 + lane];
            mod[((size_t)l * NB + b) * 6144 + j0 + lane] = sacc; }
        __syncthreads();
    }
    bf16_t* gw = (bf16_t*)(a->ws + WS_GW);
    for (size_t idx = (size_t)blockIdx.x * NTH + tid; idx < (size_t)NL * 2 * 8 * 128 * 128; idx += (size_t)gridDim.x * NTH) {
        const int i = idx & 127, j = (idx >> 7) & 127, h = (idx >> 14) & 7, mat = (idx >> 17) & 1, l = (int)(idx >> 18);
        const float* src = a->in[mat ? 10 : 8];
        const float v = src[(((size_t)l * 8 + h) * 128 + i) * 128 + j];
        gw[idx] = (bf16_t)(pk2(v, v) & 0xffff);
    }
}
struct TMat { const float* W; bf16_t* Wt; int K, N, rmode, ntn; };
__device__ __forceinline__ TMat tmat_of(ArgsP a, int mi) {
    const int l = mi >> 2, k = mi & 3; bf16_t* wl = (bf16_t*)(a->ws + WS_W) + (size_t)l * W_LAYER_E; TMat m;
    if (k == 0) { m.W = a->in[5] + (size_t)l * DM * DIN; m.Wt = wl; m.K = DM; m.N = DIN; m.rmode = 1; }
    else if (k == 1) { m.W = a->in[15] + (size_t)l * DM * DM; m.Wt = wl + W_IN_E; m.K = DM; m.N = DM; m.rmode = 0; }
    else if (k == 2) { m.W = a->in[17] + (size_t)l * DM * DFF2; m.Wt = wl + W_IN_E + W_OUT_E; m.K = DM; m.N = DFF2; m.rmode = 2; }
    else { m.W = a->in[20] + (size_t)l * DFF * DM; m.Wt = wl + W_IN_E + W_OUT_E + W_UP_E; m.K = DFF; m.N = DM; m.rmode = 0; }
    m.ntn = m.N / 64; return m;
}
constexpr int TILES_IN = (DM / 64) * (DIN / 64), TILES_OUT = (DM / 64) * (DM / 64), TILES_UP = (DM / 64) * (DFF2 / 64), TILES_DN = (DFF / 64) * (DM / 64), TILES_L = TILES_IN + TILES_OUT + TILES_UP + TILES_DN;
__device__ __forceinline__ void tile_of(int g, int& mi, int& tile) {
    const int l = g / TILES_L; int r = g - l * TILES_L; int k = 0;
    if (r >= TILES_IN) { r -= TILES_IN; k = 1; if (r >= TILES_OUT) { r -= TILES_OUT; k = 2; if (r >= TILES_UP) { r -= TILES_UP; k = 3; } } }
    mi = l * 4 + k; tile = r;
}
__device__ void p0_weights(ArgsP a, LAS unsigned char* lds, const int wv) {
    const int tid = opaque_tid(wv), w = __builtin_amdgcn_readfirstlane(tid >> 6), lane = tid & 63;
    LAS float* t = (LAS float*)(lds + w * (64 * 68 * 4));
    const int NWV = gridDim.x * 8;
    for (int g = w * (int)gridDim.x + (int)blockIdx.x; g < NL * TILES_L; g += NWV) {
        int mi, tile; tile_of(g, mi, tile); const TMat m = tmat_of(a, mi);
        const int k0 = (tile / m.ntn) * 64, n0 = (tile % m.ntn) * 64;
        const float* p = m.W + (size_t)(k0 + (lane >> 4)) * m.N + n0 + (lane & 15) * 4;
        f32x4 v[16];
#pragma unroll
        for (int i = 0; i < 16; ++i) v[i] = *(const f32x4*)(p + (size_t)(4 * i) * m.N);
#pragma unroll
        for (int i = 0; i < 16; ++i) *(LAS f32x4*)(t + (4 * i + (lane >> 4)) * 68 + (lane & 15) * 4) = v[i];
        int nr = n0 + lane; if (m.rmode == 1) nr = nr < 1024 ? nr : nr < 2048 ? (1024 + ((nr - 1024) >> 7) * 256 + (nr & 127)) : nr < 5120 ? nr + 2048 : nr < 6144 ? (1024 + ((nr - 5120) >> 7) * 256 + 128 + (nr & 127)) : nr - 3072;
        else if (m.rmode == 2) nr = nr < DFF ? ((nr >> 7) * 256 + (nr & 127)) : (((nr - DFF) >> 7) * 256 + 128 + ((nr - DFF) & 127));
        bf16_t* op = m.Wt + (size_t)nr * m.K + k0;
#pragma unroll
        for (int pz = 0; pz < 8; ++pz) { float x[8];
#pragma unroll
            for (int e = 0; e < 8; ++e) x[e] = t[(pz * 8 + e) * 68 + lane];
            u32x4 o; o.x = pk2(x[0], x[1]); o.y = pk2(x[2], x[3]); o.z = pk2(x[4], x[5]); o.w = pk2(x[6], x[7]);
            *(u32x4*)(op + pz * 8) = o; }
    }
}
__device__ void norm_phase(const float* __restrict__ xf, const bf16_t* __restrict__ xbf, const float* __restrict__ g, const float* __restrict__ modl  , int shk, int sck, bf16_t* __restrict__ xn, const int wv) {
    const int tid = opaque_tid(wv); const int w = tid >> 6, lane = tid & 63;
    for (int rowp = blockIdx.x * 8 + w; rowp < MTOK / 2; rowp += gridDim.x * 8) {
        f32x4 v[2][4]; float ss[2] = {0.f, 0.f};
#pragma unroll
        for (int h = 0; h < 2; ++h) { const int row = rowp + h * (MTOK / 2);
            if (xf) { const float* xr = xf + (size_t)row * DM;
#pragma unroll
                for (int i = 0; i < 4; ++i) v[h][i] = *(const f32x4*)(xr + lane * 4 + 256 * i);
            } else { const bf16_t* xr = xbf + (size_t)row * DM;
#pragma unroll
                for (int i = 0; i < 4; ++i) { const u32x2 t = *(const u32x2*)(xr + lane * 4 + 256 * i); v[h][i] = (f32x4){bflo(t.x), bfhi(t.x), bflo(t.y), bfhi(t.y)}; } } }
#pragma unroll
        for (int h = 0; h < 2; ++h) {
#pragma unroll
            for (int i = 0; i < 4; ++i) ss[h] += v[h][i][0] * v[h][i][0] + v[h][i][1] * v[h][i][1] + v[h][i][2] * v[h][i][2] + v[h][i][3] * v[h][i][3]; }
#pragma unroll
        for (int o = 32; o >= 1; o >>= 1) { ss[0] += lane_get(ss[0], lane ^ o); ss[1] += lane_get(ss[1], lane ^ o); }
#pragma unroll
        for (int h = 0; h < 2; ++h) { const int row = rowp + h * (MTOK / 2); const int b = row / SEQ;
            const float rstd = rsqrtf(ss[h] * (1.0f / DM) + EPS);
            const float* sh = modl + (size_t)b * 6144 + shk * 1024; const float* sc = modl + (size_t)b * 6144 + sck * 1024;
#pragma unroll
            for (int i = 0; i < 4; ++i) { const int c = lane * 4 + 256 * i; const f32x4 gg = *(const f32x4*)(g + c), s1 = *(const f32x4*)(sc + c), s0 = *(const f32x4*)(sh + c);
                f32x4 y;
#pragma unroll
                for (int j = 0; j < 4; ++j) y[j] = v[h][i][j] * rstd * gg[j] * (1.0f + s1[j]) + s0[j];
                u32x2 o; o.x = pk2(y[0], y[1]); o.y = pk2(y[2], y[3]); *(u32x2*)(xn + (size_t)row * DM + c) = o; } }
    }
}
constexpr int KP = 272, VP = 136;
constexpr int ASLOT = 64 * KP + 128 * VP;
constexpr float DEAD = 1e-20f;
typedef float f32x2 __attribute__((ext_vector_type(2)));
template <bool DIAG>
__device__ __forceinline__ void sb_weights(const f32x4 (&S)[4], float& carry, unsigned (&pw)[4][2], int q, int key0, int fq, int lane) {
    {
        f32x2 w01[4], w23[4]; float T[4], ab[4];
#pragma unroll
        for (int nb = 0; nb < 4; ++nb) {
            float E[4], be[4];
#pragma unroll
            for (int e = 0; e < 4; ++e) E[e] = __builtin_amdgcn_exp2f(-__builtin_amdgcn_fmed3f(S[nb][e], -115.f, 115.f));
            const f32x2 d01 = (f32x2){E[0], E[1]} + 1.0f, d23 = (f32x2){E[2], E[3]} + 1.0f;
            be[0] = __builtin_amdgcn_rcpf(d01.x); be[1] = __builtin_amdgcn_rcpf(d01.y); be[2] = __builtin_amdgcn_rcpf(d23.x); be[3] = __builtin_amdgcn_rcpf(d23.y);
            f32x2 b01 = (f32x2){be[0], be[1]}, b23 = (f32x2){be[2], be[3]};
            f32x2 o01 = (f32x2){E[0], E[1]} * b01, o23 = (f32x2){E[2], E[3]} * b23;
            if (DIAG) { const int k = key0 + 16 * nb;
                const bool m0 = k + 0 < q, m1 = k + 1 < q, m2 = k + 2 < q, m3 = k + 3 < q;
                b01.x = m0 ? b01.x : 0.f; o01.x = m0 ? o01.x : 1.f; b01.y = m1 ? b01.y : 0.f; o01.y = m1 ? o01.y : 1.f; b23.x = m2 ? b23.x : 0.f; o23.x = m2 ? o23.x : 1.f; b23.y = m3 ? b23.y : 0.f; o23.y = m3 ? o23.y : 1.f; }
            const float s1 = o23.y * o23.x, s0 = s1 * o01.y, run = s0 * o01.x;
            w01[nb] = b01 * (f32x2){s0, s1}; w23[nb] = b23 * (f32x2){o23.y, 1.0f};
            const float g1 = lane_get(run, lane ^ 16), g2 = lane_get(run, lane ^ 32), g3 = lane_get(g1, lane ^ 32);
            const float g23 = g2 * g3; T[nb] = (run * g1) * g23; ab[nb] = fq == 0 ? (g1 * g23) : fq == 1 ? g23 : fq == 2 ? g1 : 1.f; }
        float hi = carry;
#pragma unroll
        for (int nb = 3; nb >= 0; --nb) { const float base = hi * ab[nb]; const f32x2 p01 = w01[nb] * base, p23 = w23[nb] * base;
            pw[nb][0] = pk2(p01.x, p01.y); pw[nb][1] = pk2(p23.x, p23.y); hi *= T[nb]; }
        carry = hi;
    }
}
__device__ __forceinline__ void attn_stage(LAS unsigned char* Ks, LAS unsigned char* Vt, const u32x4 (&kr)[2], const u32x4 (&vr)[2], const float (&gks)[8], int sp, int skp, int lane) {
#pragma unroll
    for (int i = 0; i < 2; ++i) { float x[8]; float ss = 0.f;
#pragma unroll
        for (int j = 0; j < 4; ++j) { x[2 * j] = bflo(kr[i][j]); x[2 * j + 1] = bfhi(kr[i][j]); ss += x[2 * j] * x[2 * j] + x[2 * j + 1] * x[2 * j + 1]; }
        ss += lane_get(ss, lane ^ 1); ss += lane_get(ss, lane ^ 2); ss += lane_get(ss, lane ^ 4); ss += lane_get(ss, lane ^ 8);
        const float rs = rsqrtf(ss * (1.0f / 128.0f) + EPS);
        u32x4 o;
#pragma unroll
        for (int j = 0; j < 4; ++j) o[j] = pk2(x[2 * j] * rs * gks[2 * j], x[2 * j + 1] * rs * gks[2 * j + 1]);
        *(LAS u32x4*)(Ks + (2 * skp + i) * KP + sp * 16) = o; }
    const int wsz = skp ^ (sp & 14);
#pragma unroll
    for (int j = 0; j < 4; ++j) { *(LAS unsigned*)(Vt + (sp * 8 + 2 * j) * VP + wsz * 4) = (vr[0][j] & 0xffffu) | (vr[1][j] << 16); *(LAS unsigned*)(Vt + (sp * 8 + 2 * j + 1) * VP + wsz * 4) = (vr[0][j] >> 16) | (vr[1][j] & 0xffff0000u); }
}
__device__ void attn_phase(ArgsP a, int l, LAS unsigned char* lds, const int wv) {
    const int tid = opaque_tid(wv), w = __builtin_amdgcn_readfirstlane(tid >> 6), lane = tid & 63, fr = lane & 15, fq = lane >> 4;
    LAS int* flags = (LAS int*)(lds + 4 * ASLOT);
    const bf16_t* Qb = (const bf16_t*)(a->ws + WS_P); bf16_t* Yb = (bf16_t*)(a->ws + WS_P);     const bf16_t* Kb = (const bf16_t*)(a->ws + WS_P + PBUF); const bf16_t* Vb = (const bf16_t*)(a->ws + WS_P + 2 * PBUF);
    const float* gq = a->in[13] + l * 128; const float* gk = a->in[14] + l * 128;
    const int sp = tid & 15, skp = tid >> 4;
    float gks[8];
#pragma unroll
    for (int e = 0; e < 8; ++e) gks[e] = gk[sp * 8 + e] * gq[sp * 8 + e];
    const int nunits = NB * 8 * (SEQ / 256);
    for (int unit = blockIdx.x; unit < nunits; unit += gridDim.x) {
        const int qt = (SEQ / 256 - 1) - unit / (NB * 8), bh = unit % (NB * 8), b = bh >> 3, hh = bh & 7;
        const size_t rowbase = (size_t)b * SEQ; const int t0 = qt * 256, r0 = t0 + 32 * w;
        const int kbw = qt * 4 + (w >> 1);
        const bf16_t* kbase = Kb + rowbase * DM + hh * 128 + sp * 8; const bf16_t* vbase = Vb + rowbase * DM + hh * 128 + sp * 8;
        u32x4 kr[2], vr[2];
#pragma unroll
        for (int h2 = 0; h2 < 2; ++h2) { u32x4 k4[2][2], v4[2][2];
#pragma unroll
          for (int i4 = 0; i4 < 2; ++i4)
#pragma unroll
              for (int i = 0; i < 2; ++i) { const size_t ro = (size_t)((qt * 4 + 2 * h2 + i4) * 64 + 2 * skp + i) * DM; k4[i4][i] = *(const u32x4*)(kbase + ro); v4[i4][i] = *(const u32x4*)(vbase + ro); }
#pragma unroll
          for (int i4 = 0; i4 < 2; ++i4) attn_stage(lds + (2 * h2 + i4) * ASLOT, lds + (2 * h2 + i4) * ASLOT + 64 * KP, k4[i4], v4[i4], gks, sp, skp, lane); }
        bf16x8 qf[2][4];
#pragma unroll
        for (int rb = 0; rb < 2; ++rb) {
            const bf16_t* qp = Qb + (rowbase + r0 + 16 * rb + fr) * DM + hh * 128 + 8 * fq; u32x4 raw[4]; float ss = 0.f;
#pragma unroll
            for (int ks = 0; ks < 4; ++ks) { raw[ks] = *(const u32x4*)(qp + 32 * ks);
#pragma unroll
                for (int j = 0; j < 4; ++j) { const float x0 = bflo(raw[ks][j]), x1 = bfhi(raw[ks][j]); ss += x0 * x0 + x1 * x1; } }
            ss += lane_get(ss, lane ^ 16); ss += lane_get(ss, lane ^ 32);
            const float rs = rsqrtf(ss * (1.0f / 128.0f) + EPS) * (0.08838834764831845f * 1.4426950408889634f);
#pragma unroll
            for (int ks = 0; ks < 4; ++ks) { u32x4 o;
#pragma unroll
                for (int j = 0; j < 4; ++j) o[j] = pk2(bflo(raw[ks][j]) * rs, bfhi(raw[ks][j]) * rs);
                qf[rb][ks] = __builtin_bit_cast(bf16x8, o); }
        }
        f32x4 O[2][8];
#pragma unroll
        for (int rb = 0; rb < 2; ++rb)
#pragma unroll
            for (int db = 0; db < 8; ++db) O[rb][db] = (f32x4){0.f, 0.f, 0.f, 0.f};
        float carry[2] = {1.f, 1.f};
        bool alive = true;
        __syncthreads();
        for (int s_ = 0;; ++s_) {
            const int kb = kbw - s_, nbn = qt * 4 - s_ - 1;
            if (nbn >= 0) {
#pragma unroll
                for (int i = 0; i < 2; ++i) { const size_t ro = (size_t)(nbn * 64 + 2 * skp + i) * DM; kr[i] = *(const u32x4*)(kbase + ro); vr[i] = *(const u32x4*)(vbase + ro); } }
            if (alive && kb >= 0) {
                const LAS unsigned char* Ks = lds + (kb & 3) * ASLOT; const LAS unsigned char* Vt = Ks + 64 * KP;
                unsigned pw[2][4][2];
#pragma unroll
                for (int rb = 0; rb < 2; ++rb) {
                    f32x4 S[4];
#pragma unroll
                    for (int nb = 0; nb < 4; ++nb) { f32x4 sacc = (f32x4){0.f, 0.f, 0.f, 0.f};
#pragma unroll
                        for (int ks = 0; ks < 4; ++ks) { const bf16x8 kf = *(const LAS bf16x8*)(Ks + (16 * nb + fr) * KP + (32 * ks + 8 * fq) * 2); sacc = __builtin_amdgcn_mfma_f32_16x16x32_bf16(kf, qf[rb][ks], sacc, 0, 0, 0); }
                        S[nb] = sacc; }
                    if (s_ == 0) sb_weights<true>(S, carry[rb], pw[rb], r0 + 16 * rb + fr, kb * 64 + 4 * fq, fq, lane);
                    else sb_weights<false>(S, carry[rb], pw[rb], r0 + 16 * rb + fr, kb * 64 + 4 * fq, fq, lane);
                }
#pragma unroll
                for (int ks2 = 0; ks2 < 2; ++ks2) {
                    bf16x8 pf[2];
#pragma unroll
                    for (int rb = 0; rb < 2; ++rb) { u32x4 t; t.x = pw[rb][2 * ks2][0]; t.y = pw[rb][2 * ks2][1]; t.z = pw[rb][2 * ks2 + 1][0]; t.w = pw[rb][2 * ks2 + 1][1]; pf[rb] = __builtin_bit_cast(bf16x8, t); }
#pragma unroll
                    for (int db = 0; db < 8; ++db) { const LAS unsigned char* vrow = Vt + (16 * db + fr) * VP;
                        const u32x2 va = *(const LAS u32x2*)(vrow + 4 * ((16 * ks2 + 2 * fq) ^ (2 * db))), vb = *(const LAS u32x2*)(vrow + 4 * ((16 * ks2 + 8 + 2 * fq) ^ (2 * db)));
                        u32x4 t; t.x = va.x; t.y = va.y; t.z = vb.x; t.w = vb.y; const bf16x8 vf = __builtin_bit_cast(bf16x8, t);
#pragma unroll
                        for (int rb = 0; rb < 2; ++rb) O[rb][db] = __builtin_amdgcn_mfma_f32_16x16x32_bf16(vf, pf[rb], O[rb][db], 0, 0, 0); }
                }
                alive = !__all((carry[0] < DEAD) && (carry[1] < DEAD));
            }
            if (lane == 0) flags[w] = (alive && kb >= 1) ? 1 : 0;
            __syncthreads();
            int any = 0;
#pragma unroll
            for (int ww = 0; ww < 8; ++ww) any |= flags[ww];
            if (!any) break;
            if (nbn >= 0) attn_stage(lds + (nbn & 3) * ASLOT, lds + (nbn & 3) * ASLOT + 64 * KP, kr, vr, gks, sp, skp, lane);
            __syncthreads();
        }
#pragma unroll
        for (int rb = 0; rb < 2; ++rb) { bf16_t* op = Yb + (rowbase + r0 + 16 * rb + fr) * DM + hh * 128 + 4 * fq;
#pragma unroll
            for (int db = 0; db < 8; ++db) { u32x2 o; o.x = pk2(O[rb][db][0], O[rb][db][1]); o.y = pk2(O[rb][db][2], O[rb][db][3]); *(u32x2*)(op + 16 * db) = o; } }
        __syncthreads();
    }
}
constexpr int XP = 272;
__device__ void rnn_phase(ArgsP a, int l, LAS unsigned char* lds, const int wv) {
    const int tid = opaque_tid(wv), w = __builtin_amdgcn_readfirstlane(tid >> 6), lane = tid & 63, fr = lane & 15, fq = lane >> 4;
    LAS unsigned char* XC = lds; LAS unsigned char* HT = lds + RT * XP; LAS unsigned char* PT = lds + 2 * RT * XP;
    const bf16_t* XR = (const bf16_t*)(a->ws + WS_P + 3 * PBUF); const bf16_t* GY = (const bf16_t*)(a->ws + WS_P + 4 * PBUF); bf16_t* SGA = (bf16_t*)(a->ws + WS_P + 4 * PBUF);
    bf16_t* M0o = (bf16_t*)(a->out);
    float* SUM = (float*)(a->ws + WS_SUM);
    const bf16_t* gw = (const bf16_t*)(a->ws + WS_GW) + (size_t)l * 2 * 8 * 16384;
    const float* cw = a->in[6] + (size_t)l * 4 * DM; const float* cb = a->in[7] + (size_t)l * DM;
    const float* ba = a->in[9] + (size_t)l * DM; const float* bx = a->in[11] + (size_t)l * DM; const float* lam = a->in[12] + (size_t)l * DM;
    const int sp = tid & 15, tg = tid >> 4;
    const int nunits = NB * 8 * NT;
    const int hh = blockIdx.x & 7, cbase = hh * 128;
    const int c = cbase + 16 * w + fr;
    const float bac = ba[c], bxc = bx[c]; const float lm = lam[c];
    const float sp8l = 8.0f * 1.4426950408889634f * (fmaxf(-lm, 0.f) + __logf(1.0f + __expf(-fabsf(lm))));
    u32x4 r[7];
    { const int unit = blockIdx.x; if (unit < nunits) { const int b = (unit >> 3) & 3, j = unit >> 5; const size_t rowbase = (size_t)b * SEQ;
#pragma unroll
        for (int i = 0; i < 7; ++i) { const int ts = j * RT + 4 * tg - 3 + i; r[i] = (u32x4){0, 0, 0, 0}; if (ts >= 0) r[i] = *(const u32x4*)(XR + (rowbase + ts) * DM + cbase + sp * 8); } } }
    for (int unit = blockIdx.x; unit < nunits; unit += gridDim.x) {
        const int b = (unit >> 3) & 3, j = unit >> 5; const int t0 = j * RT; const size_t rowbase = (size_t)b * SEQ;
        { f32x2 wv2[4][4], bv2[4];
#pragma unroll
          for (int jj = 0; jj < 4; ++jj) { bv2[jj] = *(const f32x2*)(cb + cbase + sp * 8 + 2 * jj);
#pragma unroll
              for (int k = 0; k < 4; ++k) wv2[k][jj] = *(const f32x2*)(cw + k * DM + cbase + sp * 8 + 2 * jj); }
#pragma unroll
          for (int i = 0; i < 4; ++i) { f32x2 acc2[4];
#pragma unroll
              for (int jj = 0; jj < 4; ++jj) acc2[jj] = bv2[jj];
#pragma unroll
              for (int k = 0; k < 4; ++k) {
#pragma unroll
                  for (int jj = 0; jj < 4; ++jj) acc2[jj] += wv2[k][jj] * (f32x2){bflo(r[i + k][jj]), bfhi(r[i + k][jj])}; }
              u32x4 o; o.x = pk2(acc2[0].x, acc2[0].y); o.y = pk2(acc2[1].x, acc2[1].y); o.z = pk2(acc2[2].x, acc2[2].y); o.w = pk2(acc2[3].x, acc2[3].y);
              *(LAS u32x4*)(XC + (4 * tg + i) * XP + sp * 16) = o; } }
        bf16x8 wa[4], wx[4];
        { const bf16_t* pa = gw + ((size_t)(0 * 8 + hh) * 128 + 16 * w + fr) * 128 + 8 * fq; const bf16_t* px = gw + ((size_t)(1 * 8 + hh) * 128 + 16 * w + fr) * 128 + 8 * fq;
#pragma unroll
          for (int ks = 0; ks < 4; ++ks) { wa[ks] = *(const bf16x8*)(pa + 32 * ks); wx[ks] = *(const bf16x8*)(px + 32 * ks); } }
        { const int un = unit + gridDim.x; if (un < nunits) { const int bn = (un >> 3) & 3, jn = un >> 5; const size_t rbn = (size_t)bn * SEQ;
#pragma unroll
            for (int i = 0; i < 7; ++i) { const int ts = jn * RT + 4 * tg - 3 + i; r[i] = (u32x4){0, 0, 0, 0}; if (ts >= 0) r[i] = *(const u32x4*)(XR + (rbn + ts) * DM + cbase + sp * 8); } } }
        __syncthreads();
        f32x4 A[8], U[8];
#pragma unroll
        for (int mb = 0; mb < 8; ++mb) { f32x4 ra = (f32x4){0.f, 0.f, 0.f, 0.f}, rx = ra;
#pragma unroll
            for (int ks = 0; ks < 4; ++ks) { const bf16x8 xf = *(const LAS bf16x8*)(XC + (16 * mb + fr) * XP + (32 * ks + 8 * fq) * 2);
                ra = __builtin_amdgcn_mfma_f32_16x16x32_bf16(xf, wa[ks], ra, 0, 0, 0); rx = __builtin_amdgcn_mfma_f32_16x16x32_bf16(xf, wx[ks], rx, 0, 0, 0); }
#pragma unroll
            for (int hp = 0; hp < 2; ++hp) {
                const f32x2 ta = (f32x2){ra[2 * hp], ra[2 * hp + 1]} * (-1.4426950408889634f) + (-1.4426950408889634f * bac), tx = (f32x2){rx[2 * hp], rx[2 * hp + 1]} * (-1.4426950408889634f) + (-1.4426950408889634f * bxc);
                const f32x2 da = (f32x2){__builtin_amdgcn_exp2f(ta.x), __builtin_amdgcn_exp2f(ta.y)} + 1.0f, dx = (f32x2){__builtin_amdgcn_exp2f(tx.x), __builtin_amdgcn_exp2f(tx.y)} + 1.0f;
                const f32x2 r = (f32x2){__builtin_amdgcn_rcpf(da.x), __builtin_amdgcn_rcpf(da.y)}, ig = (f32x2){__builtin_amdgcn_rcpf(dx.x), __builtin_amdgcn_rcpf(dx.y)};
                const f32x2 la2 = r * (-sp8l);
                const f32x2 av = (f32x2){__builtin_amdgcn_exp2f(la2.x), __builtin_amdgcn_exp2f(la2.y)};
                const f32x2 x2 = la2 * 1.3862943611198906f;
                const f32x2 ser = -x2 * (x2 * (x2 * (1.0f / 6.0f) + 0.5f) + 1.0f), alt = 1.0f - av * av;
                const f32x2 om = (f32x2){x2.x > -0.02f ? ser.x : alt.x, x2.y > -0.02f ? ser.y : alt.y};
                const f32x2 xc = (f32x2){bf2f(*(const LAS bf16_t*)(XC + (16 * mb + 4 * fq + 2 * hp) * XP + (16 * w + fr) * 2)), bf2f(*(const LAS bf16_t*)(XC + (16 * mb + 4 * fq + 2 * hp + 1) * XP + (16 * w + fr) * 2))};
                const f32x2 uu = (f32x2){__builtin_amdgcn_sqrtf(om.x), __builtin_amdgcn_sqrtf(om.y)} * (ig * xc);
                ra[2 * hp] = av.x; ra[2 * hp + 1] = av.y; rx[2 * hp] = uu.x; rx[2 * hp + 1] = uu.y; }
            A[mb] = ra; U[mb] = rx; }
        u32x4 mg[4];
#pragma unroll
        for (int i = 0; i < 4; ++i) { const size_t go = (rowbase + t0 + 4 * tg + i) * DM + cbase + sp * 8; mg[i] = *(const u32x4*)(GY + go); }
        float H = 0.f, Pp = 1.0f;
#pragma unroll
        for (int mb = 0; mb < 8; ++mb) {
            float Ag = A[mb][0] * A[mb][1] * A[mb][2] * A[mb][3];
            float Ug = ((U[mb][0] * A[mb][1] + U[mb][1]) * A[mb][2] + U[mb][2]) * A[mb][3] + U[mb][3];
            { const float a1 = lane_get(Ag, lane - 16), u1 = lane_get(Ug, lane - 16); if (fq >= 1) { const f32x2 t = (f32x2){u1, a1} * Ag + (f32x2){Ug, 0.f}; Ug = t.x; Ag = t.y; } }
            { const float a2 = lane_get(Ag, lane - 32), u2 = lane_get(Ug, lane - 32); if (fq >= 2) { const f32x2 t = (f32x2){u2, a2} * Ag + (f32x2){Ug, 0.f}; Ug = t.x; Ag = t.y; } }
            const float ap = lane_get(Ag, lane - 16), up = lane_get(Ug, lane - 16);
            f32x2 hp = fq == 0 ? (f32x2){H, Pp} : (f32x2){H, Pp} * ap + (f32x2){up, 0.f};
#pragma unroll
            for (int e = 0; e < 4; ++e) { hp = hp * A[mb][e] + (f32x2){U[mb][e], 0.f}; const unsigned hp2 = pk2(hp.x, hp.y); const int off = (16 * mb + 4 * fq + e) * XP + (16 * w + fr) * 2;
                *(LAS bf16_t*)(HT + off) = (bf16_t)(hp2 & 0xffff); *(LAS bf16_t*)(PT + off) = (bf16_t)(hp2 >> 16); }
            const float Am = lane_get(Ag, 48 + fr), Um = lane_get(Ug, 48 + fr);
            { const f32x2 t = (f32x2){H, Pp} * Am + (f32x2){Um, 0.f}; H = t.x; Pp = t.y; }
        }
        if (fq == 0) { float* sm = SUM + (((size_t)b * NT + j) * DM + c) * 2; sm[0] = Pp; sm[1] = H; }
        __syncthreads();
#pragma unroll
        for (int i = 0; i < 4; ++i) { const int tl = 4 * tg + i; const size_t go = (rowbase + t0 + tl) * DM + cbase + sp * 8;
            const u32x4 hv = *(const LAS u32x4*)(HT + tl * XP + sp * 16), pv = *(const LAS u32x4*)(PT + tl * XP + sp * 16);
            u32x4 o0, o1;
#pragma unroll
            for (int jj = 0; jj < 4; ++jj) { const f32x2 g2 = (f32x2){bflo(mg[i][jj]), bfhi(mg[i][jj])};
                const f32x2 m0 = g2 * (f32x2){bflo(hv[jj]), bfhi(hv[jj])}, m1 = g2 * (f32x2){bflo(pv[jj]), bfhi(pv[jj])};
                o0[jj] = pk2(m0.x, m0.y); o1[jj] = pk2(m1.x, m1.y); }
            *(u32x4*)(M0o + go) = o0; *(u32x4*)(SGA + go) = o1; }
    }
}
__device__ void mix_phase(ArgsP a, LAS unsigned char* lds, const int wv) {
    const bf16_t* M0 = (const bf16_t*)(a->out); const bf16_t* M1 = (const bf16_t*)(a->ws + WS_P + 4 * PBUF); const bf16_t* SGB = (const bf16_t*)(a->out) + (size_t)MTOK * DM; const bf16_t* YB = (const bf16_t*)(a->ws + WS_P);
    bf16_t* MIX = (bf16_t*)(a->out); const float* SUM = (const float*)(a->ws + WS_SUM);
    LAS float* hin = (LAS float*)lds;
    const int tid = opaque_tid(wv);
    for (int tile = blockIdx.x; tile < NB * NT; tile += gridDim.x) {
        const int b = tile / NT, j = tile % NT;
        { float H0 = 0.f, H1 = 0.f; const float* sp_ = SUM + ((size_t)b * NT * DM + 2 * tid) * 2;
#pragma unroll 8
          for (int jj = 0; jj < j; ++jj) { const f32x4 v = *(const f32x4*)(sp_ + (size_t)jj * DM * 2); H0 = v[0] * H0 + v[1]; H1 = v[2] * H1 + v[3]; }
          hin[2 * tid] = H0; hin[2 * tid + 1] = H1; }
        __syncthreads();
        const int pc = tid & 127, r0 = tid >> 7; const f32x4 h0 = *(const LAS f32x4*)(hin + pc * 8), h1 = *(const LAS f32x4*)(hin + pc * 8 + 4);
        const size_t rowbase = (size_t)b * SEQ + (size_t)j * RT;
#pragma unroll 8
        for (int r = r0; r < RT; r += 4) { const size_t go = (rowbase + r) * DM + pc * 8; const u32x4 m0 = *(const u32x4*)(M0 + go), m1 = *(const u32x4*)(M1 + go), sg = *(const u32x4*)(SGB + go), yb = *(const u32x4*)(YB + go); u32x4 o;
            o.x = pk2(bflo(m0.x) + bflo(m1.x) * h0[0] + bflo(sg.x) * bflo(yb.x), bfhi(m0.x) + bfhi(m1.x) * h0[1] + bfhi(sg.x) * bfhi(yb.x)); o.y = pk2(bflo(m0.y) + bflo(m1.y) * h0[2] + bflo(sg.y) * bflo(yb.y), bfhi(m0.y) + bfhi(m1.y) * h0[3] + bfhi(sg.y) * bfhi(yb.y));
            o.z = pk2(bflo(m0.z) + bflo(m1.z) * h1[0] + bflo(sg.z) * bflo(yb.z), bfhi(m0.z) + bfhi(m1.z) * h1[1] + bfhi(sg.z) * bfhi(yb.z)); o.w = pk2(bflo(m0.w) + bflo(m1.w) * h1[2] + bflo(sg.w) * bflo(yb.w), bfhi(m0.w) + bfhi(m1.w) * h1[3] + bfhi(sg.w) * bfhi(yb.w));
            *(u32x4*)(MIX + go) = o; }
        __syncthreads();
    }
}
template <class Sched>
__device__ void ffn_fixup(ArgsP a, int l, const Sched& S, const int wv) {
    bf16_t* ACT = (bf16_t*)(a->ws + WS_P); const bf16_t* HALO = (const bf16_t*)(a->ws + WS_P + ACT_BYTES);
    const float* cw = a->in[18] + (size_t)l * 3 * DFF2; const float* cb = a->in[19] + (size_t)l * DFF2;
    const int tid = opaque_tid(wv); pg8::Unit u;
    for (int ui = 0; S.next(ui, u); ++ui)
    for (int it = tid; it < 2 * (DFF / 8); it += NTH) {
        const int cgp = it % (DFF / 8), wb = 2 * u.pm + it / (DFF / 8); const int c0 = cgp * 8, t0 = wb * 128; const bool first = (t0 & (SEQ - 1)) == 0;
        const bf16_t* hc = HALO + (size_t)wb * 4 * DFF2; const bf16_t* hpv = hc - 4 * DFF2;
        u32x4 z = (u32x4){0, 0, 0, 0}; u32x4 gm2 = z, gm1 = z, vm2 = z, vm1 = z;
        if (!first) { gm2 = *(const u32x4*)(hpv + 2 * DFF2 + c0); gm1 = *(const u32x4*)(hpv + 3 * DFF2 + c0); vm2 = *(const u32x4*)(hpv + 2 * DFF2 + DFF + c0); vm1 = *(const u32x4*)(hpv + 3 * DFF2 + DFF + c0); }
        const u32x4 g0 = *(const u32x4*)(hc + c0), g1 = *(const u32x4*)(hc + DFF2 + c0), v0 = *(const u32x4*)(hc + DFF + c0), v1 = *(const u32x4*)(hc + DFF2 + DFF + c0);
        u32x4 o0, o1;
#pragma unroll
        for (int jj = 0; jj < 4; ++jj) {
            float r0[2], r1[2];
#pragma unroll
            for (int hl = 0; hl < 2; ++hl) { const int c = c0 + 2 * jj + hl;
                const float wg0 = cw[c], wg1 = cw[DFF2 + c], wg2 = cw[2 * DFF2 + c], wv0 = cw[DFF + c], wv1 = cw[DFF2 + DFF + c], wv2 = cw[2 * DFF2 + DFF + c], bg = cb[c], bv = cb[DFF + c];
                const float G2 = hl ? bfhi(gm2[jj]) : bflo(gm2[jj]), G1 = hl ? bfhi(gm1[jj]) : bflo(gm1[jj]), Ga = hl ? bfhi(g0[jj]) : bflo(g0[jj]), Gb = hl ? bfhi(g1[jj]) : bflo(g1[jj]);
                const float V2 = hl ? bfhi(vm2[jj]) : bflo(vm2[jj]), V1 = hl ? bfhi(vm1[jj]) : bflo(vm1[jj]), Va = hl ? bfhi(v0[jj]) : bflo(v0[jj]), Vb = hl ? bfhi(v1[jj]) : bflo(v1[jj]);
                r0[hl] = gelu_tanh(bg + wg0 * G2 + wg1 * G1 + wg2 * Ga) * (bv + wv0 * V2 + wv1 * V1 + wv2 * Va);
                r1[hl] = gelu_tanh(bg + wg0 * G1 + wg1 * Ga + wg2 * Gb) * (bv + wv0 * V1 + wv1 * Va + wv2 * Vb); }
            o0[jj] = pk2(r0[0], r0[1]); o1[jj] = pk2(r1[0], r1[1]); }
        *(u32x4*)(ACT + (size_t)t0 * DFF + c0) = o0; *(u32x4*)(ACT + (size_t)(t0 + 1) * DFF + c0) = o1;
    }
}
constexpr int LDS_BYTES = 137 * 1024;
__global__ void __launch_bounds__(NTH, 2) mk_fwd(Args a_unused) {
    ArgsP a = (ArgsP)__builtin_amdgcn_kernarg_segment_ptr(); asm volatile("" : "+s"(a));
    const int wv = __builtin_amdgcn_readfirstlane(threadIdx.x >> 6);
    extern __shared__ __attribute__((aligned(16))) unsigned char lds_raw[];
    LAS unsigned char* lds = (LAS unsigned char*)lds_raw;
    cg::grid_group grid = cg::this_grid();
    volatile LAS unsigned* xbst = (volatile LAS unsigned*)(lds + LDS_BYTES - 16);
    if (threadIdx.x < 4) xbst[threadIdx.x] = 0u;
    __syncthreads();
    const XcdBarrier xbar = xcd_barrier_post((unsigned*)(a->ws + WS_BAR), xbst);
    const int G = gridDim.x, bid = blockIdx.x;
    float* mod = (float*)(a->ws + WS_MOD);
    bf16_t* XN = (bf16_t*)(a->out); bf16_t* P = (bf16_t*)(a->ws + WS_P);
#ifndef REPMASK
#define REPMASK 0
#endif
#ifndef XSYNC
#define XSYNC 0
#endif
#ifndef TMASK
#define TMASK 0
#endif
    unsigned long long tacc = 0ull;
#define RUN(k, ...) for (int _r = 0; _r < (((REPMASK >> (k)) & 1) ? 2 : 1); ++_r) { const unsigned long long _t0 = ((TMASK >> (k)) & 1) ? __builtin_amdgcn_s_memrealtime() : 0ull; __VA_ARGS__ xcd_barrier(xbar, wv); if ((TMASK >> (k)) & 1) tacc += __builtin_amdgcn_s_memrealtime() - _t0; }
    if (a->out == nullptr) grid.sync();
    RUN(0, p0_mod(a, lds, wv); p0_weights(a, lds, wv);)
    for (int _x = 0; _x < XSYNC; ++_x) xcd_barrier(xbar, wv);
    for (int l = 0; l < NL; ++l) {
        const float* modl = mod + (size_t)l * NB * 6144;
        const bf16_t* wl = (const bf16_t*)(a->ws + WS_W) + (size_t)l * W_LAYER_E;
        bf16_t* XB = (bf16_t*)(a->ws + WS_XB);
        RUN(1, norm_phase(l == 0 ? a->in[0] : nullptr, XB, a->in[4] + l * DM, modl, 0, 1, XN, wv);)
        RUN(2, { pg8::Gemm g{XN, wl, MTOK, DIN, DM}; pg8::StaticOrder S; S.init(MTOK, DIN, G, bid);
          EpiIn E{P, (bf16_t*)(a->out) + (size_t)MTOK * DM}; pg8::gemm_phase<EpiIn, pg8::StaticOrder, true, true>(lds, g, S, E, wv); })
        RUN(3, attn_phase(a, l, lds, wv); rnn_phase(a, l, lds, wv);)
        RUN(7, mix_phase(a, lds, wv);)
        RUN(8, { pg8::Gemm g{XN, wl + W_IN_E, MTOK, DM, DM}; pg8::StaticOrder S; S.init(MTOK, DM, G, bid);
          EpiRes E{l == 0 ? a->in[0] : nullptr, XB, XB, nullptr, modl + 2 * 1024}; pg8::gemm_phase<EpiRes, pg8::StaticOrder, true, true>(lds, g, S, E, wv); })
        RUN(9, norm_phase(nullptr, XB, a->in[16] + l * DM, modl, 3, 4, XN, wv);)
        RUN(10, { pg8::Gemm g{XN, wl + W_IN_E + W_OUT_E, MTOK, DFF2, DM}; pg8::StaticOrder S; S.init(MTOK, DFF2, G, bid);
          EpiConvAct E{P, (bf16_t*)(a->ws + WS_P + ACT_BYTES), a->in[18] + (size_t)l * 3 * DFF2, a->in[19] + (size_t)l * DFF2};
          pg8::gemm_phase<EpiConvAct, pg8::StaticOrder, true, true, true>(lds, g, S, E, wv); })
        RUN(12, { pg8::Gemm g{P, wl + W_IN_E + W_OUT_E + W_UP_E, MTOK, DM, DFF}; pg8::StaticOrder S; S.init(MTOK, DM, G, bid);
          ffn_fixup(a, l, S, wv); asm volatile("s_waitcnt vmcnt(0)" ::: "memory"); __syncthreads();
          EpiRes E{nullptr, XB, XB, l == NL - 1 ? a->out : nullptr, modl + 5 * 1024}; pg8::gemm_phase<EpiRes, pg8::StaticOrder, true, true>(lds, g, S, E, wv); })
    }
    if (TMASK != 0 && blockIdx.x == 0) { const unsigned long long t0 = __builtin_amdgcn_s_memrealtime(); while (__builtin_amdgcn_s_memrealtime() - t0 < tacc) __builtin_amdgcn_s_sleep(8); }
}
extern "C" void kernel_launch(void* const* d_in, const int* in_sizes, int n_in, void* d_out, int out_size, void* d_ws, size_t ws_size, hipStream_t stream) {
    static int grid = 0;
    if (!grid) {
        int dev = 0, cus = 0, per_cu = 0;
        (void)hipGetDevice(&dev);
        (void)hipDeviceGetAttribute(&cus, hipDeviceAttributeMultiprocessorCount, dev);
        (void)hipFuncSetAttribute((const void*)mk_fwd, hipFuncAttributeMaxDynamicSharedMemorySize, LDS_BYTES);
        (void)hipOccupancyMaxActiveBlocksPerMultiprocessor(&per_cu, (const void*)mk_fwd, NTH, LDS_BYTES);
        if (per_cu < 1) per_cu = 1;
        grid = cus * per_cu;
        if (ws_size < WS_END) { fprintf(stderr, "kernel_launch: workspace too small: %zu < %zu\n", ws_size, (size_t)WS_END); grid = -1; }
        if (n_in != 21 || out_size != MTOK * DM) { fprintf(stderr, "kernel_launch: unexpected shapes\n"); grid = -1; }
    }
    if (grid < 0) return;
    (void)hipMemsetAsync((char*)d_ws + WS_BAR, 0, XCD_BAR_WORDS * 4, stream);
    Args a{};
    for (int i = 0; i < 21; ++i) a.in[i] = (const float*)d_in[i];
    a.out = (float*)d_out; a.ws = (unsigned char*)d_ws;
    void* args[] = {&a};
    hipError_t e = hipLaunchCooperativeKernel((const void*)mk_fwd, dim3(grid), dim3(NTH), args, LDS_BYTES, stream);
    if (e != hipSuccess) fprintf(stderr, "cooperative launch failed: %s (grid %d)\n", hipGetErrorString(e), grid);
}
```

```cpp
#include <hip/hip_runtime.h>
#include <hip/hip_cooperative_groups.h>
#include <cstdio>
#include <cstdint>
namespace cg = cooperative_groups;
__device__ __forceinline__ int opaque_tid(int wv) { int t; asm volatile("v_mbcnt_lo_u32_b32 %0, -1, 0\n\tv_mbcnt_hi_u32_b32 %0, -1, %0" : "=v"(t)); return t | (wv << 6); }
__device__ __forceinline__ int opaque_bid() { int t = blockIdx.x; asm volatile("" : "+s"(t)); return t; }
namespace pg8 {
#define PG8_LAS __attribute__((address_space(3)))
typedef unsigned short bf16_t;
typedef short bf16x8 __attribute__((ext_vector_type(8)));
typedef float f32x4 __attribute__((ext_vector_type(4)));
typedef unsigned u32x4 __attribute__((ext_vector_type(4)));
constexpr int BM = 256, BK = 64, HALF = 128, HTB = HALF * BK * 2  , STAGE_BYTES = 8 * HTB, NXCD = 8, WGM = 8;

__host__ __device__ __forceinline__ int lds_byte(int r, int c) { const int st = (r >> 4) * 2 + (c >> 5), rr = r & 15, cc = c & 31, ob = rr * 64 + cc * 2; return st * 1024 + (ob ^ (((ob >> 9) & 1) << 5)); }
__host__ __device__ __forceinline__ void stage_rc(int b, int& R, int& C) { const int st = b / 1024, sb = b % 1024, swz = sb ^ (((sb >> 9) & 1) << 5); R = (st >> 1) * 16 + swz / 64; C = (st & 1) * 32 + (swz % 64) / 2; }
__host__ __device__ __forceinline__ int perm32(int rho) { const int n = rho >> 4, i = rho & 15; return 8 * (i >> 2) + 4 * n + (i & 3); }

struct Unit { int pm, pn; };
struct Gemm { const bf16_t* A; const bf16_t* Bt; int M, N, K; };

struct StaticOrder {
    int nM, nN, nwg, G, c;
    __host__ __device__ void init(int M, int N, int G_, int c_) { nM = M / BM; nN = N / BM; nwg = nM * nN; G = G_; c = c_; }
    __host__ __device__ bool next(int i, Unit& u) const {
        const long L = (long)i * G + c; if (L >= nwg) return false;
        int wgid = (int)L; { const int q = nwg / NXCD, r = nwg % NXCD, xcd = wgid % NXCD, off = wgid / NXCD; wgid = (xcd < r ? xcd * (q + 1) : r * (q + 1) + (xcd - r) * q) + off; }
        const int nig = WGM * nN, gid = wgid / nig, fm = gid * WGM, gsz = (nM - fm) < WGM ? (nM - fm) : WGM;
        u.pm = fm + ((wgid % nig) % gsz); u.pn = (wgid % nig) / gsz; return true;
    }
    __device__ __forceinline__ void a_ready(const Unit&) const {}
    __device__ __forceinline__ void done(const Unit&) const {}
};

template <class Epi, class Sched, bool ALIGN_EPI = false, bool SP2 = false, bool ROWPERM = false>
__device__ __forceinline__ void gemm_phase(PG8_LAS unsigned char* lds, const Gemm g, const Sched& S, const Epi& E, const int wv) {
    const int tid = opaque_tid(wv), wid = __builtin_amdgcn_readfirstlane(tid >> 6), lane = tid & 63, wr = wid >> 2, wc = wid & 3, fr = lane & 15, fq = lane >> 4;
    const int K = g.K, nt = K / BK;
    unsigned voffA[2], voffB[2];
#pragma unroll
    for (int i = 0; i < 2; ++i) { int R, C; stage_rc(tid * 16 + i * 8192, R, C); const int Rb = Epi::PERM ? ((R & ~31) + perm32(R & 31)) : R;
        const int Ra = ROWPERM ? (128 * (R >> 6) + 8 * (R & 15) + ((R >> 4) & 3)) : R;
        voffA[i] = (unsigned)(Ra * K + C) * 2u; voffB[i] = (unsigned)(Rb * K + C) * 2u; }
    const size_t kstep = (size_t)(BK * 2);
    const size_t hstep = (size_t)HALF * K * 2;
    const size_t tstep = 2 * hstep; const size_t hstepA = ROWPERM ? (size_t)4 * K * 2 : hstep;
    const unsigned ldsw = (unsigned)wid * 1024u;
    const int aoff = lds_byte(wr * 64 + fr, fq * 8), boff = lds_byte(wc * 32 + fr, fq * 8);
#define PG8_SA(b, h) (((b) * 2 + (h)) * HTB)
#define PG8_SB(b, h) ((4 + (b) * 2 + (h)) * HTB)
#define PG8_STAGE(bufoff, gbase, voff) do { _Pragma("unroll") for (int _i = 0; _i < 2; ++_i) \
        __builtin_amdgcn_global_load_lds((const unsigned*)((const char*)(gbase) + (voff)[_i]), (PG8_LAS unsigned*)(lds + (bufoff) + ldsw + _i * 8192), 16, 0, 0); } while (0)
#define PG8_LDA(dst, b, h) do { _Pragma("unroll") for (int m = 0; m < 4; ++m) _Pragma("unroll") for (int k = 0; k < 2; ++k) dst[m][k] = *(const PG8_LAS bf16x8*)(lds + PG8_SA(b, h) + aoff + m * 2048 + k * 1024); } while (0)
#define PG8_LDB(dst, b, h) do { _Pragma("unroll") for (int n = 0; n < 2; ++n) _Pragma("unroll") for (int k = 0; k < 2; ++k) dst[n][k] = *(const PG8_LAS bf16x8*)(lds + PG8_SB(b, h) + boff + n * 2048 + k * 1024); } while (0)
#define PG8_MMA(ai, bj, At, Bt) do { __builtin_amdgcn_s_setprio(1); _Pragma("unroll") for (int m = 0; m < 4; ++m) _Pragma("unroll") for (int n = 0; n < 2; ++n) _Pragma("unroll") for (int k = 0; k < 2; ++k) \
        acc[ai][bj][m][n] = __builtin_amdgcn_mfma_f32_16x16x32_bf16(Bt[n][k], At[m][k], acc[ai][bj][m][n], 0, 0, 0); __builtin_amdgcn_s_setprio(0); } while (0)
#define PG8_WAIT_V(n) asm volatile("s_waitcnt vmcnt(" #n ")" ::: "memory")
#define PG8_WAIT_L(n) asm volatile("s_waitcnt lgkmcnt(" #n ")" ::: "memory")
#define PG8_BAR __builtin_amdgcn_s_barrier()
#define PG8_SCHED __builtin_amdgcn_sched_barrier(0)
    Unit cur, nxt; int ui = 0;
    if (!S.next(0, cur)) return;
    f32x4 acc[2][2][4][2];
#pragma unroll
    for (int a = 0; a < 2; ++a)
#pragma unroll
        for (int b = 0; b < 2; ++b)
#pragma unroll
            for (int m = 0; m < 4; ++m)
#pragma unroll
                for (int n = 0; n < 2; ++n) acc[a][b][m][n] = (f32x4){0.f, 0.f, 0.f, 0.f};
    bf16x8 At[4][2], B0[2][2], B1[2][2];
    const char* cA = (const char*)g.A + (size_t)cur.pm * tstep; const char* cB = (const char*)g.Bt + (size_t)cur.pn * tstep;
    S.a_ready(cur);
    if constexpr (SP2) {
        PG8_STAGE(PG8_SB(0, 0), cB, voffB); PG8_STAGE(PG8_SB(0, 1), cB + hstep, voffB); PG8_STAGE(PG8_SA(0, 0), cA, voffA); PG8_STAGE(PG8_SA(0, 1), cA + hstepA, voffA);
        if (wr == 1) PG8_BAR;
        PG8_WAIT_V(2); PG8_BAR;
        PG8_STAGE(PG8_SB(1, 0), cB + kstep, voffB); PG8_STAGE(PG8_SA(1, 0), cA + kstep, voffA); PG8_STAGE(PG8_SB(1, 1), cB + hstep + kstep, voffB);
        PG8_WAIT_V(6); PG8_BAR;
    } else {
        PG8_STAGE(PG8_SB(0, 0), cB, voffB); PG8_STAGE(PG8_SA(0, 0), cA, voffA); PG8_STAGE(PG8_SB(0, 1), cB + hstep, voffB); PG8_STAGE(PG8_SA(0, 1), cA + hstepA, voffA);
        if (wr == 1) PG8_BAR;
        PG8_WAIT_V(4); PG8_BAR;
        PG8_STAGE(PG8_SB(1, 0), cB + kstep, voffB); PG8_STAGE(PG8_SA(1, 0), cA + kstep, voffA); PG8_STAGE(PG8_SB(1, 1), cB + hstep + kstep, voffB);
        PG8_WAIT_V(6); PG8_BAR;
    }
    for (;;) {
        const bool has_next = S.next(ui + 1, nxt);
        const char* nA = has_next ? (const char*)g.A + (size_t)nxt.pm * tstep : cA; const char* nB = has_next ? (const char*)g.Bt + (size_t)nxt.pn * tstep : cB;
        for (int t = 0; t < nt; t += 2) {
            const bool last = (t == nt - 2);
            const char* a1 = cA + (size_t)(t + 1) * kstep;
            const char* a2 = last ? nA : cA + (size_t)(t + 2) * kstep; const char* b2 = last ? nB : cB + (size_t)(t + 2) * kstep;
            const char* a3 = a2 + kstep; const char* b3 = b2 + kstep;
            if (last && has_next) S.a_ready(nxt);
            if constexpr (SP2) {
            PG8_LDB(B0, 0, 0); PG8_LDB(B1, 0, 1); PG8_SCHED; PG8_LDA(At, 0, 0); PG8_STAGE(PG8_SA(1, 1), a1 + hstepA, voffA);
            PG8_WAIT_V(8); PG8_WAIT_L(0); PG8_BAR; PG8_MMA(0, 0, At, B0); PG8_MMA(0, 1, At, B1); PG8_BAR; PG8_SCHED;
            PG8_LDA(At, 0, 1); PG8_STAGE(PG8_SB(0, 0), b2, voffB); PG8_STAGE(PG8_SB(0, 1), b2 + hstep, voffB); PG8_STAGE(PG8_SA(0, 0), a2, voffA);
            PG8_WAIT_V(8); PG8_WAIT_L(0); PG8_BAR; PG8_MMA(1, 0, At, B0); PG8_MMA(1, 1, At, B1); PG8_BAR; PG8_SCHED;
            PG8_LDB(B0, 1, 0); PG8_LDB(B1, 1, 1); PG8_SCHED; PG8_LDA(At, 1, 0); PG8_STAGE(PG8_SA(0, 1), a2 + hstepA, voffA);
            PG8_WAIT_V(8); PG8_WAIT_L(0); PG8_BAR; PG8_MMA(0, 0, At, B0); PG8_MMA(0, 1, At, B1); PG8_BAR; PG8_SCHED;
            PG8_LDA(At, 1, 1); PG8_STAGE(PG8_SB(1, 0), b3, voffB); PG8_STAGE(PG8_SB(1, 1), b3 + hstep, voffB); PG8_STAGE(PG8_SA(1, 0), a3, voffA);
            PG8_WAIT_V(8); PG8_WAIT_L(0); PG8_BAR; PG8_MMA(1, 0, At, B0); PG8_MMA(1, 1, At, B1); PG8_BAR; PG8_SCHED;
            } else {
            PG8_LDB(B0, 0, 0); PG8_SCHED; PG8_LDA(At, 0, 0); PG8_STAGE(PG8_SA(1, 1), a1 + hstepA, voffA);
            PG8_WAIT_L(8); PG8_BAR; PG8_WAIT_L(0); PG8_MMA(0, 0, At, B0); PG8_BAR; PG8_SCHED;
            PG8_LDB(B1, 0, 1); PG8_STAGE(PG8_SB(0, 0), b2, voffB);
            PG8_BAR; PG8_WAIT_L(0); PG8_MMA(0, 1, At, B1); PG8_BAR;
            PG8_LDA(At, 0, 1); PG8_STAGE(PG8_SA(0, 0), a2, voffA);
            PG8_BAR; PG8_WAIT_L(0); PG8_MMA(1, 0, At, B0); PG8_BAR; PG8_SCHED;
            PG8_STAGE(PG8_SB(0, 1), b2 + hstep, voffB);
            PG8_WAIT_V(6); PG8_BAR; PG8_MMA(1, 1, At, B1); PG8_BAR;
            PG8_LDB(B0, 1, 0); PG8_SCHED; PG8_LDA(At, 1, 0); PG8_STAGE(PG8_SA(0, 1), a2 + hstepA, voffA);
            PG8_WAIT_L(8); PG8_BAR; PG8_WAIT_L(0); PG8_MMA(0, 0, At, B0); PG8_BAR; PG8_SCHED;
            PG8_LDB(B1, 1, 1); PG8_STAGE(PG8_SB(1, 0), b3, voffB);
            PG8_BAR; PG8_WAIT_L(0); PG8_MMA(0, 1, At, B1); PG8_BAR;
            PG8_LDA(At, 1, 1); PG8_STAGE(PG8_SA(1, 0), a3, voffA);
            PG8_BAR; PG8_WAIT_L(0); PG8_MMA(1, 0, At, B0); PG8_BAR; PG8_SCHED;
            PG8_STAGE(PG8_SB(1, 1), b3 + hstep, voffB);
            PG8_WAIT_V(6); PG8_BAR; PG8_MMA(1, 1, At, B1); PG8_BAR;
            }
        }
        if constexpr (ALIGN_EPI) { if (wr == 0) PG8_BAR; }
        if constexpr (!Epi::AFTER_DRAIN) { E(acc, cur, wr, wc, fr, fq); S.done(cur); }
        if (!has_next) break;
#pragma unroll
        for (int a = 0; a < 2; ++a)
#pragma unroll
            for (int b = 0; b < 2; ++b)
#pragma unroll
                for (int m = 0; m < 4; ++m)
#pragma unroll
                    for (int n = 0; n < 2; ++n) acc[a][b][m][n] = (f32x4){0.f, 0.f, 0.f, 0.f};
        cur = nxt; cA = nA; cB = nB; ++ui;
        if constexpr (ALIGN_EPI) { if (wr == 1) PG8_BAR; }
    }
    PG8_WAIT_V(0);
    if constexpr (!ALIGN_EPI) { if (wr == 0) PG8_BAR; }
    PG8_BAR;
    if constexpr (Epi::AFTER_DRAIN) { E.fused(acc, cur, wr, wc, fr, fq, lds, wid, lane); S.done(cur); }
#undef PG8_SA
#undef PG8_SB
#undef PG8_STAGE
#undef PG8_LDA
#undef PG8_LDB
#undef PG8_MMA
#undef PG8_WAIT_V
#undef PG8_WAIT_L
#undef PG8_BAR
#undef PG8_SCHED
}
}
typedef pg8::bf16_t bf16_t;
typedef pg8::bf16x8 bf16x8;
typedef pg8::f32x4 f32x4;
typedef pg8::u32x4 u32x4;
typedef unsigned u32x2 __attribute__((ext_vector_type(2)));
#define LAS __attribute__((address_space(3)))

constexpr int DM = 1024, NB = 4, SEQ = 8192, MTOK = NB * SEQ, DIN = 7168, DFF = 3072, DFF2 = 6144, NL = 2;
constexpr int NTH = 512;
constexpr float EPS = 1e-6f;
constexpr int RT = 128, NT = SEQ / RT;
constexpr size_t WS_BAR = 0;
constexpr size_t WS_MOD = 16384;
constexpr size_t WS_GW = WS_MOD + (size_t)NL * NB * 6144 * 4;
constexpr size_t WS_SUM = WS_GW + (size_t)NL * 2 * 8 * 128 * 128 * 2;
constexpr size_t WS_HIN = WS_SUM + (size_t)NB * NT * 1024 * 2 * 4;
constexpr size_t WS_W = (WS_HIN + (size_t)NB * NT * 1024 * 4 + 4095) / 4096 * 4096;
constexpr size_t W_IN_E = (size_t)DIN * DM, W_OUT_E = (size_t)DM * DM, W_UP_E = (size_t)DFF2 * DM, W_DN_E = (size_t)DM * DFF, W_LAYER_E = W_IN_E + W_OUT_E + W_UP_E + W_DN_E;
constexpr size_t WS_XN = WS_W + NL * W_LAYER_E * 2;
constexpr size_t PBUF = (size_t)MTOK * DM * 2;
constexpr size_t WS_P = WS_XN + PBUF;
constexpr size_t WS_XB = WS_XN;
constexpr size_t WS_END = WS_P + 5 * PBUF;
constexpr size_t ACT_BYTES = (size_t)MTOK * DFF * 2;

__device__ __forceinline__ float bf2f(bf16_t b) { return __uint_as_float(((unsigned)b) << 16); }
__device__ __forceinline__ unsigned pk2(float lo, float hi) { unsigned r; asm volatile("v_cvt_pk_bf16_f32 %0, %1, %2" : "=v"(r) : "v"(lo), "v"(hi)); return r; }
__device__ __forceinline__ float bflo(unsigned w) { return __uint_as_float(w << 16); }
__device__ __forceinline__ float bfhi(unsigned w) { return __uint_as_float(w & 0xffff0000u); }
__device__ __forceinline__ float lane_get(float x, int srclane) { return __builtin_bit_cast(float, __builtin_amdgcn_ds_bpermute(srclane << 2, __builtin_bit_cast(int, x))); }
__device__ __forceinline__ float sigmoidf_(float x) { return __builtin_amdgcn_rcpf(1.0f + __expf(-x)); }
__device__ __forceinline__ float gelu_tanh(float x) { const float u = 1.5957691216057308f * (x + 0.044715f * x * x * x); return x * sigmoidf_(u); }

__device__ __forceinline__ pg8::f32x4 exp2_4(pg8::f32x4 t) { return (pg8::f32x4){__builtin_amdgcn_exp2f(t[0]), __builtin_amdgcn_exp2f(t[1]), __builtin_amdgcn_exp2f(t[2]), __builtin_amdgcn_exp2f(t[3])}; }
__device__ __forceinline__ pg8::f32x4 rcp_4(pg8::f32x4 t) { return (pg8::f32x4){__builtin_amdgcn_rcpf(t[0]), __builtin_amdgcn_rcpf(t[1]), __builtin_amdgcn_rcpf(t[2]), __builtin_amdgcn_rcpf(t[3])}; }
__device__ __forceinline__ pg8::f32x4 gelu_den4(pg8::f32x4 x) { return exp2_4(x * (x * x * (0.044715f * -2.3022082f) + -2.3022082f)) + 1.0f; }
__device__ __forceinline__ pg8::f32x4 sig_den4(pg8::f32x4 x) { return exp2_4(x * -1.4426950408889634f) + 1.0f; }

struct EpiSplit {
    static constexpr bool PERM = true, AFTER_DRAIN = false;
    bf16_t* base; size_t tstride; int modes; int skip3;
    __device__ __forceinline__ void operator()(const f32x4 (&acc)[2][2][4][2], const pg8::Unit& u, int wr, int wc, int fr, int fq) const {
        const int colt = u.pn * 256, t = colt >> 10; const int mode = (modes >> (4 * t)) & 15;
        bf16_t* o = base + (size_t)(t + ((skip3 && t == 3) ? 1 : 0)) * tstride; const int col0 = (colt & 1023) + wc * 32 + 8 * fq; const int row0 = u.pm * 256 + wr * 64 + fr;
#pragma unroll
        for (int ai = 0; ai < 2; ++ai)
#pragma unroll
            for (int m = 0; m < 4; ++m) { bf16_t* rowp = o + (size_t)(row0 + ai * 128 + m * 16) * DM + col0;
#pragma unroll
                for (int bj = 0; bj < 2; ++bj) { f32x4 v0 = acc[ai][bj][m][0], v1 = acc[ai][bj][m][1];
                    if (mode == 1) {
#pragma unroll
                        for (int j = 0; j < 4; ++j) { v0[j] = gelu_tanh(v0[j]); v1[j] = gelu_tanh(v1[j]); } }
                    else if (mode == 2) {
#pragma unroll
                        for (int j = 0; j < 4; ++j) { v0[j] = sigmoidf_(v0[j]); v1[j] = sigmoidf_(v1[j]); } }
                    u32x4 w; w.x = pk2(v0[0], v0[1]); w.y = pk2(v0[2], v0[3]); w.z = pk2(v1[0], v1[1]); w.w = pk2(v1[2], v1[3]);
                    *(u32x4*)(rowp + bj * 128) = w; } }
    }
};
struct EpiIn {
    static constexpr bool PERM = true, AFTER_DRAIN = false;
    bf16_t* P; bf16_t* P5;
    __device__ __forceinline__ void operator()(const f32x4 (&acc)[2][2][4][2], const pg8::Unit& u, int wr, int wc, int fr, int fq) const {
        const int row0 = u.pm * 256 + wr * 64 + fr; const int pn = u.pn;
        if (pn >= 4 && pn < 12) {
            bf16_t* o = P + (size_t)4 * MTOK * DM + (pn - 4) * 128 + wc * 32 + 8 * fq;
#pragma unroll
            for (int ai = 0; ai < 2; ++ai)
#pragma unroll
                for (int m = 0; m < 4; ++m) { float g[8];
                    { const f32x4 g0 = acc[ai][0][m][0] * rcp_4(gelu_den4(acc[ai][0][m][0]) * sig_den4(acc[ai][1][m][0])), g1 = acc[ai][0][m][1] * rcp_4(gelu_den4(acc[ai][0][m][1]) * sig_den4(acc[ai][1][m][1]));
                      g[0] = g0[0]; g[1] = g0[1]; g[2] = g0[2]; g[3] = g0[3]; g[4] = g1[0]; g[5] = g1[1]; g[6] = g1[2]; g[7] = g1[3]; }
                    u32x4 w; w.x = pk2(g[0], g[1]); w.y = pk2(g[2], g[3]); w.z = pk2(g[4], g[5]); w.w = pk2(g[6], g[7]);
                    *(u32x4*)(o + (size_t)(row0 + ai * 128 + m * 16) * DM) = w; }
        } else {
            const bool sg = pn >= 12 && pn < 16;
            bf16_t* o = (pn < 4 ? P + (size_t)3 * MTOK * DM + pn * 256 : sg ? P5 + (pn - 12) * 256 : P + (size_t)((pn - 16) >> 2) * MTOK * DM + ((pn - 16) & 3) * 256) + wc * 32 + 8 * fq;
#pragma unroll
            for (int ai = 0; ai < 2; ++ai)
#pragma unroll
                for (int m = 0; m < 4; ++m) { bf16_t* rowp = o + (size_t)(row0 + ai * 128 + m * 16) * DM;
#pragma unroll
                    for (int bj = 0; bj < 2; ++bj) { f32x4 v0 = acc[ai][bj][m][0], v1 = acc[ai][bj][m][1];
                        if (sg) { v0 = rcp_4(sig_den4(v0)); v1 = rcp_4(sig_den4(v1)); }
                        u32x4 w; w.x = pk2(v0[0], v0[1]); w.y = pk2(v0[2], v0[3]); w.z = pk2(v1[0], v1[1]); w.w = pk2(v1[2], v1[3]);
                        *(u32x4*)(rowp + bj * 128) = w; } }
        }
    }
};
struct EpiPlain {
    static constexpr bool PERM = true, AFTER_DRAIN = false;
    bf16_t* o; int ldc;
    __device__ __forceinline__ void operator()(const f32x4 (&acc)[2][2][4][2], const pg8::Unit& u, int wr, int wc, int fr, int fq) const {
        const int col0 = u.pn * 256 + wc * 32 + 8 * fq; const int row0 = u.pm * 256 + wr * 64 + fr;
#pragma unroll
        for (int ai = 0; ai < 2; ++ai)
#pragma unroll
            for (int m = 0; m < 4; ++m) { bf16_t* rowp = o + (size_t)(row0 + ai * 128 + m * 16) * ldc + col0;
#pragma unroll
                for (int bj = 0; bj < 2; ++bj) { const f32x4 v0 = acc[ai][bj][m][0], v1 = acc[ai][bj][m][1];
                    u32x4 w; w.x = pk2(v0[0], v0[1]); w.y = pk2(v0[2], v0[3]); w.z = pk2(v1[0], v1[1]); w.w = pk2(v1[2], v1[3]);
                    *(u32x4*)(rowp + bj * 128) = w; } }
    }
};
struct EpiRes {
    static constexpr bool PERM = true, AFTER_DRAIN = false;
    const float* resf; const bf16_t* resb; bf16_t* xb; float* outf; const float* gate  ;
    __device__ __forceinline__ void operator()(const f32x4 (&acc)[2][2][4][2], const pg8::Unit& u, int wr, int wc, int fr, int fq) const {
        const int grow0 = u.pm * 256; const int b = grow0 / SEQ; const int row0 = grow0 + wr * 64 + fr, col0 = u.pn * 256 + wc * 32 + 8 * fq;
        f32x4 gv[2][2];
#pragma unroll
        for (int bj = 0; bj < 2; ++bj)
#pragma unroll
            for (int n = 0; n < 2; ++n) gv[bj][n] = *(const f32x4*)(gate + (size_t)b * 6144 + col0 + bj * 128 + n * 4);
#pragma unroll
        for (int am = 0; am < 4; ++am) { const int ai = am >> 1, m0 = (am & 1) * 2;
            f32x4 rv[2][2][2];
            if (resf) {
#pragma unroll
                for (int mm = 0; mm < 2; ++mm) { const size_t off = (size_t)(row0 + ai * 128 + (m0 + mm) * 16) * DM + col0;
#pragma unroll
                    for (int bj = 0; bj < 2; ++bj)
#pragma unroll
                        for (int n = 0; n < 2; ++n) rv[mm][bj][n] = *(const f32x4*)(resf + off + bj * 128 + n * 4); }
            } else {
#pragma unroll
                for (int mm = 0; mm < 2; ++mm) { const size_t off = (size_t)(row0 + ai * 128 + (m0 + mm) * 16) * DM + col0;
#pragma unroll
                    for (int bj = 0; bj < 2; ++bj) { const u32x4 rw = *(const u32x4*)(resb + off + bj * 128);
                        rv[mm][bj][0] = (f32x4){bflo(rw.x), bfhi(rw.x), bflo(rw.y), bfhi(rw.y)}; rv[mm][bj][1] = (f32x4){bflo(rw.z), bfhi(rw.z), bflo(rw.w), bfhi(rw.w)}; } }
            }
#pragma unroll
            for (int mm = 0; mm < 2; ++mm) { const int m = m0 + mm; const size_t off = (size_t)(row0 + ai * 128 + m * 16) * DM + col0;
#pragma unroll
                for (int bj = 0; bj < 2; ++bj) { const f32x4 y0 = rv[mm][bj][0] + gv[bj][0] * acc[ai][bj][m][0], y1 = rv[mm][bj][1] + gv[bj][1] * acc[ai][bj][m][1];
                    if (outf) { *(f32x4*)(outf + off + bj * 128) = y0; *(f32x4*)(outf + off + bj * 128 + 4) = y1; }
                    else { u32x4 w; w.x = pk2(y0[0], y0[1]); w.y = pk2(y0[2], y0[3]); w.z = pk2(y1[0], y1[1]); w.w = pk2(y1[2], y1[3]); *(u32x4*)(xb + off + bj * 128) = w; } } }
            asm volatile("" ::: "memory"); }
    }
};


#define XB_TMO      128
#define XB_XCNT(j)  (256  + 64 * (j))
#define XB_XSUB(j)  (1280 + 64 * (j))
#define XB_XGEN(j)  (2304 + 64 * (j))
#define XB_TOP      3328
#define XB_TOPGEN   3392
#define XCD_BAR_WORDS 3456
#define XB_SPIN_CAP (1u << 22)
__device__ __forceinline__ unsigned xb_ld(unsigned* p)              { return __hip_atomic_load(p, __ATOMIC_RELAXED, __HIP_MEMORY_SCOPE_AGENT); }
__device__ __forceinline__ unsigned xb_add(unsigned* p, unsigned v) { return __hip_atomic_fetch_add(p, v, __ATOMIC_RELAXED, __HIP_MEMORY_SCOPE_AGENT); }
__device__ __forceinline__ unsigned xb_xcc_id() { return (unsigned)__builtin_amdgcn_s_getreg((3 << 11) | 20) & 0xFu; }
#define XB_SPIN(cond, bar) do { unsigned _sp = 0; while (cond) { __builtin_amdgcn_s_sleep(1); \
    if ((++_sp & 255u) == 0u) { if (xb_ld(&(bar)[XB_TMO])) break; if (_sp > XB_SPIN_CAP) { atomicAdd(&(bar)[XB_TMO], 1u); break; } } } } while (0)
struct XcdBarrier { unsigned* bar; unsigned x; volatile LAS unsigned* st; };
__device__ __forceinline__ XcdBarrier xcd_barrier_post(unsigned* bar, volatile LAS unsigned* st) {
    XcdBarrier b; b.bar = bar; b.x = xb_xcc_id(); b.st = st;
    if (threadIdx.x == 0) (void)xb_add(&bar[XB_XCNT(b.x)], 1u);
    return b;
}
__device__ __forceinline__ void xcd_barrier_complete(unsigned* bar, unsigned x, unsigned& nloc, unsigned& nx) {
    const unsigned G = gridDim.x * gridDim.y * gridDim.z;
    unsigned sum, cnt, mine, sp = 0u;
    for (;;) {
        sum = 0u; cnt = 0u; mine = 0u;
#pragma unroll
        for (unsigned j = 0; j < 16; ++j) { const unsigned c = xb_ld(&bar[XB_XCNT(j)]); sum += c; cnt += (c > 0u) ? 1u : 0u; mine = (j == x) ? c : mine; }
        if (sum == G) break;
        __builtin_amdgcn_s_sleep(1);
        if ((++sp & 255u) == 0u) { if (xb_ld(&bar[XB_TMO])) break; if (sp > XB_SPIN_CAP) { atomicAdd(&bar[XB_TMO], 1u); break; } }
    }
    nloc = mine > 0u ? mine : 1u; nx = cnt > 0u ? cnt : 1u;
}
__device__ __forceinline__ void xcd_barrier(const XcdBarrier& b, const int wv) {
    asm volatile("s_waitcnt vmcnt(0)" ::: "memory");
    __syncthreads();
    if (opaque_tid(wv) == 0) {
        unsigned* bar = b.bar;
        __builtin_amdgcn_s_waitcnt(0);
        unsigned nloc = b.st[0], nx = b.st[1];
        if (nloc == 0u) { xcd_barrier_complete(bar, b.x, nloc, nx); b.st[0] = nloc; b.st[1] = nx; }
        const unsigned old = xb_add(&bar[XB_XSUB(b.x)], 1u);
        const unsigned gen = old / nloc;
        if (old + 1u == (gen + 1u) * nloc) {
            __builtin_amdgcn_fence(__ATOMIC_RELEASE, "agent");
            asm volatile("s_waitcnt vmcnt(0)" ::: "memory");
            const unsigned og = xb_add(&bar[XB_TOP], 1u);
            const unsigned tg = og / nx;
            if (og + 1u == (tg + 1u) * nx) xb_add(&bar[XB_TOPGEN], 1u);
            else XB_SPIN(xb_ld(&bar[XB_TOPGEN]) == tg, bar);
            __builtin_amdgcn_fence(__ATOMIC_ACQUIRE, "agent");
            xb_add(&bar[XB_XGEN(b.x)], 1u);
            asm volatile("s_waitcnt vmcnt(0)" ::: "memory");
        } else {
            XB_SPIN(xb_ld(&bar[XB_XGEN(b.x)]) == gen, bar);
            __builtin_amdgcn_fence(__ATOMIC_ACQUIRE, "agent");
            asm volatile("s_waitcnt vmcnt(0)" ::: "memory");
        }
    }
    __syncthreads();
}

__device__ __forceinline__ float dpp_shr1(float x) { return __builtin_bit_cast(float, __builtin_amdgcn_update_dpp(0, __builtin_bit_cast(int, x), 0x111, 0xf, 0xf, false)); }
struct EpiConvAct {
    static constexpr bool PERM = true, AFTER_DRAIN = false;
    bf16_t* act; bf16_t* halo; const float* cw; const float* cb;
    __device__ __forceinline__ void operator()(const f32x4 (&acc)[2][2][4][2], const pg8::Unit& u, int wr, int wc, int fr, int fq) const {
        const int tb = u.pm * 256 + 128 * wr, c0 = u.pn * 128 + wc * 32 + 8 * fq;
        bf16_t* hp = halo + (size_t)(tb >> 7) * 4 * DFF2;
#pragma unroll
        for (int n = 0; n < 2; ++n) {
            const int c = c0 + 4 * n;
            const f32x4 bg = *(const f32x4*)(cb + c), bv = *(const f32x4*)(cb + DFF + c);
            const f32x4 wg0 = *(const f32x4*)(cw + c), wg1 = *(const f32x4*)(cw + DFF2 + c), wg2 = *(const f32x4*)(cw + 2 * DFF2 + c);
            const f32x4 wv0 = *(const f32x4*)(cw + DFF + c), wv1 = *(const f32x4*)(cw + DFF2 + DFF + c), wv2 = *(const f32x4*)(cw + 2 * DFF2 + DFF + c);
            f32x4 pg6, pg7, pv6, pv7;
#pragma unroll
            for (int j = 0; j < 4; ++j) { pg6[j] = dpp_shr1(acc[1][0][2][n][j]); pg7[j] = dpp_shr1(acc[1][0][3][n][j]); pv6[j] = dpp_shr1(acc[1][1][2][n][j]); pv7[j] = dpp_shr1(acc[1][1][3][n][j]); }
#pragma unroll
            for (int q = 0; q < 8; ++q) {
                const f32x4 g = acc[q >> 2][0][q & 3][n], v = acc[q >> 2][1][q & 3][n];
                const f32x4 g1 = q >= 1 ? acc[(q - 1 + 8) % 8 >> 2][0][(q - 1 + 8) % 8 & 3][n] : pg7, g2 = q >= 2 ? acc[(q - 2 + 8) % 8 >> 2][0][(q - 2 + 8) % 8 & 3][n] : (q == 1 ? pg7 : pg6);
                const f32x4 v1 = q >= 1 ? acc[(q - 1 + 8) % 8 >> 2][1][(q - 1 + 8) % 8 & 3][n] : pv7, v2 = q >= 2 ? acc[(q - 2 + 8) % 8 >> 2][1][(q - 2 + 8) % 8 & 3][n] : (q == 1 ? pv7 : pv6);
                const f32x4 g1e = q == 0 ? pg7 : g1, g2e = q == 0 ? pg6 : g2, v1e = q == 0 ? pv7 : v1, v2e = q == 0 ? pv6 : v2;
                const f32x4 cg4 = bg + wg0 * g2e + wg1 * g1e + wg2 * g, cv4 = bv + wv0 * v2e + wv1 * v1e + wv2 * v; const f32x4 o = cg4 * cv4 * rcp_4(gelu_den4(cg4));
                if (fr > 0 || q >= 2) { u32x2 w; w.x = pk2(o[0], o[1]); w.y = pk2(o[2], o[3]); *(u32x2*)(act + (size_t)(tb + 8 * fr + q) * DFF + c) = w; }
                if ((fr == 0 && q < 2) || (fr == 15 && q >= 6)) { const int r = q < 2 ? q : q - 4; u32x2 wgp, wvp; wgp.x = pk2(g[0], g[1]); wgp.y = pk2(g[2], g[3]); wvp.x = pk2(v[0], v[1]); wvp.y = pk2(v[2], v[3]);
                    *(u32x2*)(hp + (size_t)r * DFF2 + c) = wgp; *(u32x2*)(hp + (size_t)r * DFF2 + DFF + c) = wvp; }
            }
        }
    }
};

struct Args { const float* in[21]; float* out; unsigned char* ws; };
typedef const __attribute__((address_space(4))) Args* ArgsP;

__device__ void p0_mod(ArgsP a, LAS unsigned char* lds, const int wv) {
    const int tid = opaque_tid(wv), w = tid >> 6, lane = tid & 63;
    const float* c = a->in[1]; const float* aw = a->in[2]; const float* ab = a->in[3]; float* mod = (float*)(a->ws + WS_MOD);
    LAS float* cs = (LAS float*)lds;
    LAS float* red = (LAS float*)(lds + 16384);
    if ((int)blockIdx.x < NL * 6144 / 64) {
        for (int i = tid; i < NB * DM; i += NTH) cs[i] = c[i];
        __syncthreads();
        const int gl = blockIdx.x * 64, l = gl / 6144, j0 = gl % 6144; const int c4 = lane & 15, kq = lane >> 4;
        const float* wp = aw + (size_t)l * DM * 6144 + (size_t)(w * 128 + kq) * 6144 + j0 + 4 * c4;
        f32x4 s0 = (f32x4){0.f, 0.f, 0.f, 0.f}, s1 = s0, s2 = s0, s3 = s0;
#pragma unroll 8
        for (int i = 0; i < 32; ++i) { const f32x4 wv4 = *(const f32x4*)(wp + (size_t)(4 * i) * 6144); const int k = w * 128 + 4 * i + kq;
            s0 += cs[k] * wv4; s1 += cs[DM + k] * wv4; s2 += cs[2 * DM + k] * wv4; s3 += cs[3 * DM + k] * wv4; }
#pragma unroll
        for (int e = 0; e < 4; ++e) { s0[e] += lane_get(s0[e], lane ^ 16); s0[e] += lane_get(s0[e], lane ^ 32); s1[e] += lane_get(s1[e], lane ^ 16); s1[e] += lane_get(s1[e], lane ^ 32);
            s2[e] += lane_get(s2[e], lane ^ 16); s2[e] += lane_get(s2[e], lane ^ 32); s3[e] += lane_get(s3[e], lane ^ 16); s3[e] += lane_get(s3[e], lane ^ 32); }
        if (kq == 0) { *(LAS f32x4*)(red + (w * 4 + 0) * 64 + 4 * c4) = s0; *(LAS f32x4*)(red + (w * 4 + 1) * 64 + 4 * c4) = s1; *(LAS f32x4*)(red + (w * 4 + 2) * 64 + 4 * c4) = s2; *(LAS f32x4*)(red + (w * 4 + 3) * 64 + 4 * c4) = s3; }
        __syncthreads();
        if (tid < 256) { const int b = tid >> 6; float sacc = ab[(size_t)l * 6144 + j0 + lane];
#pragma unroll
            for (int ww = 0; ww < 8; ++ww) sacc += red[(ww * 4 + b) * 64 + lane];
            mod[((size_t)l * NB + b) * 6144 + j0 + lane] = sacc; }
        __syncthreads();
    }
    bf16_t* gw = (bf16_t*)(a->ws + WS_GW);
    for (size_t idx = (size_t)blockIdx.x * NTH + tid; idx < (size_t)NL * 2 * 8 * 128 * 128; idx += (size_t)gridDim.x * NTH) {
        const int i = idx & 127, j = (idx >> 7) & 127, h = (idx >> 14) & 7, mat = (idx >> 17) & 1, l = (int)(idx >> 18);
        const float* src = a->in[mat ? 10 : 8];
        const float v = src[(((size_t)l * 8 + h) * 128 + i) * 128 + j];
        gw[idx] = (bf16_t)(pk2(v, v) & 0xffff);
    }
}
struct TMat { const float* W; bf16_t* Wt; int K, N, rmode, ntn; };
__device__ __forceinline__ TMat tmat_of(ArgsP a, int mi) {
    const int l = mi >> 2, k = mi & 3; bf16_t* wl = (bf16_t*)(a->ws + WS_W) + (size_t)l * W_LAYER_E; TMat m;
    if (k == 0) { m.W = a->in[5] + (size_t)l * DM * DIN; m.Wt = wl; m.K = DM; m.N = DIN; m.rmode = 1; }
    else if (k == 1) { m.W = a->in[15] + (size_t)l * DM * DM; m.Wt = wl + W_IN_E; m.K = DM; m.N = DM; m.rmode = 0; }
    else if (k == 2) { m.W = a->in[17] + (size_t)l * DM * DFF2; m.Wt = wl + W_IN_E + W_OUT_E; m.K = DM; m.N = DFF2; m.rmode = 2; }
    else { m.W = a->in[20] + (size_t)l * DFF * DM; m.Wt = wl + W_IN_E + W_OUT_E + W_UP_E; m.K = DFF; m.N = DM; m.rmode = 0; }
    m.ntn = m.N / 64; return m;
}
constexpr int TILES_IN = (DM / 64) * (DIN / 64), TILES_OUT = (DM / 64) * (DM / 64), TILES_UP = (DM / 64) * (DFF2 / 64), TILES_DN = (DFF / 64) * (DM / 64), TILES_L = TILES_IN + TILES_OUT + TILES_UP + TILES_DN;
__device__ __forceinline__ void tile_of(int g, int& mi, int& tile) {
    const int l = g / TILES_L; int r = g - l * TILES_L; int k = 0;
    if (r >= TILES_IN) { r -= TILES_IN; k = 1; if (r >= TILES_OUT) { r -= TILES_OUT; k = 2; if (r >= TILES_UP) { r -= TILES_UP; k = 3; } } }
    mi = l * 4 + k; tile = r;
}
__device__ void p0_weights(ArgsP a, LAS unsigned char* lds, const int wv) {
    const int tid = opaque_tid(wv), w = __builtin_amdgcn_readfirstlane(tid >> 6), lane = tid & 63;
    LAS float* t = (LAS float*)(lds + w * (64 * 68 * 4));
    const int NWV = gridDim.x * 8;
    for (int g = w * (int)gridDim.x + (int)blockIdx.x; g < NL * TILES_L; g += NWV) {
        int mi, tile; tile_of(g, mi, tile); const TMat m = tmat_of(a, mi);
        const int k0 = (tile / m.ntn) * 64, n0 = (tile % m.ntn) * 64;
        const float* p = m.W + (size_t)(k0 + (lane >> 4)) * m.N + n0 + (lane & 15) * 4;
        f32x4 v[16];
#pragma unroll
        for (int i = 0; i < 16; ++i) v[i] = *(const f32x4*)(p + (size_t)(4 * i) * m.N);
#pragma unroll
        for (int i = 0; i < 16; ++i) *(LAS f32x4*)(t + (4 * i + (lane >> 4)) * 68 + (lane & 15) * 4) = v[i];
        int nr = n0 + lane; if (m.rmode == 1) nr = nr < 1024 ? nr : nr < 2048 ? (1024 + ((nr - 1024) >> 7) * 256 + (nr & 127)) : nr < 5120 ? nr + 2048 : nr < 6144 ? (1024 + ((nr - 5120) >> 7) * 256 + 128 + (nr & 127)) : nr - 3072;
        else if (m.rmode == 2) nr = nr < DFF ? ((nr >> 7) * 256 + (nr & 127)) : (((nr - DFF) >> 7) * 256 + 128 + ((nr - DFF) & 127));
        bf16_t* op = m.Wt + (size_t)nr * m.K + k0;
#pragma unroll
        for (int pz = 0; pz < 8; ++pz) { float x[8];
#pragma unroll
            for (int e = 0; e < 8; ++e) x[e] = t[(pz * 8 + e) * 68 + lane];
            u32x4 o; o.x = pk2(x[0], x[1]); o.y = pk2(x[2], x[3]); o.z = pk2(x[4], x[5]); o.w = pk2(x[6], x[7]);
            *(u32x4*)(op + pz * 8) = o; }
    }
}
__device__ void norm_phase(const float* __restrict__ xf, const bf16_t* __restrict__ xbf, const float* __restrict__ g, const float* __restrict__ modl  , int shk, int sck, bf16_t* __restrict__ xn, const int wv) {
    const int tid = opaque_tid(wv); const int w = tid >> 6, lane = tid & 63;
    for (int rowp = blockIdx.x * 8 + w; rowp < MTOK / 2; rowp += gridDim.x * 8) {
        f32x4 v[2][4]; float ss[2] = {0.f, 0.f};
#pragma unroll
        for (int h = 0; h < 2; ++h) { const int row = rowp + h * (MTOK / 2);
            if (xf) { const float* xr = xf + (size_t)row * DM;
#pragma unroll
                for (int i = 0; i < 4; ++i) v[h][i] = *(const f32x4*)(xr + lane * 4 + 256 * i);
            } else { const bf16_t* xr = xbf + (size_t)row * DM;
#pragma unroll
                for (int i = 0; i < 4; ++i) { const u32x2 t = *(const u32x2*)(xr + lane * 4 + 256 * i); v[h][i] = (f32x4){bflo(t.x), bfhi(t.x), bflo(t.y), bfhi(t.y)}; } } }
#pragma unroll
        for (int h = 0; h < 2; ++h) {
#pragma unroll
            for (int i = 0; i < 4; ++i) ss[h] += v[h][i][0] * v[h][i][0] + v[h][i][1] * v[h][i][1] + v[h][i][2] * v[h][i][2] + v[h][i][3] * v[h][i][3]; }
#pragma unroll
        for (int o = 32; o >= 1; o >>= 1) { ss[0] += lane_get(ss[0], lane ^ o); ss[1] += lane_get(ss[1], lane ^ o); }
#pragma unroll
        for (int h = 0; h < 2; ++h) { const int row = rowp + h * (MTOK / 2); const int b = row / SEQ;
            const float rstd = rsqrtf(ss[h] * (1.0f / DM) + EPS);
            const float* sh = modl + (size_t)b * 6144 + shk * 1024; const float* sc = modl + (size_t)b * 6144 + sck * 1024;
#pragma unroll
            for (int i = 0; i < 4; ++i) { const int c = lane * 4 + 256 * i; const f32x4 gg = *(const f32x4*)(g + c), s1 = *(const f32x4*)(sc + c), s0 = *(const f32x4*)(sh + c);
                f32x4 y;
#pragma unroll
                for (int j = 0; j < 4; ++j) y[j] = v[h][i][j] * rstd * gg[j] * (1.0f + s1[j]) + s0[j];
                u32x2 o; o.x = pk2(y[0], y[1]); o.y = pk2(y[2], y[3]); *(u32x2*)(xn + (size_t)row * DM + c) = o; } }
    }
}
constexpr int KP = 272, VP = 136;
constexpr int ASLOT = 64 * KP + 128 * VP;
constexpr float DEAD = 1e-20f;
typedef float f32x2 __attribute__((ext_vector_type(2)));
template <bool DIAG>
__device__ __forceinline__ void sb_weights(const f32x4 (&S)[4], float& carry, unsigned (&pw)[4][2], int q, int key0, int fq, int lane) {
    {
        f32x2 w01[4], w23[4]; float T[4], ab[4];
#pragma unroll
        for (int nb = 0; nb < 4; ++nb) {
            float E[4], be[4];
#pragma unroll
            for (int e = 0; e < 4; ++e) E[e] = __builtin_amdgcn_exp2f(-__builtin_amdgcn_fmed3f(S[nb][e], -115.f, 115.f));
            const f32x2 d01 = (f32x2){E[0], E[1]} + 1.0f, d23 = (f32x2){E[2], E[3]} + 1.0f;
            be[0] = __builtin_amdgcn_rcpf(d01.x); be[1] = __builtin_amdgcn_rcpf(d01.y); be[2] = __builtin_amdgcn_rcpf(d23.x); be[3] = __builtin_amdgcn_rcpf(d23.y);
            f32x2 b01 = (f32x2){be[0], be[1]}, b23 = (f32x2){be[2], be[3]};
            f32x2 o01 = (f32x2){E[0], E[1]} * b01, o23 = (f32x2){E[2], E[3]} * b23;
            if (DIAG) { const int k = key0 + 16 * nb;
                const bool m0 = k + 0 < q, m1 = k + 1 < q, m2 = k + 2 < q, m3 = k + 3 < q;
                b01.x = m0 ? b01.x : 0.f; o01.x = m0 ? o01.x : 1.f; b01.y = m1 ? b01.y : 0.f; o01.y = m1 ? o01.y : 1.f; b23.x = m2 ? b23.x : 0.f; o23.x = m2 ? o23.x : 1.f; b23.y = m3 ? b23.y : 0.f; o23.y = m3 ? o23.y : 1.f; }
            const float s1 = o23.y * o23.x, s0 = s1 * o01.y, run = s0 * o01.x;
            w01[nb] = b01 * (f32x2){s0, s1}; w23[nb] = b23 * (f32x2){o23.y, 1.0f};
            const float g1 = lane_get(run, lane ^ 16), g2 = lane_get(run, lane ^ 32), g3 = lane_get(g1, lane ^ 32);
            const float g23 = g2 * g3; T[nb] = (run * g1) * g23; ab[nb] = fq == 0 ? (g1 * g23) : fq == 1 ? g23 : fq == 2 ? g1 : 1.f; }
        float hi = carry;
#pragma unroll
        for (int nb = 3; nb >= 0; --nb) { const float base = hi * ab[nb]; const f32x2 p01 = w01[nb] * base, p23 = w23[nb] * base;
            pw[nb][0] = pk2(p01.x, p01.y); pw[nb][1] = pk2(p23.x, p23.y); hi *= T[nb]; }
        carry = hi;
    }
}
__device__ __forceinline__ void attn_stage(LAS unsigned char* Ks, LAS unsigned char* Vt, const u32x4 (&kr)[2], const u32x4 (&vr)[2], const float (&gks)[8], int sp, int skp, int lane) {
#pragma unroll
    for (int i = 0; i < 2; ++i) { float x[8]; float ss = 0.f;
#pragma unroll
        for (int j = 0; j < 4; ++j) { x[2 * j] = bflo(kr[i][j]); x[2 * j + 1] = bfhi(kr[i][j]); ss += x[2 * j] * x[2 * j] + x[2 * j + 1] * x[2 * j + 1]; }
        ss += lane_get(ss, lane ^ 1); ss += lane_get(ss, lane ^ 2); ss += lane_get(ss, lane ^ 4); ss += lane_get(ss, lane ^ 8);
        const float rs = rsqrtf(ss * (1.0f / 128.0f) + EPS);
        u32x4 o;
#pragma unroll
        for (int j = 0; j < 4; ++j) o[j] = pk2(x[2 * j] * rs * gks[2 * j], x[2 * j + 1] * rs * gks[2 * j + 1]);
        *(LAS u32x4*)(Ks + (2 * skp + i) * KP + sp * 16) = o; }
    const int wsz = skp ^ (sp & 14);
#pragma unroll
    for (int j = 0; j < 4; ++j) { *(LAS unsigned*)(Vt + (sp * 8 + 2 * j) * VP + wsz * 4) = (vr[0][j] & 0xffffu) | (vr[1][j] << 16); *(LAS unsigned*)(Vt + (sp * 8 + 2 * j + 1) * VP + wsz * 4) = (vr[0][j] >> 16) | (vr[1][j] & 0xffff0000u); }
}
__device__ void attn_phase(ArgsP a, int l, LAS unsigned char* lds, const int wv) {
    const int tid = opaque_tid(wv), w = __builtin_amdgcn_readfirstlane(tid >> 6), lane = tid & 63, fr = lane & 15, fq = lane >> 4;
    LAS int* flags = (LAS int*)(lds + 4 * ASLOT);
    const bf16_t* Qb = (const bf16_t*)(a->ws + WS_P); bf16_t* Yb = (bf16_t*)(a->ws + WS_P);     const bf16_t* Kb = (const bf16_t*)(a->ws + WS_P + PBUF); const bf16_t* Vb = (const bf16_t*)(a->ws + WS_P + 2 * PBUF);
    const float* gq = a->in[13] + l * 128; const float* gk = a->in[14] + l * 128;
    const int sp = tid & 15, skp = tid >> 4;
    float gks[8];
#pragma unroll
    for (int e = 0; e < 8; ++e) gks[e] = gk[sp * 8 + e] * gq[sp * 8 + e];
    const int nunits = NB * 8 * (SEQ / 256);
    for (int unit = blockIdx.x; unit < nunits; unit += gridDim.x) {
        const int qt = (SEQ / 256 - 1) - unit / (NB * 8), bh = unit % (NB * 8), b = bh >> 3, hh = bh & 7;
        const size_t rowbase = (size_t)b * SEQ; const int t0 = qt * 256, r0 = t0 + 32 * w;
        const int kbw = qt * 4 + (w >> 1);
        const bf16_t* kbase = Kb + rowbase * DM + hh * 128 + sp * 8; const bf16_t* vbase = Vb + rowbase * DM + hh * 128 + sp * 8;
        u32x4 kr[2], vr[2];
#pragma unroll
        for (int h2 = 0; h2 < 2; ++h2) { u32x4 k4[2][2], v4[2][2];
#pragma unroll
          for (int i4 = 0; i4 < 2; ++i4)
#pragma unroll
              for (int i = 0; i < 2; ++i) { const size_t ro = (size_t)((qt * 4 + 2 * h2 + i4) * 64 + 2 * skp + i) * DM; k4[i4][i] = *(const u32x4*)(kbase + ro); v4[i4][i] = *(const u32x4*)(vbase + ro); }
#pragma unroll
          for (int i4 = 0; i4 < 2; ++i4) attn_stage(lds + (2 * h2 + i4) * ASLOT, lds + (2 * h2 + i4) * ASLOT + 64 * KP, k4[i4], v4[i4], gks, sp, skp, lane); }
        bf16x8 qf[2][4];
#pragma unroll
        for (int rb = 0; rb < 2; ++rb) {
            const bf16_t* qp = Qb + (rowbase + r0 + 16 * rb + fr) * DM + hh * 128 + 8 * fq; u32x4 raw[4]; float ss = 0.f;
#pragma unroll
            for (int ks = 0; ks < 4; ++ks) { raw[ks] = *(const u32x4*)(qp + 32 * ks);
#pragma unroll
                for (int j = 0; j < 4; ++j) { const float x0 = bflo(raw[ks][j]), x1 = bfhi(raw[ks][j]); ss += x0 * x0 + x1 * x1; } }
            ss += lane_get(ss, lane ^ 16); ss += lane_get(ss, lane ^ 32);
            const float rs = rsqrtf(ss * (1.0f / 128.0f) + EPS) * (0.08838834764831845f * 1.4426950408889634f);
#pragma unroll
            for (int ks = 0; ks < 4; ++ks) { u32x4 o;
#pragma unroll
                for (int j = 0; j < 4; ++j) o[j] = pk2(bflo(raw[ks][j]) * rs, bfhi(raw[ks][j]) * rs);
                qf[rb][ks] = __builtin_bit_cast(bf16x8, o); }
        }
        f32x4 O[2][8];
#pragma unroll
        for (int rb = 0; rb < 2; ++rb)
#pragma unroll
            for (int db = 0; db < 8; ++db) O[rb][db] = (f32x4){0.f, 0.f, 0.f, 0.f};
        float carry[2] = {1.f, 1.f};
        bool alive = true;
        __syncthreads();
        for (int s_ = 0;; ++s_) {
            const int kb = kbw - s_, nbn = qt * 4 - s_ - 1;
            if (nbn >= 0) {
#pragma unroll
                for (int i = 0; i < 2; ++i) { const size_t ro = (size_t)(nbn * 64 + 2 * skp + i) * DM; kr[i] = *(const u32x4*)(kbase + ro); vr[i] = *(const u32x4*)(vbase + ro); } }
            if (alive && kb >= 0) {
                const LAS unsigned char* Ks = lds + (kb & 3) * ASLOT; const LAS unsigned char* Vt = Ks + 64 * KP;
                unsigned pw[2][4][2];
#pragma unroll
                for (int rb = 0; rb < 2; ++rb) {
                    f32x4 S[4];
#pragma unroll
                    for (int nb = 0; nb < 4; ++nb) { f32x4 sacc = (f32x4){0.f, 0.f, 0.f, 0.f};
#pragma unroll
                        for (int ks = 0; ks < 4; ++ks) { const bf16x8 kf = *(const LAS bf16x8*)(Ks + (16 * nb + fr) * KP + (32 * ks + 8 * fq) * 2); sacc = __builtin_amdgcn_mfma_f32_16x16x32_bf16(kf, qf[rb][ks], sacc, 0, 0, 0); }
                        S[nb] = sacc; }
                    if (s_ == 0) sb_weights<true>(S, carry[rb], pw[rb], r0 + 16 * rb + fr, kb * 64 + 4 * fq, fq, lane);
                    else sb_weights<false>(S, carry[rb], pw[rb], r0 + 16 * rb + fr, kb * 64 + 4 * fq, fq, lane);
                }
#pragma unroll
                for (int ks2 = 0; ks2 < 2; ++ks2) {
                    bf16x8 pf[2];
#pragma unroll
                    for (int rb = 0; rb < 2; ++rb) { u32x4 t; t.x = pw[rb][2 * ks2][0]; t.y = pw[rb][2 * ks2][1]; t.z = pw[rb][2 * ks2 + 1][0]; t.w = pw[rb][2 * ks2 + 1][1]; pf[rb] = __builtin_bit_cast(bf16x8, t); }
#pragma unroll
                    for (int db = 0; db < 8; ++db) { const LAS unsigned char* vrow = Vt + (16 * db + fr) * VP;
                        const u32x2 va = *(const LAS u32x2*)(vrow + 4 * ((16 * ks2 + 2 * fq) ^ (2 * db))), vb = *(const LAS u32x2*)(vrow + 4 * ((16 * ks2 + 8 + 2 * fq) ^ (2 * db)));
                        u32x4 t; t.x = va.x; t.y = va.y; t.z = vb.x; t.w = vb.y; const bf16x8 vf = __builtin_bit_cast(bf16x8, t);
#pragma unroll
                        for (int rb = 0; rb < 2; ++rb) O[rb][db] = __builtin_amdgcn_mfma_f32_16x16x32_bf16(vf, pf[rb], O[rb][db], 0, 0, 0); }
                }
                alive = !__all((carry[0] < DEAD) && (carry[1] < DEAD));
            }
            if (lane == 0) flags[w] = (alive && kb >= 1) ? 1 : 0;
            __syncthreads();
            int any = 0;
#pragma unroll
            for (int ww = 0; ww < 8; ++ww) any |= flags[ww];
            if (!any) break;
            if (nbn >= 0) attn_stage(lds + (nbn & 3) * ASLOT, lds + (nbn & 3) * ASLOT + 64 * KP, kr, vr, gks, sp, skp, lane);
            __syncthreads();
        }
#pragma unroll
        for (int rb = 0; rb < 2; ++rb) { bf16_t* op = Yb + (rowbase + r0 + 16 * rb + fr) * DM + hh * 128 + 4 * fq;
#pragma unroll
            for (int db = 0; db < 8; ++db) { u32x2 o; o.x = pk2(O[rb][db][0], O[rb][db][1]); o.y = pk2(O[rb][db][2], O[rb][db][3]); *(u32x2*)(op + 16 * db) = o; } }
        __syncthreads();
    }
}
constexpr int XP = 272;
__device__ void rnn_phase(ArgsP a, int l, LAS unsigned char* lds, const int wv) {
    const int tid = opaque_tid(wv), w = __builtin_amdgcn_readfirstlane(tid >> 6), lane = tid & 63, fr = lane & 15, fq = lane >> 4;
    LAS unsigned char* XC = lds; LAS unsigned char* HT = lds + RT * XP; LAS unsigned char* PT = lds + 2 * RT * XP;
    const bf16_t* XR = (const bf16_t*)(a->ws + WS_P + 3 * PBUF); const bf16_t* GY = (const bf16_t*)(a->ws + WS_P + 4 * PBUF); bf16_t* SGA = (bf16_t*)(a->ws + WS_P + 4 * PBUF);
    bf16_t* M0o = (bf16_t*)(a->out);
    float* SUM = (float*)(a->ws + WS_SUM);
    const bf16_t* gw = (const bf16_t*)(a->ws + WS_GW) + (size_t)l * 2 * 8 * 16384;
    const float* cw = a->in[6] + (size_t)l * 4 * DM; const float* cb = a->in[7] + (size_t)l * DM;
    const float* ba = a->in[9] + (size_t)l * DM; const float* bx = a->in[11] + (size_t)l * DM; const float* lam = a->in[12] + (size_t)l * DM;
    const int sp = tid & 15, tg = tid >> 4;
    const int nunits = NB * 8 * NT;
    const int hh = blockIdx.x & 7, cbase = hh * 128;
    const int c = cbase + 16 * w + fr;
    const float bac = ba[c], bxc = bx[c]; const float lm = lam[c];
    const float sp8l = 8.0f * 1.4426950408889634f * (fmaxf(-lm, 0.f) + __logf(1.0f + __expf(-fabsf(lm))));
    u32x4 r[7];
    { const int unit = blockIdx.x; if (unit < nunits) { const int b = (unit >> 3) & 3, j = unit >> 5; const size_t rowbase = (size_t)b * SEQ;
#pragma unroll
        for (int i = 0; i < 7; ++i) { const int ts = j * RT + 4 * tg - 3 + i; r[i] = (u32x4){0, 0, 0, 0}; if (ts >= 0) r[i] = *(const u32x4*)(XR + (rowbase + ts) * DM + cbase + sp * 8); } } }
    for (int unit = blockIdx.x; unit < nunits; unit += gridDim.x) {
        const int b = (unit >> 3) & 3, j = unit >> 5; const int t0 = j * RT; const size_t rowbase = (size_t)b * SEQ;
        { f32x2 wv2[4][4], bv2[4];
#pragma unroll
          for (int jj = 0; jj < 4; ++jj) { bv2[jj] = *(const f32x2*)(cb + cbase + sp * 8 + 2 * jj);
#pragma unroll
              for (int k = 0; k < 4; ++k) wv2[k][jj] = *(const f32x2*)(cw + k * DM + cbase + sp * 8 + 2 * jj); }
#pragma unroll
          for (int i = 0; i < 4; ++i) { f32x2 acc2[4];
#pragma unroll
              for (int jj = 0; jj < 4; ++jj) acc2[jj] = bv2[jj];
#pragma unroll
              for (int k = 0; k < 4; ++k) {
#pragma unroll
                  for (int jj = 0; jj < 4; ++jj) acc2[jj] += wv2[k][jj] * (f32x2){bflo(r[i + k][jj]), bfhi(r[i + k][jj])}; }
              u32x4 o; o.x = pk2(acc2[0].x, acc2[0].y); o.y = pk2(acc2[1].x, acc2[1].y); o.z = pk2(acc2[2].x, acc2[2].y); o.w = pk2(acc2[3].x, acc2[3].y);
              *(LAS u32x4*)(XC + (4 * tg + i) * XP + sp * 16) = o; } }
        bf16x8 wa[4], wx[4];
        { const bf16_t* pa = gw + ((size_t)(0 * 8 + hh) * 128 + 16 * w + fr) * 128 + 8 * fq; const bf16_t* px = gw + ((size_t)(1 * 8 + hh) * 128 + 16 * w + fr) * 128 + 8 * fq;
#pragma unroll
          for (int ks = 0; ks < 4; ++ks) { wa[ks] = *(const bf16x8*)(pa + 32 * ks); wx[ks] = *(const bf16x8*)(px + 32 * ks); } }
        { const int un = unit + gridDim.x; if (un < nunits) { const int bn = (un >> 3) & 3, jn = un >> 5; const size_t rbn = (size_t)bn * SEQ;
#pragma unroll
            for (int i = 0; i < 7; ++i) { const int ts = jn * RT + 4 * tg - 3 + i; r[i] = (u32x4){0, 0, 0, 0}; if (ts >= 0) r[i] = *(const u32x4*)(XR + (rbn + ts) * DM + cbase + sp * 8); } } }
        __syncthreads();
        f32x4 A[8], U[8];
#pragma unroll
        for (int mb = 0; mb < 8; ++mb) { f32x4 ra = (f32x4){0.f, 0.f, 0.f, 0.f}, rx = ra;
#pragma unroll
            for (int ks = 0; ks < 4; ++ks) { const bf16x8 xf = *(const LAS bf16x8*)(XC + (16 * mb + fr) * XP + (32 * ks + 8 * fq) * 2);
                ra = __builtin_amdgcn_mfma_f32_16x16x32_bf16(xf, wa[ks], ra, 0, 0, 0); rx = __builtin_amdgcn_mfma_f32_16x16x32_bf16(xf, wx[ks], rx, 0, 0, 0); }
#pragma unroll
            for (int hp = 0; hp < 2; ++hp) {
                const f32x2 ta = (f32x2){ra[2 * hp], ra[2 * hp + 1]} * (-1.4426950408889634f) + (-1.4426950408889634f * bac), tx = (f32x2){rx[2 * hp], rx[2 * hp + 1]} * (-1.4426950408889634f) + (-1.4426950408889634f * bxc);
                const f32x2 da = (f32x2){__builtin_amdgcn_exp2f(ta.x), __builtin_amdgcn_exp2f(ta.y)} + 1.0f, dx = (f32x2){__builtin_amdgcn_exp2f(tx.x), __builtin_amdgcn_exp2f(tx.y)} + 1.0f;
                const f32x2 r = (f32x2){__builtin_amdgcn_rcpf(da.x), __builtin_amdgcn_rcpf(da.y)}, ig = (f32x2){__builtin_amdgcn_rcpf(dx.x), __builtin_amdgcn_rcpf(dx.y)};
                const f32x2 la2 = r * (-sp8l);
                const f32x2 av = (f32x2){__builtin_amdgcn_exp2f(la2.x), __builtin_amdgcn_exp2f(la2.y)};
                const f32x2 x2 = la2 * 1.3862943611198906f;
                const f32x2 ser = -x2 * (x2 * (x2 * (1.0f / 6.0f) + 0.5f) + 1.0f), alt = 1.0f - av * av;
                const f32x2 om = (f32x2){x2.x > -0.02f ? ser.x : alt.x, x2.y > -0.02f ? ser.y : alt.y};
                const f32x2 xc = (f32x2){bf2f(*(const LAS bf16_t*)(XC + (16 * mb + 4 * fq + 2 * hp) * XP + (16 * w + fr) * 2)), bf2f(*(const LAS bf16_t*)(XC + (16 * mb + 4 * fq + 2 * hp + 1) * XP + (16 * w + fr) * 2))};
                const f32x2 uu = (f32x2){__builtin_amdgcn_sqrtf(om.x), __builtin_amdgcn_sqrtf(om.y)} * (ig * xc);
                ra[2 * hp] = av.x; ra[2 * hp + 1] = av.y; rx[2 * hp] = uu.x; rx[2 * hp + 1] = uu.y; }
            A[mb] = ra; U[mb] = rx; }
        u32x4 mg[4];
#pragma unroll
        for (int i = 0; i < 4; ++i) { const size_t go = (rowbase + t0 + 4 * tg + i) * DM + cbase + sp * 8; mg[i] = *(const u32x4*)(GY + go); }
        float H = 0.f, Pp = 1.0f;
#pragma unroll
        for (int mb = 0; mb < 8; ++mb) {
            float Ag = A[mb][0] * A[mb][1] * A[mb][2] * A[mb][3];
            float Ug = ((U[mb][0] * A[mb][1] + U[mb][1]) * A[mb][2] + U[mb][2]) * A[mb][3] + U[mb][3];
            { const float a1 = lane_get(Ag, lane - 16), u1 = lane_get(Ug, lane - 16); if (fq >= 1) { const f32x2 t = (f32x2){u1, a1} * Ag + (f32x2){Ug, 0.f}; Ug = t.x; Ag = t.y; } }
            { const float a2 = lane_get(Ag, lane - 32), u2 = lane_get(Ug, lane - 32); if (fq >= 2) { const f32x2 t = (f32x2){u2, a2} * Ag + (f32x2){Ug, 0.f}; Ug = t.x; Ag = t.y; } }
            const float ap = lane_get(Ag, lane - 16), up = lane_get(Ug, lane - 16);
            f32x2 hp = fq == 0 ? (f32x2){H, Pp} : (f32x2){H, Pp} * ap + (f32x2){up, 0.f};
#pragma unroll
            for (int e = 0; e < 4; ++e) { hp = hp * A[mb][e] + (f32x2){U[mb][e], 0.f}; const unsigned hp2 = pk2(hp.x, hp.y); const int off = (16 * mb + 4 * fq + e) * XP + (16 * w + fr) * 2;
                *(LAS bf16_t*)(HT + off) = (bf16_t)(hp2 & 0xffff); *(LAS bf16_t*)(PT + off) = (bf16_t)(hp2 >> 16); }
            const float Am = lane_get(Ag, 48 + fr), Um = lane_get(Ug, 48 + fr);
            { const f32x2 t = (f32x2){H, Pp} * Am + (f32x2){Um, 0.f}; H = t.x; Pp = t.y; }
        }
        if (fq == 0) { float* sm = SUM + (((size_t)b * NT + j) * DM + c) * 2; sm[0] = Pp; sm[1] = H; }
        __syncthreads();
#pragma unroll
        for (int i = 0; i < 4; ++i) { const int tl = 4 * tg + i; const size_t go = (rowbase + t0 + tl) * DM + cbase + sp * 8;
            const u32x4 hv = *(const LAS u32x4*)(HT + tl * XP + sp * 16), pv = *(const LAS u32x4*)(PT + tl * XP + sp * 16);
            u32x4 o0, o1;
#pragma unroll
            for (int jj = 0; jj < 4; ++jj) { const f32x2 g2 = (f32x2){bflo(mg[i][jj]), bfhi(mg[i][jj])};
                const f32x2 m0 = g2 * (f32x2){bflo(hv[jj]), bfhi(hv[jj])}, m1 = g2 * (f32x2){bflo(pv[jj]), bfhi(pv[jj])};
                o0[jj] = pk2(m0.x, m0.y); o1[jj] = pk2(m1.x, m1.y); }
            *(u32x4*)(M0o + go) = o0; *(u32x4*)(SGA + go) = o1; }
    }
}
__device__ void mix_phase(ArgsP a, LAS unsigned char* lds, const int wv) {
    const bf16_t* M0 = (const bf16_t*)(a->out); const bf16_t* M1 = (const bf16_t*)(a->ws + WS_P + 4 * PBUF); const bf16_t* SGB = (const bf16_t*)(a->out) + (size_t)MTOK * DM; const bf16_t* YB = (const bf16_t*)(a->ws + WS_P);
    bf16_t* MIX = (bf16_t*)(a->out); const float* SUM = (const float*)(a->ws + WS_SUM);
    LAS float* hin = (LAS float*)lds;
    const int tid = opaque_tid(wv);
    for (int tile = blockIdx.x; tile < NB * NT; tile += gridDim.x) {
        const int b = tile / NT, j = tile % NT;
        { float H0 = 0.f, H1 = 0.f; const float* sp_ = SUM + ((size_t)b * NT * DM + 2 * tid) * 2;
#pragma unroll 8
          for (int jj = 0; jj < j; ++jj) { const f32x4 v = *(const f32x4*)(sp_ + (size_t)jj * DM * 2); H0 = v[0] * H0 + v[1]; H1 = v[2] * H1 + v[3]; }
          hin[2 * tid] = H0; hin[2 * tid + 1] = H1; }
        __syncthreads();
        const int pc = tid & 127, r0 = tid >> 7; const f32x4 h0 = *(const LAS f32x4*)(hin + pc * 8), h1 = *(const LAS f32x4*)(hin + pc * 8 + 4);
        const size_t rowbase = (size_t)b * SEQ + (size_t)j * RT;
#pragma unroll 8
        for (int r = r0; r < RT; r += 4) { const size_t go = (rowbase + r) * DM + pc * 8; const u32x4 m0 = *(const u32x4*)(M0 + go), m1 = *(const u32x4*)(M1 + go), sg = *(const u32x4*)(SGB + go), yb = *(const u32x4*)(YB + go); u32x4 o;
            o.x = pk2(bflo(m0.x) + bflo(m1.x) * h0[0] + bflo(sg.x) * bflo(yb.x), bfhi(m0.x) + bfhi(m1.x) * h0[1] + bfhi(sg.x) * bfhi(yb.x)); o.y = pk2(bflo(m0.y) + bflo(m1.y) * h0[2] + bflo(sg.y) * bflo(yb.y), bfhi(m0.y) + bfhi(m1.y) * h0[3] + bfhi(sg.y) * bfhi(yb.y));
            o.z = pk2(bflo(m0.z) + bflo(m1.z) * h1[0] + bflo(sg.z) * bflo(yb.z), bfhi(m0.z) + bfhi(m1.z) * h1[1] + bfhi(sg.z) * bfhi(yb.z)); o.w = pk2(bflo(m0.w) + bflo(m1.w) * h1[2] + bflo(sg.w) * bflo(yb.w), bfhi(m0.w) + bfhi(m1.w) * h1[3] + bfhi(sg.w) * bfhi(yb.w));
            *(u32x4*)(MIX + go) = o; }
        __syncthreads();
    }
}
template <class Sched>
__device__ void ffn_fixup(ArgsP a, int l, const Sched& S, const int wv) {
    bf16_t* ACT = (bf16_t*)(a->ws + WS_P); const bf16_t* HALO = (const bf16_t*)(a->ws + WS_P + ACT_BYTES);
    const float* cw = a->in[18] + (size_t)l * 3 * DFF2; const float* cb = a->in[19] + (size_t)l * DFF2;
    const int tid = opaque_tid(wv); pg8::Unit u;
    for (int ui = 0; S.next(ui, u); ++ui)
    for (int it = tid; it < 2 * (DFF / 8); it += NTH) {
        const int cgp = it % (DFF / 8), wb = 2 * u.pm + it / (DFF / 8); const int c0 = cgp * 8, t0 = wb * 128; const bool first = (t0 & (SEQ - 1)) == 0;
        const bf16_t* hc = HALO + (size_t)wb * 4 * DFF2; const bf16_t* hpv = hc - 4 * DFF2;
        u32x4 z = (u32x4){0, 0, 0, 0}; u32x4 gm2 = z, gm1 = z, vm2 = z, vm1 = z;
        if (!first) { gm2 = *(const u32x4*)(hpv + 2 * DFF2 + c0); gm1 = *(const u32x4*)(hpv + 3 * DFF2 + c0); vm2 = *(const u32x4*)(hpv + 2 * DFF2 + DFF + c0); vm1 = *(const u32x4*)(hpv + 3 * DFF2 + DFF + c0); }
        const u32x4 g0 = *(const u32x4*)(hc + c0), g1 = *(const u32x4*)(hc + DFF2 + c0), v0 = *(const u32x4*)(hc + DFF + c0), v1 = *(const u32x4*)(hc + DFF2 + DFF + c0);
        u32x4 o0, o1;
#pragma unroll
        for (int hf = 0; hf < 2; ++hf) {
            const int c = c0 + 4 * hf;
            const f32x4 wg0 = *(const f32x4*)(cw + c), wg1 = *(const f32x4*)(cw + DFF2 + c), wg2 = *(const f32x4*)(cw + 2 * DFF2 + c), wv0 = *(const f32x4*)(cw + DFF + c), wv1 = *(const f32x4*)(cw + DFF2 + DFF + c), wv2 = *(const f32x4*)(cw + 2 * DFF2 + DFF + c);
            const f32x4 bg = *(const f32x4*)(cb + c), bv = *(const f32x4*)(cb + DFF + c);
#define UNP(x) ((f32x4){bflo((x)[2 * hf]), bfhi((x)[2 * hf]), bflo((x)[2 * hf + 1]), bfhi((x)[2 * hf + 1])})
            const f32x4 G2 = UNP(gm2), G1 = UNP(gm1), Ga = UNP(g0), Gb = UNP(g1), V2 = UNP(vm2), V1 = UNP(vm1), Va = UNP(v0), Vb = UNP(v1);
#undef UNP
            const f32x4 cg0 = bg + wg0 * G2 + wg1 * G1 + wg2 * Ga, cv0 = bv + wv0 * V2 + wv1 * V1 + wv2 * Va, cg1 = bg + wg0 * G1 + wg1 * Ga + wg2 * Gb, cv1 = bv + wv0 * V1 + wv1 * Va + wv2 * Vb;
            const f32x4 r0 = cg0 * cv0 * rcp_4(gelu_den4(cg0)), r1 = cg1 * cv1 * rcp_4(gelu_den4(cg1));
            o0[2 * hf] = pk2(r0[0], r0[1]); o0[2 * hf + 1] = pk2(r0[2], r0[3]); o1[2 * hf] = pk2(r1[0], r1[1]); o1[2 * hf + 1] = pk2(r1[2], r1[3]); }
        *(u32x4*)(ACT + (size_t)t0 * DFF + c0) = o0; *(u32x4*)(ACT + (size_t)(t0 + 1) * DFF + c0) = o1;
    }
}
constexpr int LDS_BYTES = 137 * 1024;
__global__ void __launch_bounds__(NTH, 2) mk_fwd(Args a_unused) {
    ArgsP a = (ArgsP)__builtin_amdgcn_kernarg_segment_ptr(); asm volatile("" : "+s"(a));
    const int wv = __builtin_amdgcn_readfirstlane(threadIdx.x >> 6);
    extern __shared__ __attribute__((aligned(16))) unsigned char lds_raw[];
    LAS unsigned char* lds = (LAS unsigned char*)lds_raw;
    cg::grid_group grid = cg::this_grid();
    volatile LAS unsigned* xbst = (volatile LAS unsigned*)(lds + LDS_BYTES - 16);
    if (threadIdx.x < 4) xbst[threadIdx.x] = 0u;
    __syncthreads();
    const XcdBarrier xbar = xcd_barrier_post((unsigned*)(a->ws + WS_BAR), xbst);
    const int G = gridDim.x, bid = blockIdx.x;
    float* mod = (float*)(a->ws + WS_MOD);
    bf16_t* XN = (bf16_t*)(a->out); bf16_t* P = (bf16_t*)(a->ws + WS_P);
#ifndef REPMASK
#define REPMASK 0
#endif
#ifndef XSYNC
#define XSYNC 0
#endif
#ifndef TMASK
#define TMASK 0
#endif
    unsigned long long tacc = 0ull;
#define RUN(k, ...) for (int _r = 0; _r < (((REPMASK >> (k)) & 1) ? 2 : 1); ++_r) { const unsigned long long _t0 = ((TMASK >> (k)) & 1) ? __builtin_amdgcn_s_memrealtime() : 0ull; __VA_ARGS__ xcd_barrier(xbar, wv); if ((TMASK >> (k)) & 1) tacc += __builtin_amdgcn_s_memrealtime() - _t0; }
    if (a->out == nullptr) grid.sync();
    RUN(0, p0_mod(a, lds, wv); p0_weights(a, lds, wv);)
    for (int _x = 0; _x < XSYNC; ++_x) xcd_barrier(xbar, wv);
    for (int l = 0; l < NL; ++l) {
        const float* modl = mod + (size_t)l * NB * 6144;
        const bf16_t* wl = (const bf16_t*)(a->ws + WS_W) + (size_t)l * W_LAYER_E;
        bf16_t* XB = (bf16_t*)(a->ws + WS_XB);
        RUN(1, norm_phase(l == 0 ? a->in[0] : nullptr, XB, a->in[4] + l * DM, modl, 0, 1, XN, wv);)
        RUN(2, { pg8::Gemm g{XN, wl, MTOK, DIN, DM}; pg8::StaticOrder S; S.init(MTOK, DIN, G, bid);
          EpiIn E{P, (bf16_t*)(a->out) + (size_t)MTOK * DM}; pg8::gemm_phase<EpiIn, pg8::StaticOrder, true, true>(lds, g, S, E, wv); })
        RUN(3, attn_phase(a, l, lds, wv); rnn_phase(a, l, lds, wv);)
        RUN(7, mix_phase(a, lds, wv);)
        RUN(8, { pg8::Gemm g{XN, wl + W_IN_E, MTOK, DM, DM}; pg8::StaticOrder S; S.init(MTOK, DM, G, bid);
          EpiRes E{l == 0 ? a->in[0] : nullptr, XB, XB, nullptr, modl + 2 * 1024}; pg8::gemm_phase<EpiRes, pg8::StaticOrder, true, true>(lds, g, S, E, wv); })
        RUN(9, norm_phase(nullptr, XB, a->in[16] + l * DM, modl, 3, 4, XN, wv);)
        RUN(10, { pg8::Gemm g{XN, wl + W_IN_E + W_OUT_E, MTOK, DFF2, DM}; pg8::StaticOrder S; S.init(MTOK, DFF2, G, bid);
          EpiConvAct E{P, (bf16_t*)(a->ws + WS_P + ACT_BYTES), a->in[18] + (size_t)l * 3 * DFF2, a->in[19] + (size_t)l * DFF2};
          pg8::gemm_phase<EpiConvAct, pg8::StaticOrder, true, true, true>(lds, g, S, E, wv); })
        RUN(12, { pg8::Gemm g{P, wl + W_IN_E + W_OUT_E + W_UP_E, MTOK, DM, DFF}; pg8::StaticOrder S; S.init(MTOK, DM, G, bid);
          ffn_fixup(a, l, S, wv); asm volatile("s_waitcnt vmcnt(0)" ::: "memory"); __syncthreads();
          EpiRes E{nullptr, XB, XB, l == NL - 1 ? a->out : nullptr, modl + 5 * 1024}; pg8::gemm_phase<EpiRes, pg8::StaticOrder, true, true>(lds, g, S, E, wv); })
    }
    if (TMASK != 0 && blockIdx.x == 0) { const unsigned long long t0 = __builtin_amdgcn_s_memrealtime(); while (__builtin_amdgcn_s_memrealtime() - t0 < tacc) __builtin_amdgcn_s_sleep(8); }
}
extern "C" void kernel_launch(void* const* d_in, const int* in_sizes, int n_in, void* d_out, int out_size, void* d_ws, size_t ws_size, hipStream_t stream) {
    static int grid = 0;
    if (!grid) {
        int dev = 0, cus = 0, per_cu = 0;
        (void)hipGetDevice(&dev);
        (void)hipDeviceGetAttribute(&cus, hipDeviceAttributeMultiprocessorCount, dev);
        (void)hipFuncSetAttribute((const void*)mk_fwd, hipFuncAttributeMaxDynamicSharedMemorySize, LDS_BYTES);
        (void)hipOccupancyMaxActiveBlocksPerMultiprocessor(&per_cu, (const void*)mk_fwd, NTH, LDS_BYTES);
        if (per_cu < 1) per_cu = 1;
        grid = cus * per_cu;
        if (ws_size < WS_END) { fprintf(stderr, "kernel_launch: workspace too small: %zu < %zu\n", ws_size, (size_t)WS_END); grid = -1; }
        if (n_in != 21 || out_size != MTOK * DM) { fprintf(stderr, "kernel_launch: unexpected shapes\n"); grid = -1; }
    }
    if (grid < 0) return;
    (void)hipMemsetAsync((char*)d_ws + WS_BAR, 0, XCD_BAR_WORDS * 4, stream);
    Args a{};
    for (int i = 0; i < 21; ++i) a.in[i] = (const float*)d_in[i];
    a.out = (float*)d_out; a.ws = (unsigned char*)d_ws;
    void* args[] = {&a};
    hipError_t e = hipLaunchCooperativeKernel((const void*)mk_fwd, dim3(grid), dim3(NTH), args, LDS_BYTES, stream);
    if (e != hipSuccess) fprintf(stderr, "cooperative launch failed: %s (grid %d)\n", hipGetErrorString(e), grid);
}
```
